# Optimizing an MI355X kernel written in HIP

```python
import jax, jax.numpy as jnp
from jax import lax
import numpy as np

D_MODEL = 1024
BATCH = 4
SEQ = 8192
DEPTH = 4

CHUNK = 64
GLA_HEADS = 4
GLA_DK = D_MODEL // 2
GLA_DV = D_MODEL
GLA_HEAD_DK = GLA_DK // GLA_HEADS
GLA_HEAD_DV = GLA_DV // GLA_HEADS
GATE_RANK = 16
GATE_TAU = 16.0
POOL_WIDTH = D_MODEL
POOL_WINDOWS = (2, 4, 8, 16)
POOL_GROUPS = len(POOL_WINDOWS)
POOL_GROUP_DIM = POOL_WIDTH // POOL_GROUPS
N_BRANCHES = 2
IN_SPLITS = (GLA_DK, GLA_DK, GLA_DV, GLA_DV, GATE_RANK, POOL_WIDTH, POOL_WIDTH, N_BRANCHES * D_MODEL)
IN_COLS = sum(IN_SPLITS)
IN_OFFSETS = tuple(int(v) for v in np.cumsum(IN_SPLITS)[:-1])
DEEPNORM_ALPHA = (2.0 * DEPTH) ** 0.25
DEEPNORM_BETA = (8.0 * DEPTH) ** -0.25
EPS = 1e-5

kernel_name = "hybrid_gla_pool_deepnorm_encoder"


def _layernorm(x, g, b):
    x32 = x.astype(jnp.float32)
    mu = jnp.mean(x32, axis=-1, keepdims=True)
    var = jnp.mean(jnp.square(x32 - mu), axis=-1, keepdims=True)
    return ((x32 - mu) * lax.rsqrt(var + EPS) * g + b).astype(x.dtype)


def _gla_chunked(q, k, v, log_alpha):
    B, S, H, dk = q.shape
    dv = v.shape[-1]
    nc = S // CHUNK

    def to_chunks(a):
        return a.reshape(B, nc, CHUNK, H, a.shape[-1]).transpose(1, 0, 3, 2, 4)

    qc, kc, vc, lac = to_chunks(q), to_chunks(k), to_chunks(v), to_chunks(log_alpha)

    def step(state, inp):
        qb, kb, vb, lab = inp
        G = jnp.cumsum(lab, axis=2)
        decay = jnp.exp(-jnp.abs(G[:, :, :, None, :] - G[:, :, None, :, :]))
        scores = jnp.einsum('bhtd,bhsd,bhtsd->bhts', qb, kb, decay)
        o_intra = jnp.einsum('bhts,bhsv->bhtv', scores, vb)
        o_inter = jnp.einsum('bhtd,bhdv->bhtv', qb * jnp.exp(G), state)
        G_last = G[:, :, -1:, :]
        new_state = jnp.exp(G_last)[:, :, 0, :, None] * state + jnp.einsum(
            'bhsd,bhsv->bhdv', kb * jnp.exp(G_last - G), vb)
        return new_state, o_intra + o_inter

    state0 = jnp.zeros((B, H, dk, dv), jnp.float32)
    _, o = lax.scan(step, state0, (qc, kc, vc, lac))
    return o.transpose(1, 0, 3, 2, 4).reshape(B, S, H, dv)


def _multiscale_pool(u, w_grp, scale):
    B, S, _ = u.shape
    ug = u.astype(jnp.float32).reshape(B, S, POOL_GROUPS, POOL_GROUP_DIM)
    csum = jnp.cumsum(ug, axis=1)
    pos = jnp.arange(1, S + 1)
    means = []
    for g, w in enumerate(POOL_WINDOWS):
        c = csum[:, :, g]
        shifted = jnp.pad(c, ((0, 0), (w, 0), (0, 0)))[:, :S]
        cnt = jnp.minimum(pos, w).astype(jnp.float32)
        means.append((c - shifted) / cnt[None, :, None])
    pooled = jnp.stack(means, axis=2) - ug
    mixed = jnp.einsum('bsgi,gio->bsgo', pooled, w_grp)
    return mixed.reshape(B, S, POOL_WIDTH) * scale


def _layer(x, w_in, w_alpha_up, b_alpha, gla_norm_g, w_pool_grp, pool_scale,
           b_merge, w_proj_a, w_proj_b, w_out, ln_g, ln_b):
    B, S, _ = x.shape
    h = x @ w_in
    q, k, v, gate_a, alpha_low, pool_in, gate_b, merge_logits = jnp.split(h, IN_OFFSETS, axis=-1)

    log_alpha = jax.nn.log_sigmoid((alpha_low @ w_alpha_up + b_alpha).astype(jnp.float32)) / GATE_TAU
    qh = q.reshape(B, S, GLA_HEADS, GLA_HEAD_DK) * (GLA_HEAD_DK ** -0.5)
    kh = k.reshape(B, S, GLA_HEADS, GLA_HEAD_DK)
    vh = v.reshape(B, S, GLA_HEADS, GLA_HEAD_DV)
    lah = log_alpha.reshape(B, S, GLA_HEADS, GLA_HEAD_DK)
    o = _gla_chunked(qh, kh, vh, lah)
    o = o * lax.rsqrt(jnp.mean(jnp.square(o), axis=-1, keepdims=True) + EPS) * gla_norm_g
    y_a = o.reshape(B, S, GLA_DV).astype(x.dtype) * jax.nn.silu(gate_a)

    y_b = _multiscale_pool(pool_in, w_pool_grp, pool_scale).astype(x.dtype) * jax.nn.silu(gate_b)

    gates = jax.nn.sigmoid(merge_logits + b_merge)
    g_a, g_b = jnp.split(gates, N_BRANCHES, axis=-1)
    merged = g_a * (y_a @ w_proj_a) + g_b * (y_b @ w_proj_b)
    y = merged @ w_out

    return _layernorm(DEEPNORM_ALPHA * x + y, ln_g, ln_b)


def setup_inputs(seed: int = 0) -> dict:
    key = jax.random.key(seed)
    ks = jax.random.split(key, 14)
    f32 = jnp.float32
    nrm = lambda k, shape, s: jax.random.normal(k, shape, f32) * s
    return {
        "x": jax.random.normal(ks[0], (BATCH, SEQ, D_MODEL), f32),
        "w_in": nrm(ks[1], (DEPTH, D_MODEL, IN_COLS), D_MODEL ** -0.5),
        "w_alpha_up": nrm(ks[2], (DEPTH, GATE_RANK, GLA_DK), GATE_RANK ** -0.5),
        "b_alpha": nrm(ks[3], (DEPTH, GLA_DK), 0.01),
        "gla_norm_g": 1.0 + nrm(ks[4], (DEPTH, GLA_HEADS, GLA_HEAD_DV), 0.02),
        "w_pool_grp": nrm(ks[5], (DEPTH, POOL_GROUPS, POOL_GROUP_DIM, POOL_GROUP_DIM), POOL_GROUP_DIM ** -0.5),
        "pool_scale": 1.0 + nrm(ks[6], (DEPTH, POOL_WIDTH), 0.02),
        "b_merge": nrm(ks[7], (DEPTH, N_BRANCHES * D_MODEL), 0.01),
        "w_proj_a": nrm(ks[8], (DEPTH, GLA_DV, D_MODEL), DEEPNORM_BETA * GLA_DV ** -0.5),
        "w_proj_b": nrm(ks[9], (DEPTH, POOL_WIDTH, D_MODEL), DEEPNORM_BETA * POOL_WIDTH ** -0.5),
        "w_out": nrm(ks[10], (DEPTH, D_MODEL, D_MODEL), DEEPNORM_BETA * D_MODEL ** -0.5),
        "ln_g": 1.0 + nrm(ks[11], (DEPTH, D_MODEL), 0.02),
        "ln_b": nrm(ks[12], (DEPTH, D_MODEL), 0.01),
    }


def reference(x, w_in, w_alpha_up, b_alpha, gla_norm_g, w_pool_grp, pool_scale,
              b_merge, w_proj_a, w_proj_b, w_out, ln_g, ln_b):
    for l in range(DEPTH):
        x = _layer(x, w_in[l], w_alpha_up[l], b_alpha[l], gla_norm_g[l], w_pool_grp[l],
                   pool_scale[l], b_merge[l], w_proj_a[l], w_proj_b[l], w_out[l],
                   ln_g[l], ln_b[l])
    return x
```

```cpp
#include <hip/hip_runtime.h>
#include <hip/hip_cooperative_groups.h>
#include <cstdio>
#include <cstdint>
namespace cg = cooperative_groups;

#ifndef N_LAUNCH_MODE
#define N_LAUNCH_MODE 0
#endif

#define LAS __attribute__((address_space(3)))
typedef unsigned short bf16_t;
typedef short bf16x8 __attribute__((ext_vector_type(8)));
typedef float f32x4 __attribute__((ext_vector_type(4)));
typedef float f32x2 __attribute__((ext_vector_type(2)));
typedef unsigned u32x4 __attribute__((ext_vector_type(4)));
typedef unsigned u32x2 __attribute__((ext_vector_type(2)));

constexpr int MTOK = 32768, DM = 1024, SEQ = 8192, DEPTH = 4, INC = 7184;
constexpr int NCH = 128;
constexpr float LN_EPS = 1e-5f;
constexpr float DN_ALPHA = 1.6817928305074290f;
constexpr float QSCALE = 0.08838834764831845f;
constexpr size_t UNITB = (size_t)MTOK * 1024 * 2;
constexpr size_t WS_X = 0, WS_QK = 1 * UNITB, WS_V = 2 * UNITB, WS_GA = 3 * UNITB, WS_GB = 4 * UNITB, WS_PIN = 5 * UNITB, WS_F1 = 6 * UNITB, WS_F2 = 7 * UNITB;
constexpr size_t WS_MG = WS_QK;
constexpr size_t WS_US = WS_PIN;
constexpr size_t WS_W1A = WS_F2;
constexpr size_t WS_WM = WS_W1A + (size_t)5120 * 1024 * 2;
constexpr size_t WS_WA = WS_WM + (size_t)2048 * 1024 * 2;
constexpr size_t WS_WB = WS_WA + (size_t)1024 * 1024 * 2;
constexpr size_t WS_WO = WS_WB + (size_t)1024 * 1024 * 2;
constexpr size_t WS_WG = WS_WO + (size_t)1024 * 1024 * 2;
constexpr size_t WS_AL = WS_WG + (size_t)4 * 256 * 256 * 2;
constexpr size_t WS_DF = WS_AL + (size_t)MTOK * 16 * 4;
constexpr size_t WS_END = WS_DF + (size_t)2048 * 128 * 4;
constexpr int LDS_BYTES = 131072;

__device__ __forceinline__ unsigned cvt_pk_bf16(float lo, float hi) { unsigned r; asm volatile("v_cvt_pk_bf16_f32 %0, %1, %2" : "=v"(r) : "v"(lo), "v"(hi)); return r; }
__device__ __forceinline__ float bf_lo(unsigned w) { return __uint_as_float(w << 16); }
__device__ __forceinline__ float bf_hi(unsigned w) { return __uint_as_float(w & 0xffff0000u); }
__device__ __forceinline__ float bf2f(bf16_t b) { return __uint_as_float((unsigned)b << 16); }
__device__ __forceinline__ float sigmoidf_(float z) { return 1.0f / (1.0f + __expf(-z)); }
__device__ __forceinline__ float siluf_(float z) { return z / (1.0f + __expf(-z)); }

namespace pg8 {
constexpr int BM = 256, BK = 64, HALF = 128, HTB = HALF * BK * 2, STAGE_BYTES = 8 * HTB, NXCD = 8, WGM = 8;
__host__ __device__ __forceinline__ int lds_byte(int r, int c) { const int st = (r >> 4) * 2 + (c >> 5), rr = r & 15, cc = c & 31, ob = rr * 64 + cc * 2; return st * 1024 + (ob ^ (((ob >> 9) & 1) << 5)); }
__host__ __device__ __forceinline__ void stage_rc(int b, int& R, int& C) { const int st = b / 1024, sb = b % 1024, swz = sb ^ (((sb >> 9) & 1) << 5); R = (st >> 1) * 16 + swz / 64; C = (st & 1) * 32 + (swz % 64) / 2; }
__host__ __device__ __forceinline__ int perm32(int rho) { const int n = rho >> 4, i = rho & 15; return 8 * (i >> 2) + 4 * n + (i & 3); }

struct Unit { const char* A; const char* B; int pm, pn, kind, keep; };
struct Gemm { int lda, ldb, K; };

struct Sched {
    const char *A0, *A1, *B0, *B1; size_t a_pm, a_pn, b_pn; int nM, nN, nwg, G, c, chain;
    __device__ __forceinline__ bool next(int i, Unit& u) const {
        const int ti = (chain == 2) ? (i >> 1) : i, which = (chain == 2) ? (i & 1) : 0;
        const long L = (long)ti * G + c; if (L >= nwg) return false;
        int wgid = (int)L; { const int q = nwg / NXCD, r = nwg % NXCD, xcd = wgid % NXCD, off = wgid / NXCD; wgid = (xcd < r ? xcd * (q + 1) : r * (q + 1) + (xcd - r) * q) + off; }
        const int nig = WGM * nN, gid = wgid / nig, fm = gid * WGM, gsz = (nM - fm) < WGM ? (nM - fm) : WGM;
        u.pm = fm + ((wgid % nig) % gsz); u.pn = (wgid % nig) / gsz;
        u.A = (which ? A1 : A0) + (size_t)u.pm * a_pm + (size_t)u.pn * a_pn; u.B = (which ? B1 : B0) + (size_t)u.pn * b_pn;
        u.kind = which; u.keep = (chain == 2 && which == 0) ? 1 : 0; return true;
    }
};

template <class Epi>
__device__ __forceinline__ void gemm_phase(LAS unsigned char* lds, const int tid, const Gemm g, const Sched& S, const Epi& E) {
    const int wid = __builtin_amdgcn_readfirstlane(tid >> 6), lane = tid & 63, wr = wid >> 2, wc = wid & 3, fr = lane & 15, fq = lane >> 4;
    const int K = g.K, nt = K / BK;
    unsigned voffA[2], voffB[2];
#pragma unroll
    for (int i = 0; i < 2; ++i) { int R, C; stage_rc(tid * 16 + i * 8192, R, C); const int Rb = Epi::PERM ? ((R & ~31) + perm32(R & 31)) : R;
        voffA[i] = (unsigned)(R * g.lda + C) * 2u; voffB[i] = (unsigned)(Rb * g.ldb + C) * 2u; }
    const size_t kstep = (size_t)(BK * 2);
    const size_t hstepA = (size_t)HALF * g.lda * 2, hstepB = (size_t)HALF * g.ldb * 2;
    const unsigned ldsw = (unsigned)wid * 1024u;
    const int aoff = lds_byte(wr * 64 + fr, fq * 8), boff = lds_byte(wc * 32 + fr, fq * 8);
#define PG8_SA(b, h) (((b) * 2 + (h)) * HTB)
#define PG8_SB(b, h) ((4 + (b) * 2 + (h)) * HTB)
#define PG8_STAGE(bufoff, gbase, voff) do { _Pragma("unroll") for (int _i = 0; _i < 2; ++_i) \
        __builtin_amdgcn_global_load_lds((const unsigned*)((const char*)(gbase) + (voff)[_i]), (LAS unsigned*)(lds + (bufoff) + ldsw + _i * 8192), 16, 0, 0); } while (0)
#define PG8_LDA(dst, b, h) do { _Pragma("unroll") for (int m = 0; m < 4; ++m) _Pragma("unroll") for (int k = 0; k < 2; ++k) dst[m][k] = *(const LAS bf16x8*)(lds + PG8_SA(b, h) + aoff + m * 2048 + k * 1024); } while (0)
#define PG8_LDB(dst, b, h) do { _Pragma("unroll") for (int n = 0; n < 2; ++n) _Pragma("unroll") for (int k = 0; k < 2; ++k) dst[n][k] = *(const LAS bf16x8*)(lds + PG8_SB(b, h) + boff + n * 2048 + k * 1024); } while (0)
#define PG8_MMA(ai, bj, At, Bt) do { __builtin_amdgcn_s_setprio(1); _Pragma("unroll") for (int m = 0; m < 4; ++m) _Pragma("unroll") for (int n = 0; n < 2; ++n) _Pragma("unroll") for (int k = 0; k < 2; ++k) \
        acc[ai][bj][m][n] = __builtin_amdgcn_mfma_f32_16x16x32_bf16(Bt[n][k], At[m][k], acc[ai][bj][m][n], 0, 0, 0); __builtin_amdgcn_s_setprio(0); } while (0)
#define PG8_WAIT_V(n) asm volatile("s_waitcnt vmcnt(" #n ")" ::: "memory")
#define PG8_WAIT_L(n) asm volatile("s_waitcnt lgkmcnt(" #n ")" ::: "memory")
#define PG8_BAR __builtin_amdgcn_s_barrier()
#define PG8_SCHED __builtin_amdgcn_sched_barrier(0)
    Unit cur, nxt; int ui = 0;
    if (!S.next(0, cur)) return;
    f32x4 acc[2][2][4][2];
#pragma unroll
    for (int a = 0; a < 2; ++a)
#pragma unroll
        for (int b = 0; b < 2; ++b)
#pragma unroll
            for (int m = 0; m < 4; ++m)
#pragma unroll
                for (int n = 0; n < 2; ++n) acc[a][b][m][n] = (f32x4){0.f, 0.f, 0.f, 0.f};
    bf16x8 At[4][2], B0[2][2], B1[2][2];
    const char* cA = cur.A; const char* cB = cur.B;
    PG8_STAGE(PG8_SB(0, 0), cB, voffB); PG8_STAGE(PG8_SB(0, 1), cB + hstepB, voffB); PG8_STAGE(PG8_SA(0, 0), cA, voffA); PG8_STAGE(PG8_SA(0, 1), cA + hstepA, voffA);
    if (wr == 1) PG8_BAR;
    PG8_WAIT_V(2); PG8_BAR;
    PG8_STAGE(PG8_SB(1, 0), cB + kstep, voffB); PG8_STAGE(PG8_SA(1, 0), cA + kstep, voffA); PG8_STAGE(PG8_SB(1, 1), cB + hstepB + kstep, voffB);
    PG8_WAIT_V(6); PG8_BAR;
    for (;;) {
        const bool has_next = S.next(ui + 1, nxt);
        const char* nA = has_next ? nxt.A : cA; const char* nB = has_next ? nxt.B : cB;
        for (int t = 0; t < nt; t += 2) {
            const bool last = (t == nt - 2);
            const char* a1 = cA + (size_t)(t + 1) * kstep;
            const char* a2 = last ? nA : cA + (size_t)(t + 2) * kstep; const char* b2 = last ? nB : cB + (size_t)(t + 2) * kstep;
            const char* a3 = a2 + kstep; const char* b3 = b2 + kstep;
            PG8_LDB(B0, 0, 0); PG8_LDB(B1, 0, 1); PG8_SCHED; PG8_LDA(At, 0, 0); PG8_STAGE(PG8_SA(1, 1), a1 + hstepA, voffA);
            PG8_WAIT_V(8); PG8_WAIT_L(0); PG8_BAR; PG8_MMA(0, 0, At, B0); PG8_MMA(0, 1, At, B1); PG8_BAR; PG8_SCHED;
            PG8_LDA(At, 0, 1); PG8_STAGE(PG8_SB(0, 0), b2, voffB); PG8_STAGE(PG8_SB(0, 1), b2 + hstepB, voffB); PG8_STAGE(PG8_SA(0, 0), a2, voffA);
            PG8_WAIT_V(8); PG8_WAIT_L(0); PG8_BAR; PG8_MMA(1, 0, At, B0); PG8_MMA(1, 1, At, B1); PG8_BAR; PG8_SCHED;
            PG8_LDB(B0, 1, 0); PG8_LDB(B1, 1, 1); PG8_SCHED; PG8_LDA(At, 1, 0); PG8_STAGE(PG8_SA(0, 1), a2 + hstepA, voffA);
            PG8_WAIT_V(8); PG8_WAIT_L(0); PG8_BAR; PG8_MMA(0, 0, At, B0); PG8_MMA(0, 1, At, B1); PG8_BAR; PG8_SCHED;
            PG8_LDA(At, 1, 1); PG8_STAGE(PG8_SB(1, 0), b3, voffB); PG8_STAGE(PG8_SB(1, 1), b3 + hstepB, voffB); PG8_STAGE(PG8_SA(1, 0), a3, voffA);
            PG8_WAIT_V(8); PG8_WAIT_L(0); PG8_BAR; PG8_MMA(1, 0, At, B0); PG8_MMA(1, 1, At, B1); PG8_BAR; PG8_SCHED;
        }
        if (wr == 0) PG8_BAR;
        E(acc, cur, wr, wc, fr, fq);
        if (!has_next) break;
        if (!cur.keep) {
#pragma unroll
            for (int a = 0; a < 2; ++a)
#pragma unroll
                for (int b = 0; b < 2; ++b)
#pragma unroll
                    for (int m = 0; m < 4; ++m)
#pragma unroll
                        for (int n = 0; n < 2; ++n) acc[a][b][m][n] = (f32x4){0.f, 0.f, 0.f, 0.f};
        }
        cur = nxt; cA = nA; cB = nB; ++ui;
        if (wr == 1) PG8_BAR;
    }
    PG8_WAIT_V(0);
    PG8_BAR;
#undef PG8_SA
#undef PG8_SB
#undef PG8_STAGE
#undef PG8_LDA
#undef PG8_LDB
#undef PG8_MMA
#undef PG8_WAIT_V
#undef PG8_WAIT_L
#undef PG8_BAR
#undef PG8_SCHED
}

struct EpiSplit {
    static constexpr bool PERM = true;
    bf16_t* base;
    __device__ __forceinline__ void operator()(const f32x4 (&acc)[2][2][4][2], const Unit& u, int wr, int wc, int fr, int fq) const {
        const int row0 = u.pm * BM + wr * 64 + fr; const int colt = u.pn * BM; const int t = colt >> 10;
        bf16_t* b = base + (size_t)t * ((size_t)MTOK * 1024); const int col0 = (colt & 1023) + wc * 32 + 8 * fq;
#pragma unroll
        for (int ai = 0; ai < 2; ++ai)
#pragma unroll
            for (int m = 0; m < 4; ++m) { bf16_t* rowp = b + (size_t)(row0 + ai * HALF + m * 16) * 1024 + col0;
#pragma unroll
                for (int bj = 0; bj < 2; ++bj) { const f32x4 v0 = acc[ai][bj][m][0], v1 = acc[ai][bj][m][1];
                    u32x4 w; w.x = cvt_pk_bf16(v0[0], v0[1]); w.y = cvt_pk_bf16(v0[2], v0[3]); w.z = cvt_pk_bf16(v1[0], v1[1]); w.w = cvt_pk_bf16(v1[2], v1[3]);
                    *(u32x4*)(rowp + bj * HALF) = w; } }
    }
};
struct EpiSig {
    static constexpr bool PERM = true;
    bf16_t* O; const float* bias;
    __device__ __forceinline__ void operator()(const f32x4 (&acc)[2][2][4][2], const Unit& u, int wr, int wc, int fr, int fq) const {
        const int row0 = u.pm * BM + wr * 64 + fr; const int col0 = u.pn * BM + wc * 32 + 8 * fq;
        f32x4 bv[2][2];
#pragma unroll
        for (int bj = 0; bj < 2; ++bj)
#pragma unroll
            for (int n = 0; n < 2; ++n) bv[bj][n] = *(const f32x4*)(bias + col0 + bj * HALF + 4 * n);
#pragma unroll
        for (int ai = 0; ai < 2; ++ai)
#pragma unroll
            for (int m = 0; m < 4; ++m) { bf16_t* rowp = O + (size_t)(row0 + ai * HALF + m * 16) * 2048 + col0;
#pragma unroll
                for (int bj = 0; bj < 2; ++bj) { f32x4 v0 = acc[ai][bj][m][0] + bv[bj][0], v1 = acc[ai][bj][m][1] + bv[bj][1];
#pragma unroll
                    for (int j = 0; j < 4; ++j) { v0[j] = sigmoidf_(v0[j]); v1[j] = sigmoidf_(v1[j]); }
                    u32x4 w; w.x = cvt_pk_bf16(v0[0], v0[1]); w.y = cvt_pk_bf16(v0[2], v0[3]); w.z = cvt_pk_bf16(v1[0], v1[1]); w.w = cvt_pk_bf16(v1[2], v1[3]);
                    *(u32x4*)(rowp + bj * HALF) = w; } }
    }
};
struct EpiPool {
    static constexpr bool PERM = true;
    bf16_t* GB; const float* scale;
    __device__ __forceinline__ void operator()(const f32x4 (&acc)[2][2][4][2], const Unit& u, int wr, int wc, int fr, int fq) const {
        const int row0 = u.pm * BM + wr * 64 + fr; const int col0 = u.pn * BM + wc * 32 + 8 * fq;
        f32x4 sv[2][2];
#pragma unroll
        for (int bj = 0; bj < 2; ++bj)
#pragma unroll
            for (int n = 0; n < 2; ++n) sv[bj][n] = *(const f32x4*)(scale + col0 + bj * HALF + 4 * n);
#pragma unroll
        for (int ai = 0; ai < 2; ++ai)
#pragma unroll
            for (int m = 0; m < 4; ++m) { bf16_t* rowp = GB + (size_t)(row0 + ai * HALF + m * 16) * 1024 + col0;
#pragma unroll
                for (int bj = 0; bj < 2; ++bj) { const u32x4 gw = *(const u32x4*)(rowp + bj * HALF);
                    f32x4 v0 = acc[ai][bj][m][0] * sv[bj][0], v1 = acc[ai][bj][m][1] * sv[bj][1];
                    v0[0] *= siluf_(bf_lo(gw.x)); v0[1] *= siluf_(bf_hi(gw.x)); v0[2] *= siluf_(bf_lo(gw.y)); v0[3] *= siluf_(bf_hi(gw.y));
                    v1[0] *= siluf_(bf_lo(gw.z)); v1[1] *= siluf_(bf_hi(gw.z)); v1[2] *= siluf_(bf_lo(gw.w)); v1[3] *= siluf_(bf_hi(gw.w));
                    u32x4 w; w.x = cvt_pk_bf16(v0[0], v0[1]); w.y = cvt_pk_bf16(v0[2], v0[3]); w.z = cvt_pk_bf16(v1[0], v1[1]); w.w = cvt_pk_bf16(v1[2], v1[3]);
                    *(u32x4*)(rowp + bj * HALF) = w; } }
    }
};
struct EpiProj {
    static constexpr bool PERM = true;
    const bf16_t* MG; bf16_t* O;
    __device__ __forceinline__ void operator()(f32x4 (&acc)[2][2][4][2], const Unit& u, int wr, int wc, int fr, int fq) const {
        const int row0 = u.pm * BM + wr * 64 + fr; const int col0 = u.pn * BM + wc * 32 + 8 * fq;
        if (u.kind == 0) {
#pragma unroll
            for (int ai = 0; ai < 2; ++ai)
#pragma unroll
                for (int m = 0; m < 4; ++m) { const bf16_t* gp = MG + (size_t)(row0 + ai * HALF + m * 16) * 2048 + col0;
#pragma unroll
                    for (int bj = 0; bj < 2; ++bj) { const u32x4 ga = *(const u32x4*)(gp + bj * HALF), gb = *(const u32x4*)(gp + 1024 + bj * HALF);
                        f32x4& v0 = acc[ai][bj][m][0]; f32x4& v1 = acc[ai][bj][m][1];
                        v0[0] *= bf_lo(ga.x) * __builtin_amdgcn_rcpf(bf_lo(gb.x)); v0[1] *= bf_hi(ga.x) * __builtin_amdgcn_rcpf(bf_hi(gb.x));
                        v0[2] *= bf_lo(ga.y) * __builtin_amdgcn_rcpf(bf_lo(gb.y)); v0[3] *= bf_hi(ga.y) * __builtin_amdgcn_rcpf(bf_hi(gb.y));
                        v1[0] *= bf_lo(ga.z) * __builtin_amdgcn_rcpf(bf_lo(gb.z)); v1[1] *= bf_hi(ga.z) * __builtin_amdgcn_rcpf(bf_hi(gb.z));
                        v1[2] *= bf_lo(ga.w) * __builtin_amdgcn_rcpf(bf_lo(gb.w)); v1[3] *= bf_hi(ga.w) * __builtin_amdgcn_rcpf(bf_hi(gb.w)); } }
        } else {
#pragma unroll
            for (int ai = 0; ai < 2; ++ai)
#pragma unroll
                for (int m = 0; m < 4; ++m) { const size_t r = (size_t)(row0 + ai * HALF + m * 16); const bf16_t* gp = MG + r * 2048 + 1024 + col0; bf16_t* rowp = O + r * 1024 + col0;
#pragma unroll
                    for (int bj = 0; bj < 2; ++bj) { const u32x4 gb = *(const u32x4*)(gp + bj * HALF);
                        const f32x4 v0 = acc[ai][bj][m][0], v1 = acc[ai][bj][m][1];
                        u32x4 w; w.x = cvt_pk_bf16(v0[0] * bf_lo(gb.x), v0[1] * bf_hi(gb.x)); w.y = cvt_pk_bf16(v0[2] * bf_lo(gb.y), v0[3] * bf_hi(gb.y));
                        w.z = cvt_pk_bf16(v1[0] * bf_lo(gb.z), v1[1] * bf_hi(gb.z)); w.w = cvt_pk_bf16(v1[2] * bf_lo(gb.w), v1[3] * bf_hi(gb.w));
                        *(u32x4*)(rowp + bj * HALF) = w; } }
        }
    }
};
struct EpiOut {
    static constexpr bool PERM = false;
    const float* xres; float* out;
    __device__ __forceinline__ void operator()(const f32x4 (&acc)[2][2][4][2], const Unit& u, int wr, int wc, int fr, int fq) const {
        const int row0 = u.pm * BM + wr * 64 + fr, col0 = u.pn * BM + wc * 32 + 4 * fq;
#pragma unroll
        for (int ai = 0; ai < 2; ++ai)
#pragma unroll
            for (int m = 0; m < 4; ++m) { const size_t off = (size_t)(row0 + ai * HALF + m * 16) * 1024 + col0;
#pragma unroll
                for (int bj = 0; bj < 2; ++bj)
#pragma unroll
                    for (int n = 0; n < 2; ++n) { const f32x4 xs = *(const f32x4*)(xres + off + bj * HALF + n * 16);
                        *(f32x4*)(out + off + bj * HALF + n * 16) = xs * DN_ALPHA + acc[ai][bj][m][n]; } }
    }
};
}

struct Args { const float* in[13]; float* out; unsigned char* ws; int ph_lo, ph_hi; };
struct Ctx { int tid, lane, wave, G, bid; };

__device__ __forceinline__ float wave_sum(float v) {
#pragma unroll
    for (int o = 1; o < 64; o <<= 1) v += __shfl_xor(v, o);
    return v;
}

__device__ __forceinline__ void transpose_item(const float* W, int ld_src, int col0, int nblk, int K, bf16_t* WT, int row_off, LAS float* scr, int item, int lane) {
    const int kb = item / nblk, nb = item % nblk, k0 = 64 * kb, n0 = 32 * nb;
#pragma unroll 8
    for (int i = 0; i < 32; ++i) { const int kk = 2 * i + (lane >> 5); scr[kk * 33 + (lane & 31)] = W[(size_t)(k0 + kk) * ld_src + col0 + n0 + (lane & 31)]; }
    asm volatile("s_waitcnt lgkmcnt(0)" ::: "memory");
    const int c = lane & 7;
#pragma unroll
    for (int j = 0; j < 4; ++j) { const int n = (lane >> 3) + 8 * j; const LAS float* s = scr + (8 * c) * 33 + n;
        u32x4 o; o.x = cvt_pk_bf16(s[0 * 33], s[1 * 33]); o.y = cvt_pk_bf16(s[2 * 33], s[3 * 33]); o.z = cvt_pk_bf16(s[4 * 33], s[5 * 33]); o.w = cvt_pk_bf16(s[6 * 33], s[7 * 33]);
        *(u32x4*)(WT + (size_t)(row_off + n0 + n) * K + k0 + 8 * c) = o; }
    asm volatile("s_waitcnt lgkmcnt(0)" ::: "memory");
}
__device__ __forceinline__ void convert_weights(const Args& a, const Ctx& cx, LAS unsigned char* lds, int l) {
    LAS float* scr = (LAS float*)(lds + cx.wave * 8448);
    const int gw = cx.bid * 8 + cx.wave, NGW = cx.G * 8;
    unsigned char* ws = a.ws;
    const float* w_in = a.in[1] + (size_t)l * 1024 * INC;
    const float* w_pa = a.in[8] + (size_t)l * 1024 * 1024; const float* w_pb = a.in[9] + (size_t)l * 1024 * 1024; const float* w_o = a.in[10] + (size_t)l * 1024 * 1024;
    const float* w_g = a.in[5] + (size_t)l * 4 * 256 * 256;
    constexpr int I_A = 16 * 96, I_GB = 16 * 32, I_PIN = 16 * 32, I_M = 16 * 64, I_P = 16 * 32, I_G = 4 * 8;
    constexpr int NIT = I_A + I_GB + I_PIN + I_M + 3 * I_P + 4 * I_G;
    for (int it = gw; it < NIT; it += NGW) {
        int r = it;
        if (r < I_A) { transpose_item(w_in, INC, 0, 96, 1024, (bf16_t*)(ws + WS_W1A), 0, scr, r, cx.lane); continue; } r -= I_A;
        if (r < I_GB) { transpose_item(w_in, INC, 4112, 32, 1024, (bf16_t*)(ws + WS_W1A), 3072, scr, r, cx.lane); continue; } r -= I_GB;
        if (r < I_PIN) { transpose_item(w_in, INC, 3088, 32, 1024, (bf16_t*)(ws + WS_W1A), 4096, scr, r, cx.lane); continue; } r -= I_PIN;
        if (r < I_M) { transpose_item(w_in, INC, 5136, 64, 1024, (bf16_t*)(ws + WS_WM), 0, scr, r, cx.lane); continue; } r -= I_M;
        if (r < I_P) { transpose_item(w_pa, 1024, 0, 32, 1024, (bf16_t*)(ws + WS_WA), 0, scr, r, cx.lane); continue; } r -= I_P;
        if (r < I_P) { transpose_item(w_pb, 1024, 0, 32, 1024, (bf16_t*)(ws + WS_WB), 0, scr, r, cx.lane); continue; } r -= I_P;
        if (r < I_P) { transpose_item(w_o, 1024, 0, 32, 1024, (bf16_t*)(ws + WS_WO), 0, scr, r, cx.lane); continue; } r -= I_P;
        const int gi = r / I_G; r -= gi * I_G;
        transpose_item(w_g + (size_t)gi * 65536, 256, 0, 8, 256, (bf16_t*)(ws + WS_WG) + (size_t)gi * 65536, 0, scr, r, cx.lane);
    }
}

__device__ __forceinline__ void row_phase(const Ctx& cx, LAS unsigned char* lds, const float* src, float* dst, bf16_t* xbf, float* AL, const float* walpha  ,
                                          const float* lng, const float* lnb, bool do_ln) {
    LAS float* WT = (LAS float*)lds;
    if (AL) {
        for (int idx = cx.tid; idx < 16384; idx += 512) { const int k = idx >> 4, c = idx & 15; WT[c * 1028 + k] = walpha[(size_t)k * INC + c]; }
    }
    __syncthreads();
    const int gw = cx.bid * 8 + cx.wave, NGW = cx.G * 8, lane = cx.lane;
    f32x4 gj[4], bj[4];
#pragma unroll
    for (int j = 0; j < 4; ++j) { gj[j] = (f32x4){1.f, 1.f, 1.f, 1.f}; bj[j] = (f32x4){0.f, 0.f, 0.f, 0.f}; }
    if (do_ln) {
#pragma unroll
        for (int j = 0; j < 4; ++j) { gj[j] = *(const f32x4*)(lng + 256 * j + 4 * lane); bj[j] = *(const f32x4*)(lnb + 256 * j + 4 * lane); }
    }
    for (int rg = gw; rg < MTOK / 4; rg += NGW) {
        const size_t m0 = (size_t)rg * 4;
        f32x4 v[4][4];
#pragma unroll
        for (int r = 0; r < 4; ++r)
#pragma unroll
            for (int j = 0; j < 4; ++j) v[r][j] = *(const f32x4*)(src + (m0 + r) * 1024 + 256 * j + 4 * lane);
        if (do_ln) {
#pragma unroll
            for (int r = 0; r < 4; ++r) {
                float s = 0.f;
#pragma unroll
                for (int j = 0; j < 4; ++j) s += (v[r][j][0] + v[r][j][1]) + (v[r][j][2] + v[r][j][3]);
                const float mean = wave_sum(s) * (1.f / 1024.f); float s2 = 0.f;
#pragma unroll
                for (int j = 0; j < 4; ++j) { v[r][j] = v[r][j] - mean; s2 += (v[r][j][0] * v[r][j][0] + v[r][j][1] * v[r][j][1]) + (v[r][j][2] * v[r][j][2] + v[r][j][3] * v[r][j][3]); }
                const float rstd = 1.0f / sqrtf(wave_sum(s2) * (1.f / 1024.f) + LN_EPS);
#pragma unroll
                for (int j = 0; j < 4; ++j) { v[r][j] = v[r][j] * rstd * gj[j] + bj[j]; *(f32x4*)(dst + (m0 + r) * 1024 + 256 * j + 4 * lane) = v[r][j]; }
            }
        }
        if (xbf) {
#pragma unroll
            for (int r = 0; r < 4; ++r)
#pragma unroll
                for (int j = 0; j < 4; ++j) { u32x2 w; w.x = cvt_pk_bf16(v[r][j][0], v[r][j][1]); w.y = cvt_pk_bf16(v[r][j][2], v[r][j][3]);
                    *(u32x2*)(xbf + (m0 + r) * 1024 + 256 * j + 4 * lane) = w; }
        }
        if (AL) {
            float acc[64];
#pragma unroll
            for (int i = 0; i < 64; ++i) acc[i] = 0.f;
#pragma unroll
            for (int c = 0; c < 16; ++c)
#pragma unroll
                for (int j = 0; j < 4; ++j) { const f32x4 w = *(const LAS f32x4*)(WT + c * 1028 + 256 * j + 4 * lane);
#pragma unroll
                    for (int r = 0; r < 4; ++r) acc[r * 16 + c] += (v[r][j][0] * w[0] + v[r][j][1] * w[1]) + (v[r][j][2] * w[2] + v[r][j][3] * w[3]); }
#pragma unroll
            for (int h = 32; h >= 1; h >>= 1) {
                const bool up = (lane & h) != 0;
#pragma unroll
                for (int i = 0; i < h; ++i) { const float keep = up ? acc[i + h] : acc[i]; const float send = up ? acc[i] : acc[i + h]; acc[i] = keep + __shfl_xor(send, h); }
            }
            AL[m0 * 16 + lane] = acc[0];
        }
    }
}

__device__ __forceinline__ void unpack8(const u32x4 w, float (&f)[8]) { f[0] = bf_lo(w.x); f[1] = bf_hi(w.x); f[2] = bf_lo(w.y); f[3] = bf_hi(w.y); f[4] = bf_lo(w.z); f[5] = bf_hi(w.z); f[6] = bf_lo(w.w); f[7] = bf_hi(w.w); }
__device__ __forceinline__ void pool_phase(const Ctx& cx, const bf16_t* pin, bf16_t* pooled) {
    const int NT = (MTOK / 32) * 128;
    for (int q = cx.bid * 512 + cx.tid; q < NT; q += cx.G * 512) {
        const int cg8 = q & 127, seg = q >> 7; const int g = cg8 >> 5; const int w = 2 << g;
        const int t0 = seg * 32, pos0 = t0 & (SEQ - 1);
        const bf16_t* base = pin + (size_t)t0 * 1024 + cg8 * 8;
        float sum[8];
#pragma unroll
        for (int e = 0; e < 8; ++e) sum[e] = 0.f;
        for (int j = 1; j < w; ++j) if (pos0 - j >= 0) { float f[8]; unpack8(*(const u32x4*)(base - (size_t)j * 1024), f);
#pragma unroll
            for (int e = 0; e < 8; ++e) sum[e] += f[e]; }
        for (int i = 0; i < 32; ++i) {
            const int pos = pos0 + i; float x[8]; unpack8(*(const u32x4*)(base + (size_t)i * 1024), x);
#pragma unroll
            for (int e = 0; e < 8; ++e) sum[e] += x[e];
            if (i > 0 && pos - w >= 0) { float f[8]; unpack8(*(const u32x4*)(base + (size_t)(i - w) * 1024), f);
#pragma unroll
                for (int e = 0; e < 8; ++e) sum[e] -= f[e]; }
            const int cnt = (pos + 1 < w) ? (pos + 1) : w; const float inv = 1.0f / (float)cnt;
            u32x4 o; o.x = cvt_pk_bf16(sum[0] * inv - x[0], sum[1] * inv - x[1]); o.y = cvt_pk_bf16(sum[2] * inv - x[2], sum[3] * inv - x[3]);
            o.z = cvt_pk_bf16(sum[4] * inv - x[4], sum[5] * inv - x[5]); o.w = cvt_pk_bf16(sum[6] * inv - x[6], sum[7] * inv - x[7]);
            *(u32x4*)(pooled + (size_t)(t0 + i) * 1024 + cg8 * 8) = o;
        }
    }
}

constexpr int L_AL = 0, L_GL = 4096, L_RS = 6144, L_KT = 8192  , L_VT1 = 26624  ;
constexpr int L_QA = 8192, L_KA = 25600, L_QB = 43008, L_KB = 60416, L_VT3 = 77824, L_P = 114688;

__device__ __forceinline__ void gla_G(LAS unsigned char* lds, const float* wup  , float bias, int d, int tg, float (&g)[16], float& total) {
    const LAS float* AL_s = (const LAS float*)(lds + L_AL); LAS float* GL_s = (LAS float*)(lds + L_GL);
    float w[16];
#pragma unroll
    for (int r = 0; r < 16; ++r) w[r] = wup[r * 512];
    float run = 0.f;
#pragma unroll
    for (int tt = 0; tt < 16; ++tt) {
        const LAS f32x4* ap = (const LAS f32x4*)(AL_s + (tg * 16 + tt) * 16);
        const f32x4 a0 = ap[0], a1 = ap[1], a2 = ap[2], a3 = ap[3];
        float z = bias;
        z += a0[0] * w[0]; z += a0[1] * w[1]; z += a0[2] * w[2]; z += a0[3] * w[3];
        z += a1[0] * w[4]; z += a1[1] * w[5]; z += a1[2] * w[6]; z += a1[3] * w[7];
        z += a2[0] * w[8]; z += a2[1] * w[9]; z += a2[2] * w[10]; z += a2[3] * w[11];
        z += a3[0] * w[12]; z += a3[1] * w[13]; z += a3[2] * w[14]; z += a3[3] * w[15];
        const float ls = fminf(z, 0.f) - __logf(1.0f + __expf(-fabsf(z)));
        run += ls * (1.0f / 16.0f);
        g[tt] = run;
    }
    GL_s[tg * 128 + d] = run;
    __syncthreads();
    const float p0 = GL_s[d], p1 = GL_s[128 + d], p2 = GL_s[256 + d], p3 = GL_s[384 + d];
    const float prefix = (tg > 0 ? p0 : 0.f) + (tg > 1 ? p1 : 0.f) + (tg > 2 ? p2 : 0.f);
    total = (p0 + p1) + (p2 + p3);
#pragma unroll
    for (int tt = 0; tt < 16; ++tt) g[tt] += prefix;
}
__device__ __forceinline__ void gla_stage(const Ctx& cx, LAS unsigned char* lds, int vt_off, const float* AL, const bf16_t* Vb, int row0, int h) {
    if (cx.tid < 256) ((LAS f32x4*)(lds + L_AL))[cx.tid] = *(const f32x4*)(AL + (size_t)row0 * 16 + cx.tid * 4);
    LAS unsigned* VT32 = (LAS unsigned*)(lds + vt_off);
#pragma unroll
    for (int i = 0; i < 2; ++i) {
        const int q = cx.tid + 512 * i, tp = q & 31, ng = q >> 5;
        const bf16_t* vp = Vb + (size_t)(row0 + 2 * tp) * 1024 + h * 256 + ng * 8;
        const u32x4 r0 = *(const u32x4*)vp, r1 = *(const u32x4*)(vp + 1024);
#pragma unroll
        for (int j = 0; j < 4; ++j) {
            VT32[(ng * 8 + 2 * j) * 36 + tp] = (r0[j] & 0xffffu) | (r1[j] << 16);
            VT32[(ng * 8 + 2 * j + 1) * 36 + tp] = (r0[j] >> 16) | (r1[j] & 0xffff0000u);
        }
    }
}

__device__ __forceinline__ void gla_p1(const Args& a, const Ctx& cx, LAS unsigned char* lds, int l) {
    unsigned char* ws = a.ws;
    const float* AL = (const float*)(ws + WS_AL); const bf16_t* QKb = (const bf16_t*)(ws + WS_QK); const bf16_t* Vb = (const bf16_t*)(ws + WS_V);
    unsigned char* US = ws + WS_US; float* DF = (float*)(ws + WS_DF);
    const float* Wup = a.in[2] + (size_t)l * 16 * 512; const float* balpha = a.in[3] + (size_t)l * 512;
    const int tid = cx.tid, lane = cx.lane, wv = cx.wave, fr = lane & 15, fq = lane >> 4;
    for (int it = cx.bid; it < 2048; it += cx.G) {
        const int b = it >> 9, c = (it >> 2) & 127, h = it & 3; const int row0 = b * SEQ + c * 64; const int slot = (b * 4 + h) * NCH + c;
        __syncthreads();
        gla_stage(cx, lds, L_VT1, AL, Vb, row0, h);
        __syncthreads();
        const int d = tid & 127, tg = tid >> 7;
        float g[16], total;
        gla_G(lds, Wup + h * 128 + d, balpha[h * 128 + d], d, tg, g, total);
        const bf16_t* kp = QKb + (size_t)(row0 + tg * 16) * 1024 + 512 + h * 128 + d;
        unsigned pk[8];
#pragma unroll
        for (int tt = 0; tt < 16; tt += 2) { const float k0 = bf2f(kp[(size_t)tt * 1024]) * __expf(total - g[tt]), k1 = bf2f(kp[(size_t)(tt + 1) * 1024]) * __expf(total - g[tt + 1]); pk[tt >> 1] = cvt_pk_bf16(k0, k1); }
        LAS u32x4* kt = (LAS u32x4*)(lds + L_KT + d * 144 + tg * 32);
        kt[0] = (u32x4){pk[0], pk[1], pk[2], pk[3]}; kt[1] = (u32x4){pk[4], pk[5], pk[6], pk[7]};
        if (tg == 0) DF[(size_t)slot * 128 + d] = __expf(total);
        __syncthreads();
        f32x4 acc[8][2];
#pragma unroll
        for (int dt = 0; dt < 8; ++dt) { acc[dt][0] = (f32x4){0.f, 0.f, 0.f, 0.f}; acc[dt][1] = (f32x4){0.f, 0.f, 0.f, 0.f}; }
#pragma unroll
        for (int ks = 0; ks < 2; ++ks) {
            bf16x8 bfr[2];
#pragma unroll
            for (int nn = 0; nn < 2; ++nn) bfr[nn] = *(const LAS bf16x8*)(lds + L_VT1 + ((2 * wv + nn) * 16 + fr) * 144 + ks * 64 + fq * 16);
#pragma unroll
            for (int dt = 0; dt < 8; ++dt) { const bf16x8 af = *(const LAS bf16x8*)(lds + L_KT + (dt * 16 + fr) * 144 + ks * 64 + fq * 16);
#pragma unroll
                for (int nn = 0; nn < 2; ++nn) acc[dt][nn] = __builtin_amdgcn_mfma_f32_16x16x32_bf16(af, bfr[nn], acc[dt][nn], 0, 0, 0); }
        }
        unsigned char* up = US + (size_t)slot * 65536;
#pragma unroll
        for (int dt = 0; dt < 8; ++dt)
#pragma unroll
            for (int nn = 0; nn < 2; ++nn) { u32x2 o; o.x = cvt_pk_bf16(acc[dt][nn][0], acc[dt][nn][1]); o.y = cvt_pk_bf16(acc[dt][nn][2], acc[dt][nn][3]);
                *(u32x2*)(up + ((2 * wv + nn) * 16 + fr) * 256 + (dt * 16 + fq * 4) * 2) = o; }
    }
}
__device__ __forceinline__ void gla_p2(const Args& a, const Ctx& cx) {
    unsigned char* US = a.ws + WS_US; const float* DF = (const float*)(a.ws + WS_DF);
    for (int q = cx.bid * 512 + cx.tid; q < 16 * 8192; q += cx.G * 512) {
        const int bh = q >> 13, within = q & 8191; const int dq = within & 31;
        unsigned char* p = US + (size_t)bh * NCH * 65536 + (size_t)within * 8;
        const float* dfp = DF + (size_t)bh * NCH * 128 + dq * 4;
        float s0 = 0.f, s1 = 0.f, s2 = 0.f, s3 = 0.f;
        for (int cb = 0; cb < NCH; cb += 16) {
            u32x2 u[16]; f32x4 df[16];
#pragma unroll
            for (int i = 0; i < 16; ++i) { u[i] = *(const u32x2*)(p + (size_t)(cb + i) * 65536); df[i] = *(const f32x4*)(dfp + (size_t)(cb + i) * 128); }
#pragma unroll
            for (int i = 0; i < 16; ++i) {
                s0 = df[i][0] * s0 + bf_lo(u[i].x); s1 = df[i][1] * s1 + bf_hi(u[i].x); s2 = df[i][2] * s2 + bf_lo(u[i].y); s3 = df[i][3] * s3 + bf_hi(u[i].y);
                u32x2 o; o.x = cvt_pk_bf16(s0, s1); o.y = cvt_pk_bf16(s2, s3);
                *(u32x2*)(p + (size_t)(cb + i) * 65536) = o;
            }
        }
    }
}
__device__ __forceinline__ void gla_p3(const Args& a, const Ctx& cx, LAS unsigned char* lds, int l) {
    unsigned char* ws = a.ws;
    const float* AL = (const float*)(ws + WS_AL); const bf16_t* QKb = (const bf16_t*)(ws + WS_QK); const bf16_t* Vb = (const bf16_t*)(ws + WS_V);
    const unsigned char* US = ws + WS_US; bf16_t* GA = (bf16_t*)(ws + WS_GA);
    const float* Wup = a.in[2] + (size_t)l * 16 * 512; const float* balpha = a.in[3] + (size_t)l * 512; const float* gnorm = a.in[4] + (size_t)l * 1024;
    const int tid = cx.tid, lane = cx.lane, wv = cx.wave, fr = lane & 15, fq = lane >> 4;
    for (int it = cx.bid; it < 2048; it += cx.G) {
        const int b = it >> 9, c = (it >> 2) & 127, h = it & 3; const int row0 = b * SEQ + c * 64; const int slot = (b * 4 + h) * NCH + c;
        __syncthreads();
        gla_stage(cx, lds, L_VT3, AL, Vb, row0, h);
        __syncthreads();
        const int d = tid & 127, tg = tid >> 7;
        float g[16], total;
        gla_G(lds, Wup + h * 128 + d, balpha[h * 128 + d], d, tg, g, total);
        {
            const bf16_t* qp = QKb + (size_t)(row0 + tg * 16) * 1024 + h * 128 + d; const bf16_t* kp = qp + 512;
            LAS bf16_t* QA = (LAS bf16_t*)(lds + L_QA); LAS bf16_t* KA = (LAS bf16_t*)(lds + L_KA); LAS bf16_t* QB = (LAS bf16_t*)(lds + L_QB); LAS bf16_t* KB = (LAS bf16_t*)(lds + L_KB);
#pragma unroll
            for (int tt = 0; tt < 16; ++tt) {
                const float qv = bf2f(qp[(size_t)tt * 1024]) * QSCALE, kv = bf2f(kp[(size_t)tt * 1024]); const float eg = __expf(g[tt]), ei = __expf(-g[tt]);
                const int o = (tg * 16 + tt) * 136 + d;
                const unsigned w0 = cvt_pk_bf16(qv * eg, kv * ei), w1 = cvt_pk_bf16(qv * ei, kv * eg);
                QA[o] = (bf16_t)(w0 & 0xffffu); KA[o] = (bf16_t)(w0 >> 16); QB[o] = (bf16_t)(w1 & 0xffffu); KB[o] = (bf16_t)(w1 >> 16);
            }
        }
        __syncthreads();
#pragma unroll
        for (int x = 0; x < 2; ++x) {
            const int tile = 2 * wv + x, ti = tile >> 2, si = tile & 3;
            f32x4 a1 = (f32x4){0.f, 0.f, 0.f, 0.f}, a2 = (f32x4){0.f, 0.f, 0.f, 0.f};
            if (ti >= si) {
#pragma unroll
                for (int ks = 0; ks < 4; ++ks) { const bf16x8 af = *(const LAS bf16x8*)(lds + L_KA + (si * 16 + fr) * 272 + ks * 64 + fq * 16), bfv = *(const LAS bf16x8*)(lds + L_QA + (ti * 16 + fr) * 272 + ks * 64 + fq * 16);
                    a1 = __builtin_amdgcn_mfma_f32_16x16x32_bf16(af, bfv, a1, 0, 0, 0); }
            }
            if (ti <= si) {
#pragma unroll
                for (int ks = 0; ks < 4; ++ks) { const bf16x8 af = *(const LAS bf16x8*)(lds + L_KB + (si * 16 + fr) * 272 + ks * 64 + fq * 16), bfv = *(const LAS bf16x8*)(lds + L_QB + (ti * 16 + fr) * 272 + ks * 64 + fq * 16);
                    a2 = __builtin_amdgcn_mfma_f32_16x16x32_bf16(af, bfv, a2, 0, 0, 0); }
            }
            const int t = ti * 16 + fr, s0 = si * 16 + fq * 4;
            const float p0 = (t >= s0) ? a1[0] : a2[0], p1 = (t >= s0 + 1) ? a1[1] : a2[1], p2 = (t >= s0 + 2) ? a1[2] : a2[2], p3 = (t >= s0 + 3) ? a1[3] : a2[3];
            u32x2 o; o.x = cvt_pk_bf16(p0, p1); o.y = cvt_pk_bf16(p2, p3);
            *(LAS u32x2*)(lds + L_P + t * 144 + s0 * 2) = o;
        }
        __syncthreads();
        const int ti = wv & 3, nh = wv >> 2;
        f32x4 acc[8];
#pragma unroll
        for (int i = 0; i < 8; ++i) acc[i] = (f32x4){0.f, 0.f, 0.f, 0.f};
        bf16x8 bP[2], bQ[4];
#pragma unroll
        for (int ks = 0; ks < 2; ++ks) bP[ks] = *(const LAS bf16x8*)(lds + L_P + (ti * 16 + fr) * 144 + ks * 64 + fq * 16);
#pragma unroll
        for (int ks = 0; ks < 4; ++ks) bQ[ks] = *(const LAS bf16x8*)(lds + L_QA + (ti * 16 + fr) * 272 + ks * 64 + fq * 16);
        const unsigned char* sp = US + (size_t)(c > 0 ? slot - 1 : slot) * 65536;
#pragma unroll
        for (int nt = 0; nt < 8; ++nt) {
            const int n = (nh * 8 + nt) * 16 + fr;
#pragma unroll
            for (int ks = 0; ks < 2; ++ks) { const bf16x8 af = *(const LAS bf16x8*)(lds + L_VT3 + n * 144 + ks * 64 + fq * 16); acc[nt] = __builtin_amdgcn_mfma_f32_16x16x32_bf16(af, bP[ks], acc[nt], 0, 0, 0); }
            if (c > 0) {
#pragma unroll
                for (int ks = 0; ks < 4; ++ks) { const bf16x8 af = *(const bf16x8*)(sp + n * 256 + ks * 64 + fq * 16); acc[nt] = __builtin_amdgcn_mfma_f32_16x16x32_bf16(af, bQ[ks], acc[nt], 0, 0, 0); }
            }
        }
        float ss = 0.f;
#pragma unroll
        for (int nt = 0; nt < 8; ++nt) ss += (acc[nt][0] * acc[nt][0] + acc[nt][1] * acc[nt][1]) + (acc[nt][2] * acc[nt][2] + acc[nt][3] * acc[nt][3]);
        ss += __shfl_xor(ss, 16); ss += __shfl_xor(ss, 32);
        LAS float* RS = (LAS float*)(lds + L_RS);
        const int t = ti * 16 + fr;
        if (fq == 0) RS[t * 2 + nh] = ss;
        __syncthreads();
        const float rinv = 1.0f / sqrtf((RS[t * 2] + RS[t * 2 + 1]) * (1.0f / 256.0f) + LN_EPS);
        bf16_t* gp = GA + (size_t)(row0 + t) * 1024 + h * 256;
#pragma unroll
        for (int nt = 0; nt < 8; ++nt) {
            const int n0 = (nh * 8 + nt) * 16 + fq * 4;
            const f32x4 gn = *(const f32x4*)(gnorm + h * 256 + n0);
            const u32x2 gw = *(const u32x2*)(gp + n0);
            const float y0 = acc[nt][0] * rinv * gn[0] * siluf_(bf_lo(gw.x)), y1 = acc[nt][1] * rinv * gn[1] * siluf_(bf_hi(gw.x));
            const float y2 = acc[nt][2] * rinv * gn[2] * siluf_(bf_lo(gw.y)), y3 = acc[nt][3] * rinv * gn[3] * siluf_(bf_hi(gw.y));
            u32x2 o; o.x = cvt_pk_bf16(y0, y1); o.y = cvt_pk_bf16(y2, y3);
            *(u32x2*)(gp + n0) = o;
        }
    }
}

constexpr int PH_PER_LAYER = 10, N_PHASES = 1 + DEPTH * PH_PER_LAYER;

__device__ __forceinline__ void run_phase(const Args& a, const Ctx& cx, LAS unsigned char* lds, int ph) {
    unsigned char* ws = a.ws;
    if (ph == 0) {
        convert_weights(a, cx, lds, 0);
        __syncthreads();
        row_phase(cx, lds, a.in[0], nullptr, (bf16_t*)(ws + WS_X), (float*)(ws + WS_AL), a.in[1] + 3072, nullptr, nullptr, false);
        return;
    }
    const int l = (ph - 1) / PH_PER_LAYER; int sp = (ph - 1) % PH_PER_LAYER;
#ifdef ONLY_SP
    sp = ONLY_SP;
#endif
    pg8::Sched S; S.G = cx.G; S.c = cx.bid; S.chain = 1; S.A1 = nullptr; S.B1 = nullptr; S.a_pn = 0; S.nM = MTOK / 256;
    switch (sp) {
    case 0: {
        S.A0 = (const char*)(ws + WS_X); S.B0 = (const char*)(ws + WS_W1A); S.a_pm = (size_t)256 * 1024 * 2; S.b_pn = (size_t)256 * 1024 * 2; S.nN = 20; S.nwg = S.nM * S.nN;
        pg8::EpiSplit E{(bf16_t*)(ws + WS_QK)};
        pg8::gemm_phase<pg8::EpiSplit>(lds, cx.tid, pg8::Gemm{1024, 1024, 1024}, S, E);
    } break;
    case 1: pool_phase(cx, (const bf16_t*)(ws + WS_PIN), (bf16_t*)(ws + WS_F1)); break;
    case 2: {
        S.A0 = (const char*)(ws + WS_F1); S.B0 = (const char*)(ws + WS_WG); S.a_pm = (size_t)256 * 1024 * 2; S.a_pn = 256 * 2; S.b_pn = (size_t)65536 * 2; S.nN = 4; S.nwg = S.nM * S.nN;
        pg8::EpiPool E{(bf16_t*)(ws + WS_GB), a.in[6] + (size_t)l * 1024};
        pg8::gemm_phase<pg8::EpiPool>(lds, cx.tid, pg8::Gemm{1024, 256, 256}, S, E);
    } break;
    case 3: gla_p1(a, cx, lds, l); break;
    case 4: gla_p2(a, cx); break;
    case 5: gla_p3(a, cx, lds, l); break;
    case 6: {
        S.A0 = (const char*)(ws + WS_X); S.B0 = (const char*)(ws + WS_WM); S.a_pm = (size_t)256 * 1024 * 2; S.b_pn = (size_t)256 * 1024 * 2; S.nN = 8; S.nwg = S.nM * S.nN;
        pg8::EpiSig E{(bf16_t*)(ws + WS_MG), a.in[7] + (size_t)l * 2048};
        pg8::gemm_phase<pg8::EpiSig>(lds, cx.tid, pg8::Gemm{1024, 1024, 1024}, S, E);
    } break;
    case 7: {
        S.chain = 2; S.A0 = (const char*)(ws + WS_GA); S.A1 = (const char*)(ws + WS_GB); S.B0 = (const char*)(ws + WS_WA); S.B1 = (const char*)(ws + WS_WB);
        S.a_pm = (size_t)256 * 1024 * 2; S.b_pn = (size_t)256 * 1024 * 2; S.nN = 4; S.nwg = S.nM * S.nN;
        pg8::EpiProj E{(const bf16_t*)(ws + WS_MG), (bf16_t*)(ws + WS_PIN)};
        pg8::gemm_phase<pg8::EpiProj>(lds, cx.tid, pg8::Gemm{1024, 1024, 1024}, S, E);
    } break;
    case 8: {
        S.A0 = (const char*)(ws + WS_PIN); S.B0 = (const char*)(ws + WS_WO); S.a_pm = (size_t)256 * 1024 * 2; S.b_pn = (size_t)256 * 1024 * 2; S.nN = 4; S.nwg = S.nM * S.nN;
        pg8::EpiOut E{l == 0 ? a.in[0] : a.out, a.out};
        pg8::gemm_phase<pg8::EpiOut>(lds, cx.tid, pg8::Gemm{1024, 1024, 1024}, S, E);
    } break;
    default: {
        const bool more = (l + 1 < DEPTH);
        if (more) { convert_weights(a, cx, lds, l + 1); __syncthreads(); }
        row_phase(cx, lds, a.out, a.out, more ? (bf16_t*)(ws + WS_X) : nullptr, more ? (float*)(ws + WS_AL) : nullptr,
                  a.in[1] + (size_t)(more ? l + 1 : l) * 1024 * INC + 3072, a.in[11] + (size_t)l * 1024, a.in[12] + (size_t)l * 1024, true);
    } break;
    }
}

__global__ void __launch_bounds__(512, 2) mega_fwd(Args a) {
    extern __shared__ __attribute__((aligned(16))) unsigned char lds_raw[];
    LAS unsigned char* lds = (LAS unsigned char*)lds_raw;
    cg::grid_group grid = cg::this_grid();
    for (int ph = a.ph_lo; ph < a.ph_hi; ++ph) {
        if (ph > a.ph_lo) grid.sync();
        int tid = threadIdx.x; asm volatile("" : "+v"(tid));
        Ctx cx; cx.tid = tid; cx.lane = tid & 63; cx.wave = __builtin_amdgcn_readfirstlane(tid >> 6); cx.G = gridDim.x; cx.bid = blockIdx.x;
        Args b = a;
#pragma unroll
        for (int i = 0; i < 13; ++i) asm volatile("" : "+s"(b.in[i]));
        asm volatile("" : "+s"(b.out)); asm volatile("" : "+s"(b.ws));
        run_phase(b, cx, lds, ph);
    }
}

extern "C" void kernel_launch(void* const* d_in, const int* in_sizes, int n_in, void* d_out, int out_size, void* d_ws, size_t ws_size, hipStream_t stream) {
    static int grid = 0;
    if (grid == 0) {
        if (n_in != 13 || in_sizes[0] != MTOK * DM || out_size != MTOK * DM || ws_size < WS_END) {
            fprintf(stderr, "kernel_launch: unexpected shapes (n_in %d, in0 %d, out %d, ws %zu, need %zu); nothing launched\n", n_in, n_in > 0 ? in_sizes[0] : -1, out_size, ws_size, (size_t)WS_END); grid = -1; return; }
        int dev = 0, cus = 0, per_cu = 0;
        if (hipGetDevice(&dev) != hipSuccess || hipDeviceGetAttribute(&cus, hipDeviceAttributeMultiprocessorCount, dev) != hipSuccess) { grid = -1; return; }
        if (hipFuncSetAttribute((const void*)mega_fwd, hipFuncAttributeMaxDynamicSharedMemorySize, LDS_BYTES) != hipSuccess) { fprintf(stderr, "kernel_launch: hipFuncSetAttribute failed\n"); grid = -1; return; }
        if (hipOccupancyMaxActiveBlocksPerMultiprocessor(&per_cu, (const void*)mega_fwd, 512, LDS_BYTES) != hipSuccess || per_cu < 1) { fprintf(stderr, "kernel_launch: occupancy query says %d\n", per_cu); per_cu = 1; }
        (void)hipGetLastError();
        grid = cus;
    }
    if (grid < 0) return;
    Args a{};
    for (int i = 0; i < 13; ++i) a.in[i] = (const float*)d_in[i];
    a.out = (float*)d_out; a.ws = (unsigned char*)d_ws;
#if N_LAUNCH_MODE == 1
    for (int ph = 0; ph < N_PHASES; ++ph) {
        a.ph_lo = ph; a.ph_hi = ph + 1;
        hipLaunchKernelGGL(mega_fwd, dim3(grid), dim3(512), LDS_BYTES, stream, a);
    }
#else
    a.ph_lo = 0; a.ph_hi = N_PHASES;
    void* args[] = {&a};
    hipError_t e = hipLaunchCooperativeKernel((const void*)mega_fwd, dim3(grid), dim3(512), args, LDS_BYTES, stream);
    if (e != hipSuccess) fprintf(stderr, "cooperative launch failed: %s (grid %d)\n", hipGetErrorString(e), grid);
#endif
}
```

```cpp
#include <hip/hip_runtime.h>
#include <hip/hip_cooperative_groups.h>
#include <cstdio>
#include <cstdint>
namespace cg = cooperative_groups;

#ifndef N_LAUNCH_MODE
#define N_LAUNCH_MODE 0
#endif

#ifndef DUP_SP
#define DUP_SP -1
#endif
#ifndef SYNC_REPS
#define SYNC_REPS 1
#endif
#define LAS __attribute__((address_space(3)))
typedef unsigned short bf16_t;
typedef short bf16x8 __attribute__((ext_vector_type(8)));
typedef float f32x4 __attribute__((ext_vector_type(4)));
typedef float f32x2 __attribute__((ext_vector_type(2)));
typedef unsigned u32x4 __attribute__((ext_vector_type(4)));
typedef unsigned u32x2 __attribute__((ext_vector_type(2)));

constexpr int MTOK = 32768, DM = 1024, SEQ = 8192, DEPTH = 4, INC = 7184;
constexpr int NCH = 128;
constexpr float LN_EPS = 1e-5f;
constexpr float DN_ALPHA = 1.6817928305074290f;
constexpr float QSCALE = 0.08838834764831845f;
constexpr size_t UNITB = (size_t)MTOK * 1024 * 2;
constexpr size_t WS_X = 0, WS_QK = 1 * UNITB, WS_V = 2 * UNITB, WS_GA = 3 * UNITB, WS_GB = 4 * UNITB, WS_PIN = 5 * UNITB, WS_F1 = 6 * UNITB, WS_F2 = 7 * UNITB;
constexpr size_t WS_MG = WS_QK;
constexpr size_t WS_US = WS_PIN;
constexpr size_t WS_W1A = WS_F2;
constexpr size_t WS_WM = WS_W1A + (size_t)5120 * 1024 * 2;
constexpr size_t WS_WA = WS_WM + (size_t)2048 * 1024 * 2;
constexpr size_t WS_WB = WS_WA + (size_t)1024 * 1024 * 2;
constexpr size_t WS_WO = WS_WB + (size_t)1024 * 1024 * 2;
constexpr size_t WS_WG = WS_WO + (size_t)1024 * 1024 * 2;
constexpr size_t WS_AL = WS_WG + (size_t)4 * 256 * 256 * 2;
constexpr size_t WS_DF = WS_AL + (size_t)MTOK * 16 * 4;
constexpr size_t WS_BAR = WS_DF + (size_t)2048 * 128 * 4;
constexpr size_t BAR_BYTES = 16384;
constexpr size_t WS_END = WS_BAR + BAR_BYTES;
constexpr int LDS_PHASE = 131072, LDS_BYTES = LDS_PHASE + 64;

#define GAS __attribute__((address_space(1)))
template <class T> __device__ __forceinline__ T gld(const void* p) { return *(const GAS T*)p; }
template <class T> __device__ __forceinline__ void gst(void* p, const T v) { *(GAS T*)p = v; }
__device__ __forceinline__ unsigned cvt_pk_bf16(float lo, float hi) { unsigned r; asm volatile("v_cvt_pk_bf16_f32 %0, %1, %2" : "=v"(r) : "v"(lo), "v"(hi)); return r; }
__device__ __forceinline__ float bf_lo(unsigned w) { return __uint_as_float(w << 16); }
__device__ __forceinline__ float bf_hi(unsigned w) { return __uint_as_float(w & 0xffff0000u); }
__device__ __forceinline__ float bf2f(bf16_t b) { return __uint_as_float((unsigned)b << 16); }
__device__ __forceinline__ float sigmoidf_(float z) { return 1.0f / (1.0f + __expf(-z)); }
__device__ __forceinline__ float siluf_(float z) { return z / (1.0f + __expf(-z)); }

namespace pg8 {
constexpr int BM = 256, BK = 64, HALF = 128, HTB = HALF * BK * 2, STAGE_BYTES = 8 * HTB, NXCD = 8, WGM = 8;
__host__ __device__ __forceinline__ int lds_byte(int r, int c) { const int st = (r >> 4) * 2 + (c >> 5), rr = r & 15, cc = c & 31, ob = rr * 64 + cc * 2; return st * 1024 + (ob ^ (((ob >> 9) & 1) << 5)); }
__host__ __device__ __forceinline__ void stage_rc(int b, int& R, int& C) { const int st = b / 1024, sb = b % 1024, swz = sb ^ (((sb >> 9) & 1) << 5); R = (st >> 1) * 16 + swz / 64; C = (st & 1) * 32 + (swz % 64) / 2; }
__host__ __device__ __forceinline__ int perm32(int rho) { const int n = rho >> 4, i = rho & 15; return 8 * (i >> 2) + 4 * n + (i & 3); }

struct Unit { const char* A; const char* B; int pm, pn, kind, keep; };
struct Gemm { int lda, ldb, K; };

struct Sched {
    const char *A0, *A1, *B0, *B1; size_t a_pm, a_pn, b_pn; int nM, nN, nwg, G, c, chain;
    __device__ __forceinline__ bool next(int i, Unit& u) const {
        const int ti = (chain == 2) ? (i >> 1) : i, which = (chain == 2) ? (i & 1) : 0;
        const long L = (long)ti * G + c; if (L >= nwg) return false;
        int wgid = (int)L; { const int q = nwg / NXCD, r = nwg % NXCD, xcd = wgid % NXCD, off = wgid / NXCD; wgid = (xcd < r ? xcd * (q + 1) : r * (q + 1) + (xcd - r) * q) + off; }
        const int nig = WGM * nN, gid = wgid / nig, fm = gid * WGM, gsz = (nM - fm) < WGM ? (nM - fm) : WGM;
        u.pm = fm + ((wgid % nig) % gsz); u.pn = (wgid % nig) / gsz;
        u.A = (which ? A1 : A0) + (size_t)u.pm * a_pm + (size_t)u.pn * a_pn; u.B = (which ? B1 : B0) + (size_t)u.pn * b_pn;
        u.kind = which; u.keep = (chain == 2 && which == 0) ? 1 : 0; return true;
    }
};

template <class Epi>
__device__ __forceinline__ void gemm_phase(LAS unsigned char* lds, const int tid, const Gemm g, const Sched& S, const Epi& E) {
    const int wid = __builtin_amdgcn_readfirstlane(tid >> 6), lane = tid & 63, wr = wid >> 2, wc = wid & 3, fr = lane & 15, fq = lane >> 4;
    const int K = g.K, nt = K / BK;
    unsigned voffA[2], voffB[2];
#pragma unroll
    for (int i = 0; i < 2; ++i) { int R, C; stage_rc(tid * 16 + i * 8192, R, C); const int Rb = Epi::PERM ? ((R & ~31) + perm32(R & 31)) : R;
        voffA[i] = (unsigned)(R * g.lda + C) * 2u; voffB[i] = (unsigned)(Rb * g.ldb + C) * 2u; }
    const size_t kstep = (size_t)(BK * 2);
    const size_t hstepA = (size_t)HALF * g.lda * 2, hstepB = (size_t)HALF * g.ldb * 2;
    const unsigned ldsw = (unsigned)wid * 1024u;
    const int aoff = lds_byte(wr * 64 + fr, fq * 8), boff = lds_byte(wc * 32 + fr, fq * 8);
#define PG8_SA(b, h) (((b) * 2 + (h)) * HTB)
#define PG8_SB(b, h) ((4 + (b) * 2 + (h)) * HTB)
#define PG8_STAGE(bufoff, gbase, voff) do { _Pragma("unroll") for (int _i = 0; _i < 2; ++_i) \
        __builtin_amdgcn_global_load_lds((const unsigned*)((const char*)(gbase) + (voff)[_i]), (LAS unsigned*)(lds + (bufoff) + ldsw + _i * 8192), 16, 0, 0); } while (0)
#define PG8_LDA(dst, b, h) do { _Pragma("unroll") for (int m = 0; m < 4; ++m) _Pragma("unroll") for (int k = 0; k < 2; ++k) dst[m][k] = *(const LAS bf16x8*)(lds + PG8_SA(b, h) + aoff + m * 2048 + k * 1024); } while (0)
#define PG8_LDB(dst, b, h) do { _Pragma("unroll") for (int n = 0; n < 2; ++n) _Pragma("unroll") for (int k = 0; k < 2; ++k) dst[n][k] = *(const LAS bf16x8*)(lds + PG8_SB(b, h) + boff + n * 2048 + k * 1024); } while (0)
#define PG8_MMA(ai, bj, At, Bt) do { __builtin_amdgcn_s_setprio(1); _Pragma("unroll") for (int m = 0; m < 4; ++m) _Pragma("unroll") for (int n = 0; n < 2; ++n) _Pragma("unroll") for (int k = 0; k < 2; ++k) \
        acc[ai][bj][m][n] = __builtin_amdgcn_mfma_f32_16x16x32_bf16(Bt[n][k], At[m][k], acc[ai][bj][m][n], 0, 0, 0); __builtin_amdgcn_s_setprio(0); } while (0)
#define PG8_WAIT_V(n) asm volatile("s_waitcnt vmcnt(" #n ")" ::: "memory")
#define PG8_WAIT_L(n) asm volatile("s_waitcnt lgkmcnt(" #n ")" ::: "memory")
#define PG8_BAR __builtin_amdgcn_s_barrier()
#define PG8_SCHED __builtin_amdgcn_sched_barrier(0)
    Unit cur, nxt; int ui = 0;
    if (!S.next(0, cur)) return;
    f32x4 acc[2][2][4][2];
#pragma unroll
    for (int a = 0; a < 2; ++a)
#pragma unroll
        for (int b = 0; b < 2; ++b)
#pragma unroll
            for (int m = 0; m < 4; ++m)
#pragma unroll
                for (int n = 0; n < 2; ++n) acc[a][b][m][n] = (f32x4){0.f, 0.f, 0.f, 0.f};
    bf16x8 At[4][2], B0[2][2], B1[2][2];
    const char* cA = cur.A; const char* cB = cur.B;
    PG8_STAGE(PG8_SB(0, 0), cB, voffB); PG8_STAGE(PG8_SB(0, 1), cB + hstepB, voffB); PG8_STAGE(PG8_SA(0, 0), cA, voffA); PG8_STAGE(PG8_SA(0, 1), cA + hstepA, voffA);
    if (wr == 1) PG8_BAR;
    PG8_WAIT_V(2); PG8_BAR;
    PG8_STAGE(PG8_SB(1, 0), cB + kstep, voffB); PG8_STAGE(PG8_SA(1, 0), cA + kstep, voffA); PG8_STAGE(PG8_SB(1, 1), cB + hstepB + kstep, voffB);
    PG8_WAIT_V(6); PG8_BAR;
    for (;;) {
        const bool has_next = S.next(ui + 1, nxt);
        const char* nA = has_next ? nxt.A : cA; const char* nB = has_next ? nxt.B : cB;
        for (int t = 0; t < nt; t += 2) {
            const bool last = (t == nt - 2);
            const char* a1 = cA + (size_t)(t + 1) * kstep;
            const char* a2 = last ? nA : cA + (size_t)(t + 2) * kstep; const char* b2 = last ? nB : cB + (size_t)(t + 2) * kstep;
            const char* a3 = a2 + kstep; const char* b3 = b2 + kstep;
            PG8_LDB(B0, 0, 0); PG8_LDB(B1, 0, 1); PG8_SCHED; PG8_LDA(At, 0, 0); PG8_STAGE(PG8_SA(1, 1), a1 + hstepA, voffA);
            PG8_WAIT_V(8); PG8_WAIT_L(0); PG8_BAR; PG8_MMA(0, 0, At, B0); PG8_MMA(0, 1, At, B1); PG8_BAR; PG8_SCHED;
            PG8_LDA(At, 0, 1); PG8_STAGE(PG8_SB(0, 0), b2, voffB); PG8_STAGE(PG8_SB(0, 1), b2 + hstepB, voffB); PG8_STAGE(PG8_SA(0, 0), a2, voffA);
            PG8_WAIT_V(8); PG8_WAIT_L(0); PG8_BAR; PG8_MMA(1, 0, At, B0); PG8_MMA(1, 1, At, B1); PG8_BAR; PG8_SCHED;
            PG8_LDB(B0, 1, 0); PG8_LDB(B1, 1, 1); PG8_SCHED; PG8_LDA(At, 1, 0); PG8_STAGE(PG8_SA(0, 1), a2 + hstepA, voffA);
            PG8_WAIT_V(8); PG8_WAIT_L(0); PG8_BAR; PG8_MMA(0, 0, At, B0); PG8_MMA(0, 1, At, B1); PG8_BAR; PG8_SCHED;
            PG8_LDA(At, 1, 1); PG8_STAGE(PG8_SB(1, 0), b3, voffB); PG8_STAGE(PG8_SB(1, 1), b3 + hstepB, voffB); PG8_STAGE(PG8_SA(1, 0), a3, voffA);
            PG8_WAIT_V(8); PG8_WAIT_L(0); PG8_BAR; PG8_MMA(1, 0, At, B0); PG8_MMA(1, 1, At, B1); PG8_BAR; PG8_SCHED;
        }
        if (wr == 0) PG8_BAR;
        { int t2 = tid; asm volatile("" : "+v"(t2));
          const int l2 = t2 & 63; E(acc, cur, wr, wc, l2 & 15, l2 >> 4); }
        if (!has_next) break;
        if (!cur.keep) {
#pragma unroll
            for (int a = 0; a < 2; ++a)
#pragma unroll
                for (int b = 0; b < 2; ++b)
#pragma unroll
                    for (int m = 0; m < 4; ++m)
#pragma unroll
                        for (int n = 0; n < 2; ++n) acc[a][b][m][n] = (f32x4){0.f, 0.f, 0.f, 0.f};
        }
        cur = nxt; cA = nA; cB = nB; ++ui;
        if (wr == 1) PG8_BAR;
    }
    PG8_WAIT_V(0);
    PG8_BAR;
#undef PG8_SA
#undef PG8_SB
#undef PG8_STAGE
#undef PG8_LDA
#undef PG8_LDB
#undef PG8_MMA
#undef PG8_WAIT_V
#undef PG8_WAIT_L
#undef PG8_BAR
#undef PG8_SCHED
}

struct EpiSplit {
    static constexpr bool PERM = true;
    bf16_t* base;
    __device__ __forceinline__ void operator()(const f32x4 (&acc)[2][2][4][2], const Unit& u, int wr, int wc, int fr, int fq) const {
        const int row0 = u.pm * BM + wr * 64 + fr; const int colt = u.pn * BM; const int t = colt >> 10;
        bf16_t* b = base + (size_t)t * ((size_t)MTOK * 1024); const int col0 = (colt & 1023) + wc * 32 + 8 * fq;
#pragma unroll
        for (int ai = 0; ai < 2; ++ai)
#pragma unroll
            for (int m = 0; m < 4; ++m) { bf16_t* rowp = b + (size_t)(row0 + ai * HALF + m * 16) * 1024 + col0;
#pragma unroll
                for (int bj = 0; bj < 2; ++bj) { const f32x4 v0 = acc[ai][bj][m][0], v1 = acc[ai][bj][m][1];
                    u32x4 w; w.x = cvt_pk_bf16(v0[0], v0[1]); w.y = cvt_pk_bf16(v0[2], v0[3]); w.z = cvt_pk_bf16(v1[0], v1[1]); w.w = cvt_pk_bf16(v1[2], v1[3]);
                    gst<u32x4>(rowp + bj * HALF, w); } }
    }
};
struct EpiSig {
    static constexpr bool PERM = true;
    bf16_t* O; const float* bias;
    __device__ __forceinline__ void operator()(const f32x4 (&acc)[2][2][4][2], const Unit& u, int wr, int wc, int fr, int fq) const {
        const int row0 = u.pm * BM + wr * 64 + fr; const int col0 = u.pn * BM + wc * 32 + 8 * fq;
        f32x4 bv[2][2];
#pragma unroll
        for (int bj = 0; bj < 2; ++bj)
#pragma unroll
            for (int n = 0; n < 2; ++n) bv[bj][n] = gld<f32x4>(bias + col0 + bj * HALF + 4 * n);
#pragma unroll
        for (int ai = 0; ai < 2; ++ai)
#pragma unroll
            for (int m = 0; m < 4; ++m) { bf16_t* rowp = O + (size_t)(row0 + ai * HALF + m * 16) * 2048 + col0;
#pragma unroll
                for (int bj = 0; bj < 2; ++bj) { f32x4 v0 = acc[ai][bj][m][0] + bv[bj][0], v1 = acc[ai][bj][m][1] + bv[bj][1];
#pragma unroll
                    for (int j = 0; j < 4; ++j) { v0[j] = sigmoidf_(v0[j]); v1[j] = sigmoidf_(v1[j]); }
                    u32x4 w; w.x = cvt_pk_bf16(v0[0], v0[1]); w.y = cvt_pk_bf16(v0[2], v0[3]); w.z = cvt_pk_bf16(v1[0], v1[1]); w.w = cvt_pk_bf16(v1[2], v1[3]);
                    gst<u32x4>(rowp + bj * HALF, w); } }
    }
};
struct EpiPool {
    static constexpr bool PERM = true;
    bf16_t* GB; const float* scale;
    __device__ __forceinline__ void operator()(const f32x4 (&acc)[2][2][4][2], const Unit& u, int wr, int wc, int fr, int fq) const {
        const int row0 = u.pm * BM + wr * 64 + fr; const int col0 = u.pn * BM + wc * 32 + 8 * fq;
        f32x4 sv[2][2];
#pragma unroll
        for (int bj = 0; bj < 2; ++bj)
#pragma unroll
            for (int n = 0; n < 2; ++n) sv[bj][n] = gld<f32x4>(scale + col0 + bj * HALF + 4 * n);
#pragma unroll
        for (int ai = 0; ai < 2; ++ai)
#pragma unroll
            for (int m = 0; m < 4; ++m) { bf16_t* rowp = GB + (size_t)(row0 + ai * HALF + m * 16) * 1024 + col0;
#pragma unroll
                for (int bj = 0; bj < 2; ++bj) { const u32x4 gw = gld<u32x4>(rowp + bj * HALF);
                    f32x4 v0 = acc[ai][bj][m][0] * sv[bj][0], v1 = acc[ai][bj][m][1] * sv[bj][1];
                    v0[0] *= siluf_(bf_lo(gw.x)); v0[1] *= siluf_(bf_hi(gw.x)); v0[2] *= siluf_(bf_lo(gw.y)); v0[3] *= siluf_(bf_hi(gw.y));
                    v1[0] *= siluf_(bf_lo(gw.z)); v1[1] *= siluf_(bf_hi(gw.z)); v1[2] *= siluf_(bf_lo(gw.w)); v1[3] *= siluf_(bf_hi(gw.w));
                    u32x4 w; w.x = cvt_pk_bf16(v0[0], v0[1]); w.y = cvt_pk_bf16(v0[2], v0[3]); w.z = cvt_pk_bf16(v1[0], v1[1]); w.w = cvt_pk_bf16(v1[2], v1[3]);
                    gst<u32x4>(rowp + bj * HALF, w); } }
    }
};
struct EpiProj {
    static constexpr bool PERM = true;
    const bf16_t* MG; bf16_t* O;
    __device__ __forceinline__ void operator()(f32x4 (&acc)[2][2][4][2], const Unit& u, int wr, int wc, int fr, int fq) const {
        const int row0 = u.pm * BM + wr * 64 + fr; const int col0 = u.pn * BM + wc * 32 + 8 * fq;
        if (u.kind == 0) {
#pragma unroll
            for (int ai = 0; ai < 2; ++ai)
#pragma unroll
                for (int m = 0; m < 4; ++m) { const bf16_t* gp = MG + (size_t)(row0 + ai * HALF + m * 16) * 2048 + col0;
#pragma unroll
                    for (int bj = 0; bj < 2; ++bj) { const u32x4 ga = gld<u32x4>(gp + bj * HALF), gb = gld<u32x4>(gp + 1024 + bj * HALF);
                        f32x4& v0 = acc[ai][bj][m][0]; f32x4& v1 = acc[ai][bj][m][1];
                        v0[0] *= bf_lo(ga.x) * __builtin_amdgcn_rcpf(bf_lo(gb.x)); v0[1] *= bf_hi(ga.x) * __builtin_amdgcn_rcpf(bf_hi(gb.x));
                        v0[2] *= bf_lo(ga.y) * __builtin_amdgcn_rcpf(bf_lo(gb.y)); v0[3] *= bf_hi(ga.y) * __builtin_amdgcn_rcpf(bf_hi(gb.y));
                        v1[0] *= bf_lo(ga.z) * __builtin_amdgcn_rcpf(bf_lo(gb.z)); v1[1] *= bf_hi(ga.z) * __builtin_amdgcn_rcpf(bf_hi(gb.z));
                        v1[2] *= bf_lo(ga.w) * __builtin_amdgcn_rcpf(bf_lo(gb.w)); v1[3] *= bf_hi(ga.w) * __builtin_amdgcn_rcpf(bf_hi(gb.w)); } }
        } else {
#pragma unroll
            for (int ai = 0; ai < 2; ++ai)
#pragma unroll
                for (int m = 0; m < 4; ++m) { const size_t r = (size_t)(row0 + ai * HALF + m * 16); const bf16_t* gp = MG + r * 2048 + 1024 + col0; bf16_t* rowp = O + r * 1024 + col0;
#pragma unroll
                    for (int bj = 0; bj < 2; ++bj) { const u32x4 gb = gld<u32x4>(gp + bj * HALF);
                        const f32x4 v0 = acc[ai][bj][m][0], v1 = acc[ai][bj][m][1];
                        u32x4 w; w.x = cvt_pk_bf16(v0[0] * bf_lo(gb.x), v0[1] * bf_hi(gb.x)); w.y = cvt_pk_bf16(v0[2] * bf_lo(gb.y), v0[3] * bf_hi(gb.y));
                        w.z = cvt_pk_bf16(v1[0] * bf_lo(gb.z), v1[1] * bf_hi(gb.z)); w.w = cvt_pk_bf16(v1[2] * bf_lo(gb.w), v1[3] * bf_hi(gb.w));
                        gst<u32x4>(rowp + bj * HALF, w); } }
        }
    }
};
struct EpiOut {
    static constexpr bool PERM = false;
    const float* xres; float* out;
    __device__ __forceinline__ void operator()(const f32x4 (&acc)[2][2][4][2], const Unit& u, int wr, int wc, int fr, int fq) const {
        const int row0 = u.pm * BM + wr * 64 + fr, col0 = u.pn * BM + wc * 32 + 4 * fq;
#pragma unroll
        for (int ai = 0; ai < 2; ++ai)
#pragma unroll
            for (int m = 0; m < 4; ++m) { const size_t off = (size_t)(row0 + ai * HALF + m * 16) * 1024 + col0;
#pragma unroll
                for (int bj = 0; bj < 2; ++bj)
#pragma unroll
                    for (int n = 0; n < 2; ++n) { const f32x4 xs = gld<f32x4>(xres + off + bj * HALF + n * 16);
                        gst<f32x4>(out + off + bj * HALF + n * 16, xs * DN_ALPHA + acc[ai][bj][m][n]); } }
    }
};
}

struct Args { const float* in[13]; float* out; unsigned char* ws; int ph_lo, ph_hi; };
struct Ctx { int tid, lane, wave, G, bid; };

__device__ __forceinline__ float wave_sum(float v) {
#pragma unroll
    for (int o = 1; o < 64; o <<= 1) v += __shfl_xor(v, o);
    return v;
}

__device__ __forceinline__ void transpose_item(const float* W, int ld_src, int col0, int nblk, int K, bf16_t* WT, int row_off, LAS float* scr, int item, int lane) {
    const int kb = item / nblk, nb = item % nblk, k0 = 64 * kb, n0 = 32 * nb;
#pragma unroll 8
    for (int i = 0; i < 32; ++i) { const int kk = 2 * i + (lane >> 5); scr[kk * 33 + (lane & 31)] = gld<float>(W + (size_t)(k0 + kk) * ld_src + col0 + n0 + (lane & 31)); }
    asm volatile("s_waitcnt lgkmcnt(0)" ::: "memory");
    const int c = lane & 7;
#pragma unroll
    for (int j = 0; j < 4; ++j) { const int n = (lane >> 3) + 8 * j; const LAS float* s = scr + (8 * c) * 33 + n;
        u32x4 o; o.x = cvt_pk_bf16(s[0 * 33], s[1 * 33]); o.y = cvt_pk_bf16(s[2 * 33], s[3 * 33]); o.z = cvt_pk_bf16(s[4 * 33], s[5 * 33]); o.w = cvt_pk_bf16(s[6 * 33], s[7 * 33]);
        gst<u32x4>(WT + (size_t)(row_off + n0 + n) * K + k0 + 8 * c, o); }
    asm volatile("s_waitcnt lgkmcnt(0)" ::: "memory");
}
__device__ __forceinline__ void convert_weights(const Args& a, const Ctx& cx, LAS unsigned char* lds, int l) {
    LAS float* scr = (LAS float*)(lds + cx.wave * 8448);
    const int gw = cx.bid * 8 + cx.wave, NGW = cx.G * 8;
    unsigned char* ws = a.ws;
    const float* w_in = a.in[1] + (size_t)l * 1024 * INC;
    const float* w_pa = a.in[8] + (size_t)l * 1024 * 1024; const float* w_pb = a.in[9] + (size_t)l * 1024 * 1024; const float* w_o = a.in[10] + (size_t)l * 1024 * 1024;
    const float* w_g = a.in[5] + (size_t)l * 4 * 256 * 256;
    constexpr int I_A = 16 * 96, I_GB = 16 * 32, I_PIN = 16 * 32, I_M = 16 * 64, I_P = 16 * 32, I_G = 4 * 8;
    constexpr int NIT = I_A + I_GB + I_PIN + I_M + 3 * I_P + 4 * I_G;
    for (int it = gw; it < NIT; it += NGW) {
        int r = it;
        if (r < I_A) { transpose_item(w_in, INC, 0, 96, 1024, (bf16_t*)(ws + WS_W1A), 0, scr, r, cx.lane); continue; } r -= I_A;
        if (r < I_GB) { transpose_item(w_in, INC, 4112, 32, 1024, (bf16_t*)(ws + WS_W1A), 3072, scr, r, cx.lane); continue; } r -= I_GB;
        if (r < I_PIN) { transpose_item(w_in, INC, 3088, 32, 1024, (bf16_t*)(ws + WS_W1A), 4096, scr, r, cx.lane); continue; } r -= I_PIN;
        if (r < I_M) { transpose_item(w_in, INC, 5136, 64, 1024, (bf16_t*)(ws + WS_WM), 0, scr, r, cx.lane); continue; } r -= I_M;
        if (r < I_P) { transpose_item(w_pa, 1024, 0, 32, 1024, (bf16_t*)(ws + WS_WA), 0, scr, r, cx.lane); continue; } r -= I_P;
        if (r < I_P) { transpose_item(w_pb, 1024, 0, 32, 1024, (bf16_t*)(ws + WS_WB), 0, scr, r, cx.lane); continue; } r -= I_P;
        if (r < I_P) { transpose_item(w_o, 1024, 0, 32, 1024, (bf16_t*)(ws + WS_WO), 0, scr, r, cx.lane); continue; } r -= I_P;
        const int gi = r / I_G; r -= gi * I_G;
        transpose_item(w_g + (size_t)gi * 65536, 256, 0, 8, 256, (bf16_t*)(ws + WS_WG) + (size_t)gi * 65536, 0, scr, r, cx.lane);
    }
}

__device__ __forceinline__ void row_phase(const Ctx& cx, LAS unsigned char* lds, const float* src, float* dst, bf16_t* xbf, float* AL, const float* walpha  ,
                                          const float* lng, const float* lnb, bool do_ln) {
    LAS float* WT = (LAS float*)lds;
    if (AL) {
        for (int idx = cx.tid; idx < 16384; idx += 512) { const int k = idx >> 4, c = idx & 15; WT[c * 1028 + k] = gld<float>(walpha + (size_t)k * INC + c); }
    }
    __syncthreads();
    const int gw = cx.bid * 8 + cx.wave, NGW = cx.G * 8, lane = cx.lane;
    f32x4 gj[4], bj[4];
#pragma unroll
    for (int j = 0; j < 4; ++j) { gj[j] = (f32x4){1.f, 1.f, 1.f, 1.f}; bj[j] = (f32x4){0.f, 0.f, 0.f, 0.f}; }
    if (do_ln) {
#pragma unroll
        for (int j = 0; j < 4; ++j) { gj[j] = gld<f32x4>(lng + 256 * j + 4 * lane); bj[j] = gld<f32x4>(lnb + 256 * j + 4 * lane); }
    }
    for (int rg = gw; rg < MTOK / 4; rg += NGW) {
        const size_t m0 = (size_t)rg * 4;
        f32x4 v[4][4];
#pragma unroll
        for (int r = 0; r < 4; ++r)
#pragma unroll
            for (int j = 0; j < 4; ++j) v[r][j] = gld<f32x4>(src + (m0 + r) * 1024 + 256 * j + 4 * lane);
        if (do_ln) {
#pragma unroll
            for (int r = 0; r < 4; ++r) {
                float s = 0.f;
#pragma unroll
                for (int j = 0; j < 4; ++j) s += (v[r][j][0] + v[r][j][1]) + (v[r][j][2] + v[r][j][3]);
                const float mean = wave_sum(s) * (1.f / 1024.f); float s2 = 0.f;
#pragma unroll
                for (int j = 0; j < 4; ++j) { v[r][j] = v[r][j] - mean; s2 += (v[r][j][0] * v[r][j][0] + v[r][j][1] * v[r][j][1]) + (v[r][j][2] * v[r][j][2] + v[r][j][3] * v[r][j][3]); }
                const float rstd = 1.0f / sqrtf(wave_sum(s2) * (1.f / 1024.f) + LN_EPS);
#pragma unroll
                for (int j = 0; j < 4; ++j) { v[r][j] = v[r][j] * rstd * gj[j] + bj[j]; gst<f32x4>(dst + (m0 + r) * 1024 + 256 * j + 4 * lane, v[r][j]); }
            }
        }
        if (xbf) {
#pragma unroll
            for (int r = 0; r < 4; ++r)
#pragma unroll
                for (int j = 0; j < 4; ++j) { u32x2 w; w.x = cvt_pk_bf16(v[r][j][0], v[r][j][1]); w.y = cvt_pk_bf16(v[r][j][2], v[r][j][3]);
                    gst<u32x2>(xbf + (m0 + r) * 1024 + 256 * j + 4 * lane, w); }
        }
        if (AL) {
            float acc[64];
#pragma unroll
            for (int i = 0; i < 64; ++i) acc[i] = 0.f;
#pragma unroll
            for (int c = 0; c < 16; ++c)
#pragma unroll
                for (int j = 0; j < 4; ++j) { const f32x4 w = *(const LAS f32x4*)(WT + c * 1028 + 256 * j + 4 * lane);
#pragma unroll
                    for (int r = 0; r < 4; ++r) acc[r * 16 + c] += (v[r][j][0] * w[0] + v[r][j][1] * w[1]) + (v[r][j][2] * w[2] + v[r][j][3] * w[3]); }
#pragma unroll
            for (int h = 32; h >= 1; h >>= 1) {
                const bool up = (lane & h) != 0;
#pragma unroll
                for (int i = 0; i < h; ++i) { const float keep = up ? acc[i + h] : acc[i]; const float send = up ? acc[i] : acc[i + h]; acc[i] = keep + __shfl_xor(send, h); }
            }
            gst<float>(AL + m0 * 16 + lane, acc[0]);
        }
    }
}

__device__ __forceinline__ void unpack8(const u32x4 w, float (&f)[8]) { f[0] = bf_lo(w.x); f[1] = bf_hi(w.x); f[2] = bf_lo(w.y); f[3] = bf_hi(w.y); f[4] = bf_lo(w.z); f[5] = bf_hi(w.z); f[6] = bf_lo(w.w); f[7] = bf_hi(w.w); }
__device__ __forceinline__ void pool_phase(const Ctx& cx, const bf16_t* pin, bf16_t* pooled) {
    const int NT = (MTOK / 32) * 128;
    for (int q = cx.bid * 512 + cx.tid; q < NT; q += cx.G * 512) {
        const int cg8 = q & 127, seg = q >> 7; const int g = cg8 >> 5; const int w = 2 << g;
        const int t0 = seg * 32, pos0 = t0 & (SEQ - 1);
        const bf16_t* base = pin + (size_t)t0 * 1024 + cg8 * 8;
        float sum[8];
#pragma unroll
        for (int e = 0; e < 8; ++e) sum[e] = 0.f;
        for (int j = 1; j < w; ++j) if (pos0 - j >= 0) { float f[8]; unpack8(gld<u32x4>(base - (size_t)j * 1024), f);
#pragma unroll
            for (int e = 0; e < 8; ++e) sum[e] += f[e]; }
        for (int i = 0; i < 32; ++i) {
            const int pos = pos0 + i; float x[8]; unpack8(gld<u32x4>(base + (size_t)i * 1024), x);
#pragma unroll
            for (int e = 0; e < 8; ++e) sum[e] += x[e];
            if (i > 0 && pos - w >= 0) { float f[8]; unpack8(gld<u32x4>(base + (size_t)(i - w) * 1024), f);
#pragma unroll
                for (int e = 0; e < 8; ++e) sum[e] -= f[e]; }
            const int cnt = (pos + 1 < w) ? (pos + 1) : w; const float inv = 1.0f / (float)cnt;
            u32x4 o; o.x = cvt_pk_bf16(sum[0] * inv - x[0], sum[1] * inv - x[1]); o.y = cvt_pk_bf16(sum[2] * inv - x[2], sum[3] * inv - x[3]);
            o.z = cvt_pk_bf16(sum[4] * inv - x[4], sum[5] * inv - x[5]); o.w = cvt_pk_bf16(sum[6] * inv - x[6], sum[7] * inv - x[7]);
            gst<u32x4>(pooled + (size_t)(t0 + i) * 1024 + cg8 * 8, o);
        }
    }
}

constexpr int L_AL = 0, L_GL = 4096, L_RS = 6144, L_KT = 8192  , L_VT1 = 26624  ;
constexpr int L_QA = 8192, L_KA = 25600, L_QB = 43008, L_KB = 60416, L_VT3 = 77824, L_P = 114688;

__device__ __forceinline__ void gla_G(LAS unsigned char* lds, const float* wup  , float bias, int d, int tg, float (&g)[16], float& total) {
    const LAS float* AL_s = (const LAS float*)(lds + L_AL); LAS float* GL_s = (LAS float*)(lds + L_GL);
    float w[16];
#pragma unroll
    for (int r = 0; r < 16; ++r) w[r] = gld<float>(wup + r * 512);
    float run = 0.f;
#pragma unroll
    for (int tt = 0; tt < 16; ++tt) {
        const LAS f32x4* ap = (const LAS f32x4*)(AL_s + (tg * 16 + tt) * 16);
        const f32x4 a0 = ap[0], a1 = ap[1], a2 = ap[2], a3 = ap[3];
        float z = bias;
        z += a0[0] * w[0]; z += a0[1] * w[1]; z += a0[2] * w[2]; z += a0[3] * w[3];
        z += a1[0] * w[4]; z += a1[1] * w[5]; z += a1[2] * w[6]; z += a1[3] * w[7];
        z += a2[0] * w[8]; z += a2[1] * w[9]; z += a2[2] * w[10]; z += a2[3] * w[11];
        z += a3[0] * w[12]; z += a3[1] * w[13]; z += a3[2] * w[14]; z += a3[3] * w[15];
        const float ls = fminf(z, 0.f) - __logf(1.0f + __expf(-fabsf(z)));
        run += ls * (1.0f / 16.0f);
        g[tt] = run;
    }
    GL_s[tg * 128 + d] = run;
    __syncthreads();
    const float p0 = GL_s[d], p1 = GL_s[128 + d], p2 = GL_s[256 + d], p3 = GL_s[384 + d];
    const float prefix = (tg > 0 ? p0 : 0.f) + (tg > 1 ? p1 : 0.f) + (tg > 2 ? p2 : 0.f);
    total = (p0 + p1) + (p2 + p3);
#pragma unroll
    for (int tt = 0; tt < 16; ++tt) g[tt] += prefix;
}
__device__ __forceinline__ void gla_stage(const Ctx& cx, LAS unsigned char* lds, int vt_off, const float* AL, const bf16_t* Vb, int row0, int h) {
    if (cx.tid < 256) ((LAS f32x4*)(lds + L_AL))[cx.tid] = gld<f32x4>(AL + (size_t)row0 * 16 + cx.tid * 4);
    LAS unsigned* VT32 = (LAS unsigned*)(lds + vt_off);
#pragma unroll
    for (int i = 0; i < 2; ++i) {
        const int q = cx.tid + 512 * i, tp = q & 31, ng = q >> 5;
        const bf16_t* vp = Vb + (size_t)(row0 + 2 * tp) * 1024 + h * 256 + ng * 8;
        const u32x4 r0 = gld<u32x4>(vp), r1 = gld<u32x4>(vp + 1024);
#pragma unroll
        for (int j = 0; j < 4; ++j) {
            VT32[(ng * 8 + 2 * j) * 36 + tp] = (r0[j] & 0xffffu) | (r1[j] << 16);
            VT32[(ng * 8 + 2 * j + 1) * 36 + tp] = (r0[j] >> 16) | (r1[j] & 0xffff0000u);
        }
    }
}

__device__ __forceinline__ void gla_p1(const Args& a, const Ctx& cx, LAS unsigned char* lds, int l) {
    unsigned char* ws = a.ws;
    const float* AL = (const float*)(ws + WS_AL); const bf16_t* QKb = (const bf16_t*)(ws + WS_QK); const bf16_t* Vb = (const bf16_t*)(ws + WS_V);
    unsigned char* US = ws + WS_US; float* DF = (float*)(ws + WS_DF);
    const float* Wup = a.in[2] + (size_t)l * 16 * 512; const float* balpha = a.in[3] + (size_t)l * 512;
    const int tid = cx.tid, lane = cx.lane, wv = cx.wave, fr = lane & 15, fq = lane >> 4;
    for (int it = cx.bid; it < 2048; it += cx.G) {
        const int b = it >> 9, c = (it >> 2) & 127, h = it & 3; const int row0 = b * SEQ + c * 64; const int slot = (b * 4 + h) * NCH + c;
        __syncthreads();
        gla_stage(cx, lds, L_VT1, AL, Vb, row0, h);
        __syncthreads();
        const int d = tid & 127, tg = tid >> 7;
        float g[16], total;
        gla_G(lds, Wup + h * 128 + d, gld<float>(balpha + h * 128 + d), d, tg, g, total);
        const bf16_t* kp = QKb + (size_t)(row0 + tg * 16) * 1024 + 512 + h * 128 + d;
        unsigned pk[8];
#pragma unroll
        for (int tt = 0; tt < 16; tt += 2) { const float k0 = bf2f(gld<bf16_t>(kp + (size_t)tt * 1024)) * __expf(total - g[tt]), k1 = bf2f(gld<bf16_t>(kp + (size_t)(tt + 1) * 1024)) * __expf(total - g[tt + 1]); pk[tt >> 1] = cvt_pk_bf16(k0, k1); }
        LAS u32x4* kt = (LAS u32x4*)(lds + L_KT + d * 144 + tg * 32);
        kt[0] = (u32x4){pk[0], pk[1], pk[2], pk[3]}; kt[1] = (u32x4){pk[4], pk[5], pk[6], pk[7]};
        if (tg == 0) gst<float>(DF + (size_t)slot * 128 + d, __expf(total));
        __syncthreads();
        f32x4 acc[8][2];
#pragma unroll
        for (int dt = 0; dt < 8; ++dt) { acc[dt][0] = (f32x4){0.f, 0.f, 0.f, 0.f}; acc[dt][1] = (f32x4){0.f, 0.f, 0.f, 0.f}; }
#pragma unroll
        for (int ks = 0; ks < 2; ++ks) {
            bf16x8 bfr[2];
#pragma unroll
            for (int nn = 0; nn < 2; ++nn) bfr[nn] = *(const LAS bf16x8*)(lds + L_VT1 + ((2 * wv + nn) * 16 + fr) * 144 + ks * 64 + fq * 16);
#pragma unroll
            for (int dt = 0; dt < 8; ++dt) { const bf16x8 af = *(const LAS bf16x8*)(lds + L_KT + (dt * 16 + fr) * 144 + ks * 64 + fq * 16);
#pragma unroll
                for (int nn = 0; nn < 2; ++nn) acc[dt][nn] = __builtin_amdgcn_mfma_f32_16x16x32_bf16(af, bfr[nn], acc[dt][nn], 0, 0, 0); }
        }
        unsigned char* up = US + (size_t)slot * 65536;
#pragma unroll
        for (int dt = 0; dt < 8; ++dt)
#pragma unroll
            for (int nn = 0; nn < 2; ++nn) { u32x2 o; o.x = cvt_pk_bf16(acc[dt][nn][0], acc[dt][nn][1]); o.y = cvt_pk_bf16(acc[dt][nn][2], acc[dt][nn][3]);
                gst<u32x2>(up + ((2 * wv + nn) * 16 + fr) * 256 + (dt * 16 + fq * 4) * 2, o); }
    }
}
__device__ __forceinline__ void gla_p2(const Args& a, const Ctx& cx) {
    unsigned char* US = a.ws + WS_US; const float* DF = (const float*)(a.ws + WS_DF);
    for (int q = cx.bid * 512 + cx.tid; q < 16 * 8192; q += cx.G * 512) {
        const int bh = q >> 13, within = q & 8191; const int dq = within & 31;
        unsigned char* p = US + (size_t)bh * NCH * 65536 + (size_t)within * 8;
        const float* dfp = DF + (size_t)bh * NCH * 128 + dq * 4;
        float s0 = 0.f, s1 = 0.f, s2 = 0.f, s3 = 0.f;
        for (int cb = 0; cb < NCH; cb += 16) {
            u32x2 u[16]; f32x4 df[16];
#pragma unroll
            for (int i = 0; i < 16; ++i) { u[i] = gld<u32x2>(p + (size_t)(cb + i) * 65536); df[i] = gld<f32x4>(dfp + (size_t)(cb + i) * 128); }
#pragma unroll
            for (int i = 0; i < 16; ++i) {
                s0 = df[i][0] * s0 + bf_lo(u[i].x); s1 = df[i][1] * s1 + bf_hi(u[i].x); s2 = df[i][2] * s2 + bf_lo(u[i].y); s3 = df[i][3] * s3 + bf_hi(u[i].y);
                u32x2 o; o.x = cvt_pk_bf16(s0, s1); o.y = cvt_pk_bf16(s2, s3);
                gst<u32x2>(p + (size_t)(cb + i) * 65536, o);
            }
        }
    }
}
__device__ __forceinline__ void gla_p3(const Args& a, const Ctx& cx, LAS unsigned char* lds, int l) {
    unsigned char* ws = a.ws;
    const float* AL = (const float*)(ws + WS_AL); const bf16_t* QKb = (const bf16_t*)(ws + WS_QK); const bf16_t* Vb = (const bf16_t*)(ws + WS_V);
    const unsigned char* US = ws + WS_US; bf16_t* GA = (bf16_t*)(ws + WS_GA);
    const float* Wup = a.in[2] + (size_t)l * 16 * 512; const float* balpha = a.in[3] + (size_t)l * 512; const float* gnorm = a.in[4] + (size_t)l * 1024;
    const int tid = cx.tid, lane = cx.lane, wv = cx.wave, fr = lane & 15, fq = lane >> 4;
    for (int it = cx.bid; it < 2048; it += cx.G) {
        const int b = it >> 9, c = (it >> 2) & 127, h = it & 3; const int row0 = b * SEQ + c * 64; const int slot = (b * 4 + h) * NCH + c;
        __syncthreads();
        gla_stage(cx, lds, L_VT3, AL, Vb, row0, h);
        __syncthreads();
        const int d = tid & 127, tg = tid >> 7;
        float g[16], total;
        gla_G(lds, Wup + h * 128 + d, gld<float>(balpha + h * 128 + d), d, tg, g, total);
        {
            const bf16_t* qp = QKb + (size_t)(row0 + tg * 16) * 1024 + h * 128 + d; const bf16_t* kp = qp + 512;
            LAS bf16_t* QA = (LAS bf16_t*)(lds + L_QA); LAS bf16_t* KA = (LAS bf16_t*)(lds + L_KA); LAS bf16_t* QB = (LAS bf16_t*)(lds + L_QB); LAS bf16_t* KB = (LAS bf16_t*)(lds + L_KB);
#pragma unroll
            for (int tt = 0; tt < 16; ++tt) {
                const float qv = bf2f(gld<bf16_t>(qp + (size_t)tt * 1024)) * QSCALE, kv = bf2f(gld<bf16_t>(kp + (size_t)tt * 1024)); const float eg = __expf(g[tt]), ei = __expf(-g[tt]);
                const int o = (tg * 16 + tt) * 136 + d;
                const unsigned w0 = cvt_pk_bf16(qv * eg, kv * ei), w1 = cvt_pk_bf16(qv * ei, kv * eg);
                QA[o] = (bf16_t)(w0 & 0xffffu); KA[o] = (bf16_t)(w0 >> 16); QB[o] = (bf16_t)(w1 & 0xffffu); KB[o] = (bf16_t)(w1 >> 16);
            }
        }
        __syncthreads();
#pragma unroll
        for (int x = 0; x < 2; ++x) {
            const int tile = 2 * wv + x, ti = tile >> 2, si = tile & 3;
            f32x4 a1 = (f32x4){0.f, 0.f, 0.f, 0.f}, a2 = (f32x4){0.f, 0.f, 0.f, 0.f};
            if (ti >= si) {
#pragma unroll
                for (int ks = 0; ks < 4; ++ks) { const bf16x8 af = *(const LAS bf16x8*)(lds + L_KA + (si * 16 + fr) * 272 + ks * 64 + fq * 16), bfv = *(const LAS bf16x8*)(lds + L_QA + (ti * 16 + fr) * 272 + ks * 64 + fq * 16);
                    a1 = __builtin_amdgcn_mfma_f32_16x16x32_bf16(af, bfv, a1, 0, 0, 0); }
            }
            if (ti <= si) {
#pragma unroll
                for (int ks = 0; ks < 4; ++ks) { const bf16x8 af = *(const LAS bf16x8*)(lds + L_KB + (si * 16 + fr) * 272 + ks * 64 + fq * 16), bfv = *(const LAS bf16x8*)(lds + L_QB + (ti * 16 + fr) * 272 + ks * 64 + fq * 16);
                    a2 = __builtin_amdgcn_mfma_f32_16x16x32_bf16(af, bfv, a2, 0, 0, 0); }
            }
            const int t = ti * 16 + fr, s0 = si * 16 + fq * 4;
            const float p0 = (t >= s0) ? a1[0] : a2[0], p1 = (t >= s0 + 1) ? a1[1] : a2[1], p2 = (t >= s0 + 2) ? a1[2] : a2[2], p3 = (t >= s0 + 3) ? a1[3] : a2[3];
            u32x2 o; o.x = cvt_pk_bf16(p0, p1); o.y = cvt_pk_bf16(p2, p3);
            *(LAS u32x2*)(lds + L_P + t * 144 + s0 * 2) = o;
        }
        __syncthreads();
        const int ti = wv & 3, nh = wv >> 2;
        f32x4 acc[8];
#pragma unroll
        for (int i = 0; i < 8; ++i) acc[i] = (f32x4){0.f, 0.f, 0.f, 0.f};
        bf16x8 bP[2], bQ[4];
#pragma unroll
        for (int ks = 0; ks < 2; ++ks) bP[ks] = *(const LAS bf16x8*)(lds + L_P + (ti * 16 + fr) * 144 + ks * 64 + fq * 16);
#pragma unroll
        for (int ks = 0; ks < 4; ++ks) bQ[ks] = *(const LAS bf16x8*)(lds + L_QA + (ti * 16 + fr) * 272 + ks * 64 + fq * 16);
        const unsigned char* sp = US + (size_t)(c > 0 ? slot - 1 : slot) * 65536;
#pragma unroll
        for (int nt = 0; nt < 8; ++nt) {
            const int n = (nh * 8 + nt) * 16 + fr;
#pragma unroll
            for (int ks = 0; ks < 2; ++ks) { const bf16x8 af = *(const LAS bf16x8*)(lds + L_VT3 + n * 144 + ks * 64 + fq * 16); acc[nt] = __builtin_amdgcn_mfma_f32_16x16x32_bf16(af, bP[ks], acc[nt], 0, 0, 0); }
            if (c > 0) {
#pragma unroll
                for (int ks = 0; ks < 4; ++ks) { const bf16x8 af = gld<bf16x8>(sp + n * 256 + ks * 64 + fq * 16); acc[nt] = __builtin_amdgcn_mfma_f32_16x16x32_bf16(af, bQ[ks], acc[nt], 0, 0, 0); }
            }
        }
        float ss = 0.f;
#pragma unroll
        for (int nt = 0; nt < 8; ++nt) ss += (acc[nt][0] * acc[nt][0] + acc[nt][1] * acc[nt][1]) + (acc[nt][2] * acc[nt][2] + acc[nt][3] * acc[nt][3]);
        ss += __shfl_xor(ss, 16); ss += __shfl_xor(ss, 32);
        LAS float* RS = (LAS float*)(lds + L_RS);
        const int t = ti * 16 + fr;
        if (fq == 0) RS[t * 2 + nh] = ss;
        __syncthreads();
        const float rinv = 1.0f / sqrtf((RS[t * 2] + RS[t * 2 + 1]) * (1.0f / 256.0f) + LN_EPS);
        bf16_t* gp = GA + (size_t)(row0 + t) * 1024 + h * 256;
#pragma unroll
        for (int nt = 0; nt < 8; ++nt) {
            const int n0 = (nh * 8 + nt) * 16 + fq * 4;
            const f32x4 gn = gld<f32x4>(gnorm + h * 256 + n0);
            const u32x2 gw = gld<u32x2>(gp + n0);
            const float y0 = acc[nt][0] * rinv * gn[0] * siluf_(bf_lo(gw.x)), y1 = acc[nt][1] * rinv * gn[1] * siluf_(bf_hi(gw.x));
            const float y2 = acc[nt][2] * rinv * gn[2] * siluf_(bf_lo(gw.y)), y3 = acc[nt][3] * rinv * gn[3] * siluf_(bf_hi(gw.y));
            u32x2 o; o.x = cvt_pk_bf16(y0, y1); o.y = cvt_pk_bf16(y2, y3);
            gst<u32x2>(gp + n0, o);
        }
    }
}


#define XB_TMO      128
#define XB_XCNT(j)  (256  + 64 * (j))
#define XB_XSUB(j)  (1280 + 64 * (j))
#define XB_XGEN(j)  (2304 + 64 * (j))
#define XB_TOP      3328
#define XB_TOPGEN   3392
#define XCD_BAR_WORDS 3456
#define XB_SPIN_CAP (1u << 22)
__device__ __forceinline__ unsigned xb_ld(unsigned* p)              { return __hip_atomic_load(p, __ATOMIC_RELAXED, __HIP_MEMORY_SCOPE_AGENT); }
__device__ __forceinline__ unsigned xb_add(unsigned* p, unsigned v) { return __hip_atomic_fetch_add(p, v, __ATOMIC_RELAXED, __HIP_MEMORY_SCOPE_AGENT); }
__device__ __forceinline__ unsigned xb_xcc_id() { return (unsigned)__builtin_amdgcn_s_getreg((3 << 11) | 20) & 0xFu; }
#define XB_SPIN(cond, bar) do { unsigned _sp = 0; while (cond) { __builtin_amdgcn_s_sleep(1); \
    if ((++_sp & 255u) == 0u) { if (xb_ld(&(bar)[XB_TMO])) break; if (_sp > XB_SPIN_CAP) { atomicAdd(&(bar)[XB_TMO], 1u); break; } } } } while (0)
struct XcdBarrier { unsigned* bar; unsigned x; volatile LAS unsigned* st; };
__device__ __forceinline__ XcdBarrier xcd_barrier_post(unsigned* bar, volatile LAS unsigned* st) {
    XcdBarrier b; b.bar = bar; b.x = xb_xcc_id(); b.st = st;
    if (threadIdx.x == 0) (void)xb_add(&bar[XB_XCNT(b.x)], 1u);
    return b;
}
__device__ __forceinline__ void xcd_barrier_complete(unsigned* bar, unsigned x, unsigned& nloc, unsigned& nx) {
    const unsigned G = gridDim.x * gridDim.y * gridDim.z;
    unsigned sum, cnt, mine, sp = 0u;
    for (;;) {
        sum = 0u; cnt = 0u; mine = 0u;
#pragma unroll
        for (unsigned j = 0; j < 16; ++j) { const unsigned c = xb_ld(&bar[XB_XCNT(j)]); sum += c; cnt += (c > 0u) ? 1u : 0u; mine = (j == x) ? c : mine; }
        if (sum == G) break;
        __builtin_amdgcn_s_sleep(1);
        if ((++sp & 255u) == 0u) { if (xb_ld(&bar[XB_TMO])) break; if (sp > XB_SPIN_CAP) { atomicAdd(&bar[XB_TMO], 1u); break; } }
    }
    nloc = mine > 0u ? mine : 1u; nx = cnt > 0u ? cnt : 1u;
}
__device__ __forceinline__ void xcd_barrier(const XcdBarrier& b) {
    asm volatile("s_waitcnt vmcnt(0)" ::: "memory");
    __syncthreads();
    if (threadIdx.x == 0) {
        unsigned* bar; { const unsigned long long v = (unsigned long long)b.bar;
            unsigned lo = (unsigned)__builtin_amdgcn_readfirstlane((unsigned)v), hi = (unsigned)__builtin_amdgcn_readfirstlane((unsigned)(v >> 32));
            asm volatile("" : "+s"(lo), "+s"(hi)); bar = (unsigned*)(((unsigned long long)hi << 32) | lo); }
        __builtin_amdgcn_s_waitcnt(0);
        unsigned nloc = b.st[0], nx = b.st[1];
        if (nloc == 0u) { xcd_barrier_complete(bar, b.x, nloc, nx); b.st[0] = nloc; b.st[1] = nx; }
        const unsigned old = xb_add(&bar[XB_XSUB(b.x)], 1u);
        const unsigned gen = old / nloc;
        if (old + 1u == (gen + 1u) * nloc) {
            __builtin_amdgcn_fence(__ATOMIC_RELEASE, "agent");
            asm volatile("s_waitcnt vmcnt(0)" ::: "memory");
            const unsigned og = xb_add(&bar[XB_TOP], 1u);
            const unsigned tg = og / nx;
            if (og + 1u == (tg + 1u) * nx) xb_add(&bar[XB_TOPGEN], 1u);
            else XB_SPIN(xb_ld(&bar[XB_TOPGEN]) == tg, bar);
            __builtin_amdgcn_fence(__ATOMIC_ACQUIRE, "agent");
            xb_add(&bar[XB_XGEN(b.x)], 1u);
            asm volatile("s_waitcnt vmcnt(0)" ::: "memory");
        } else {
            XB_SPIN(xb_ld(&bar[XB_XGEN(b.x)]) == gen, bar);
            __builtin_amdgcn_fence(__ATOMIC_ACQUIRE, "agent");
            asm volatile("s_waitcnt vmcnt(0)" ::: "memory");
        }
    }
    __syncthreads();
}

constexpr int PH_PER_LAYER = 10, N_PHASES = 1 + DEPTH * PH_PER_LAYER;

__device__ __forceinline__ void run_phase(const Args& a, const Ctx& cx, LAS unsigned char* lds, int ph) {
    unsigned char* ws = a.ws;
    if (ph == 0) {
        convert_weights(a, cx, lds, 0);
        __syncthreads();
        row_phase(cx, lds, a.in[0], nullptr, (bf16_t*)(ws + WS_X), (float*)(ws + WS_AL), a.in[1] + 3072, nullptr, nullptr, false);
        return;
    }
    const int l = (ph - 1) / PH_PER_LAYER; int sp = (ph - 1) % PH_PER_LAYER;
#ifdef ONLY_SP
    sp = ONLY_SP;
#endif
    pg8::Sched S; S.G = cx.G; S.c = cx.bid; S.chain = 1; S.A1 = nullptr; S.B1 = nullptr; S.a_pn = 0; S.nM = MTOK / 256;
    switch (sp) {
    case 0: {
        S.A0 = (const char*)(ws + WS_X); S.B0 = (const char*)(ws + WS_W1A); S.a_pm = (size_t)256 * 1024 * 2; S.b_pn = (size_t)256 * 1024 * 2; S.nN = 20; S.nwg = S.nM * S.nN;
        pg8::EpiSplit E{(bf16_t*)(ws + WS_QK)};
        pg8::gemm_phase<pg8::EpiSplit>(lds, cx.tid, pg8::Gemm{1024, 1024, 1024}, S, E);
    } break;
    case 1: pool_phase(cx, (const bf16_t*)(ws + WS_PIN), (bf16_t*)(ws + WS_F1)); break;
    case 2: {
        S.A0 = (const char*)(ws + WS_F1); S.B0 = (const char*)(ws + WS_WG); S.a_pm = (size_t)256 * 1024 * 2; S.a_pn = 256 * 2; S.b_pn = (size_t)65536 * 2; S.nN = 4; S.nwg = S.nM * S.nN;
        pg8::EpiPool E{(bf16_t*)(ws + WS_GB), a.in[6] + (size_t)l * 1024};
        pg8::gemm_phase<pg8::EpiPool>(lds, cx.tid, pg8::Gemm{1024, 256, 256}, S, E);
    } break;
    case 3: gla_p1(a, cx, lds, l); break;
    case 4: gla_p2(a, cx); break;
    case 5: gla_p3(a, cx, lds, l); break;
    case 6: {
        S.A0 = (const char*)(ws + WS_X); S.B0 = (const char*)(ws + WS_WM); S.a_pm = (size_t)256 * 1024 * 2; S.b_pn = (size_t)256 * 1024 * 2; S.nN = 8; S.nwg = S.nM * S.nN;
        pg8::EpiSig E{(bf16_t*)(ws + WS_MG), a.in[7] + (size_t)l * 2048};
        pg8::gemm_phase<pg8::EpiSig>(lds, cx.tid, pg8::Gemm{1024, 1024, 1024}, S, E);
    } break;
    case 7: {
        S.chain = 2; S.A0 = (const char*)(ws + WS_GA); S.A1 = (const char*)(ws + WS_GB); S.B0 = (const char*)(ws + WS_WA); S.B1 = (const char*)(ws + WS_WB);
        S.a_pm = (size_t)256 * 1024 * 2; S.b_pn = (size_t)256 * 1024 * 2; S.nN = 4; S.nwg = S.nM * S.nN;
        pg8::EpiProj E{(const bf16_t*)(ws + WS_MG), (bf16_t*)(ws + WS_PIN)};
        pg8::gemm_phase<pg8::EpiProj>(lds, cx.tid, pg8::Gemm{1024, 1024, 1024}, S, E);
    } break;
    case 8: {
        S.A0 = (const char*)(ws + WS_PIN); S.B0 = (const char*)(ws + WS_WO); S.a_pm = (size_t)256 * 1024 * 2; S.b_pn = (size_t)256 * 1024 * 2; S.nN = 4; S.nwg = S.nM * S.nN;
        pg8::EpiOut E{l == 0 ? a.in[0] : a.out, a.out};
        pg8::gemm_phase<pg8::EpiOut>(lds, cx.tid, pg8::Gemm{1024, 1024, 1024}, S, E);
    } break;
    default: {
        const bool more = (l + 1 < DEPTH);
        if (more) { convert_weights(a, cx, lds, l + 1); __syncthreads(); }
        row_phase(cx, lds, a.out, a.out, more ? (bf16_t*)(ws + WS_X) : nullptr, more ? (float*)(ws + WS_AL) : nullptr,
                  a.in[1] + (size_t)(more ? l + 1 : l) * 1024 * INC + 3072, a.in[11] + (size_t)l * 1024, a.in[12] + (size_t)l * 1024, true);
    } break;
    }
}

__global__ void __launch_bounds__(512, 2) mega_fwd(Args a) {
    extern __shared__ __attribute__((aligned(16))) unsigned char lds_raw[];
    LAS unsigned char* lds = (LAS unsigned char*)lds_raw;
    cg::grid_group grid = cg::this_grid();
    if (threadIdx.x < 16) ((LAS unsigned*)(lds + LDS_PHASE))[threadIdx.x] = 0u;
    __syncthreads();
    const XcdBarrier bar = xcd_barrier_post((unsigned*)(a.ws + WS_BAR), (volatile LAS unsigned*)(lds + LDS_PHASE));
    constexpr int PPL = PH_PER_LAYER + (DUP_SP >= 0 ? 1 : 0);
    for (int idx = a.ph_lo; idx < a.ph_hi; ++idx) {
        if (idx > a.ph_lo) { if (a.ph_lo < 0) grid.sync();
            for (int r = 0; r < SYNC_REPS; ++r) xcd_barrier(bar); }
        int ph = 0;
        if (idx > 0) { const int l = (idx - 1) / PPL, e = (idx - 1) % PPL; const int sp = (DUP_SP >= 0 && e > DUP_SP) ? e - 1 : e; ph = 1 + l * PH_PER_LAYER + sp; }
        int tid = threadIdx.x; asm volatile("" : "+v"(tid));
        Ctx cx; cx.tid = tid; cx.lane = tid & 63; cx.wave = __builtin_amdgcn_readfirstlane(tid >> 6); cx.G = gridDim.x; cx.bid = blockIdx.x;
        Args b = a;
#pragma unroll
        for (int i = 0; i < 13; ++i) asm volatile("" : "+s"(b.in[i]));
        asm volatile("" : "+s"(b.out)); asm volatile("" : "+s"(b.ws));
        run_phase(b, cx, lds, ph);
    }
}

extern "C" void kernel_launch(void* const* d_in, const int* in_sizes, int n_in, void* d_out, int out_size, void* d_ws, size_t ws_size, hipStream_t stream) {
    static int grid = 0;
    if (grid == 0) {
        if (n_in != 13 || in_sizes[0] != MTOK * DM || out_size != MTOK * DM || ws_size < WS_END) {
            fprintf(stderr, "kernel_launch: unexpected shapes (n_in %d, in0 %d, out %d, ws %zu, need %zu); nothing launched\n", n_in, n_in > 0 ? in_sizes[0] : -1, out_size, ws_size, (size_t)WS_END); grid = -1; return; }
        int dev = 0, cus = 0, per_cu = 0;
        if (hipGetDevice(&dev) != hipSuccess || hipDeviceGetAttribute(&cus, hipDeviceAttributeMultiprocessorCount, dev) != hipSuccess) { grid = -1; return; }
        if (hipFuncSetAttribute((const void*)mega_fwd, hipFuncAttributeMaxDynamicSharedMemorySize, LDS_BYTES) != hipSuccess) { fprintf(stderr, "kernel_launch: hipFuncSetAttribute failed\n"); grid = -1; return; }
        if (hipOccupancyMaxActiveBlocksPerMultiprocessor(&per_cu, (const void*)mega_fwd, 512, LDS_BYTES) != hipSuccess || per_cu < 1) { fprintf(stderr, "kernel_launch: occupancy query says %d\n", per_cu); per_cu = 1; }
        (void)hipGetLastError();
        grid = cus;
    }
    if (grid < 0) return;
    Args a{};
    for (int i = 0; i < 13; ++i) a.in[i] = (const float*)d_in[i];
    a.out = (float*)d_out; a.ws = (unsigned char*)d_ws;
#if N_LAUNCH_MODE == 1
    for (int ph = 0; ph < N_PHASES; ++ph) {
        a.ph_lo = ph; a.ph_hi = ph + 1;
        hipLaunchKernelGGL(mega_fwd, dim3(grid), dim3(512), LDS_BYTES, stream, a);
    }
#else
    if (hipMemsetAsync((unsigned char*)d_ws + WS_BAR, 0, BAR_BYTES, stream) != hipSuccess) { fprintf(stderr, "kernel_launch: memset of barrier words failed\n"); return; }
    a.ph_lo = 0; a.ph_hi = 1 + DEPTH * (PH_PER_LAYER + (DUP_SP >= 0 ? 1 : 0));
    void* args[] = {&a};
    hipError_t e = hipLaunchCooperativeKernel((const void*)mega_fwd, dim3(grid), dim3(512), args, LDS_BYTES, stream);
    if (e != hipSuccess) fprintf(stderr, "cooperative launch failed: %s (grid %d)\n", hipGetErrorString(e), grid);
#endif
}
```

```cpp
#include <hip/hip_runtime.h>
#include <hip/hip_cooperative_groups.h>
#include <cstdio>
#include <cstdint>
namespace cg = cooperative_groups;

#ifndef N_LAUNCH_MODE
#define N_LAUNCH_MODE 0
#endif

#ifndef DUP_SP
#define DUP_SP -1
#endif
#ifndef SYNC_REPS
#define SYNC_REPS 1
#endif
#define LAS __attribute__((address_space(3)))
typedef unsigned short bf16_t;
typedef short bf16x8 __attribute__((ext_vector_type(8)));
typedef float f32x4 __attribute__((ext_vector_type(4)));
typedef float f32x2 __attribute__((ext_vector_type(2)));
typedef unsigned u32x4 __attribute__((ext_vector_type(4)));
typedef unsigned u32x2 __attribute__((ext_vector_type(2)));

constexpr int MTOK = 32768, DM = 1024, SEQ = 8192, DEPTH = 4, INC = 7184;
constexpr int NCH = 128;
constexpr float LN_EPS = 1e-5f;
constexpr float DN_ALPHA = 1.6817928305074290f;
constexpr float QSCALE = 0.08838834764831845f;
constexpr size_t UNITB = (size_t)MTOK * 1024 * 2;
constexpr size_t WS_X = 0, WS_QK = 1 * UNITB, WS_V = 2 * UNITB, WS_GA = 3 * UNITB, WS_GB = 4 * UNITB, WS_PIN = 5 * UNITB, WS_F1 = 6 * UNITB, WS_F2 = 7 * UNITB;
constexpr size_t WS_MG = WS_QK;
constexpr size_t WS_US = WS_PIN;
constexpr size_t WS_W1A = WS_F2;
constexpr size_t WS_WM = WS_W1A + (size_t)5120 * 1024 * 2;
constexpr size_t WS_WA = WS_WM + (size_t)2048 * 1024 * 2;
constexpr size_t WS_WB = WS_WA + (size_t)1024 * 1024 * 2;
constexpr size_t WS_WO = WS_WB + (size_t)1024 * 1024 * 2;
constexpr size_t WS_WG = WS_WO + (size_t)1024 * 1024 * 2;
constexpr size_t WS_AL = WS_WG + (size_t)4 * 256 * 256 * 2;
constexpr size_t WS_DF = WS_AL + (size_t)MTOK * 16 * 4;
constexpr size_t WS_BAR = WS_DF + (size_t)2048 * 128 * 4;
constexpr size_t BAR_BYTES = 16384;
constexpr size_t WS_END = WS_BAR + BAR_BYTES;
constexpr int LDS_PHASE = 131072, LDS_BYTES = LDS_PHASE + 64;

#define GAS __attribute__((address_space(1)))
template <class T> __device__ __forceinline__ T gld(const void* p) { return *(const GAS T*)p; }
template <class T> __device__ __forceinline__ void gst(void* p, const T v) { *(GAS T*)p = v; }
template <class T> __device__ __forceinline__ T gldo(const void* ubase, unsigned off) { return *(const GAS T*)((const GAS char*)ubase + off); }
template <class T> __device__ __forceinline__ void gsto(void* ubase, unsigned off, const T v) { *(GAS T*)((GAS char*)ubase + off) = v; }
__device__ __forceinline__ unsigned cvt_pk_bf16(float lo, float hi) { unsigned r; asm volatile("v_cvt_pk_bf16_f32 %0, %1, %2" : "=v"(r) : "v"(lo), "v"(hi)); return r; }
__device__ __forceinline__ float bf_lo(unsigned w) { return __uint_as_float(w << 16); }
__device__ __forceinline__ float bf_hi(unsigned w) { return __uint_as_float(w & 0xffff0000u); }
__device__ __forceinline__ float bf2f(bf16_t b) { return __uint_as_float((unsigned)b << 16); }
__device__ __forceinline__ float sigmoidf_(float z) { return 1.0f / (1.0f + __expf(-z)); }
__device__ __forceinline__ float siluf_(float z) { return z / (1.0f + __expf(-z)); }

namespace pg8 {
constexpr int BM = 256, BK = 64, HALF = 128, HTB = HALF * BK * 2, STAGE_BYTES = 8 * HTB, NXCD = 8, WGM = 8;
__host__ __device__ __forceinline__ int lds_byte(int r, int c) { const int st = (r >> 4) * 2 + (c >> 5), rr = r & 15, cc = c & 31, ob = rr * 64 + cc * 2; return st * 1024 + (ob ^ (((ob >> 9) & 1) << 5)); }
__host__ __device__ __forceinline__ void stage_rc(int b, int& R, int& C) { const int st = b / 1024, sb = b % 1024, swz = sb ^ (((sb >> 9) & 1) << 5); R = (st >> 1) * 16 + swz / 64; C = (st & 1) * 32 + (swz % 64) / 2; }
__host__ __device__ __forceinline__ int perm32(int rho) { const int n = rho >> 4, i = rho & 15; return 8 * (i >> 2) + 4 * n + (i & 3); }

struct Unit { const char* A; const char* B; int pm, pn, kind, keep; };
struct Gemm { int lda, ldb, K; };

struct Sched {
    const char *A0, *A1, *B0, *B1; size_t a_pm, a_pn, b_pn; int nM, nN, nwg, G, c, chain;
    __device__ __forceinline__ bool next(int i, Unit& u) const {
        const int ti = (chain == 2) ? (i >> 1) : i, which = (chain == 2) ? (i & 1) : 0;
        const long L = (long)ti * G + c; if (L >= nwg) return false;
        int wgid = (int)L; { const int q = nwg / NXCD, r = nwg % NXCD, xcd = wgid % NXCD, off = wgid / NXCD; wgid = (xcd < r ? xcd * (q + 1) : r * (q + 1) + (xcd - r) * q) + off; }
        const int nig = WGM * nN, gid = wgid / nig, fm = gid * WGM, gsz = (nM - fm) < WGM ? (nM - fm) : WGM;
        u.pm = fm + ((wgid % nig) % gsz); u.pn = (wgid % nig) / gsz;
        u.A = (which ? A1 : A0) + (size_t)u.pm * a_pm + (size_t)u.pn * a_pn; u.B = (which ? B1 : B0) + (size_t)u.pn * b_pn;
        u.kind = which; u.keep = (chain == 2 && which == 0) ? 1 : 0; return true;
    }
};

template <class Epi>
__device__ __forceinline__ void gemm_phase(LAS unsigned char* lds, const int tid, const Gemm g, const Sched& S, const Epi& E) {
    const int wid = __builtin_amdgcn_readfirstlane(tid >> 6), lane = tid & 63, wr = wid >> 2, wc = wid & 3, fr = lane & 15, fq = lane >> 4;
    const int K = g.K, nt = K / BK;
    unsigned voffA[2], voffB[2];
#pragma unroll
    for (int i = 0; i < 2; ++i) { int R, C; stage_rc(tid * 16 + i * 8192, R, C); const int Rb = Epi::PERM ? ((R & ~31) + perm32(R & 31)) : R;
        voffA[i] = (unsigned)(R * g.lda + C) * 2u; voffB[i] = (unsigned)(Rb * g.ldb + C) * 2u; }
    const size_t kstep = (size_t)(BK * 2);
    const size_t hstepA = (size_t)HALF * g.lda * 2, hstepB = (size_t)HALF * g.ldb * 2;
    const unsigned ldsw = (unsigned)wid * 1024u;
    const int aoff = lds_byte(wr * 64 + fr, fq * 8), boff = lds_byte(wc * 32 + fr, fq * 8);
#define PG8_SA(b, h) (((b) * 2 + (h)) * HTB)
#define PG8_SB(b, h) ((4 + (b) * 2 + (h)) * HTB)
#define PG8_STAGE(bufoff, gbase, voff) do { _Pragma("unroll") for (int _i = 0; _i < 2; ++_i) \
        __builtin_amdgcn_global_load_lds((const unsigned*)((const char*)(gbase) + (voff)[_i]), (LAS unsigned*)(lds + (bufoff) + ldsw + _i * 8192), 16, 0, 0); } while (0)
#define PG8_LDA(dst, b, h) do { _Pragma("unroll") for (int m = 0; m < 4; ++m) _Pragma("unroll") for (int k = 0; k < 2; ++k) dst[m][k] = *(const LAS bf16x8*)(lds + PG8_SA(b, h) + aoff + m * 2048 + k * 1024); } while (0)
#define PG8_LDB(dst, b, h) do { _Pragma("unroll") for (int n = 0; n < 2; ++n) _Pragma("unroll") for (int k = 0; k < 2; ++k) dst[n][k] = *(const LAS bf16x8*)(lds + PG8_SB(b, h) + boff + n * 2048 + k * 1024); } while (0)
#define PG8_MMA(ai, bj, At, Bt) do { __builtin_amdgcn_s_setprio(1); _Pragma("unroll") for (int m = 0; m < 4; ++m) _Pragma("unroll") for (int n = 0; n < 2; ++n) _Pragma("unroll") for (int k = 0; k < 2; ++k) \
        acc[ai][bj][m][n] = __builtin_amdgcn_mfma_f32_16x16x32_bf16(Bt[n][k], At[m][k], acc[ai][bj][m][n], 0, 0, 0); __builtin_amdgcn_s_setprio(0); } while (0)
#define PG8_WAIT_V(n) asm volatile("s_waitcnt vmcnt(" #n ")" ::: "memory")
#define PG8_WAIT_L(n) asm volatile("s_waitcnt lgkmcnt(" #n ")" ::: "memory")
#define PG8_BAR __builtin_amdgcn_s_barrier()
#define PG8_SCHED __builtin_amdgcn_sched_barrier(0)
    Unit cur, nxt; int ui = 0;
    if (!S.next(0, cur)) return;
    f32x4 acc[2][2][4][2];
#pragma unroll
    for (int a = 0; a < 2; ++a)
#pragma unroll
        for (int b = 0; b < 2; ++b)
#pragma unroll
            for (int m = 0; m < 4; ++m)
#pragma unroll
                for (int n = 0; n < 2; ++n) acc[a][b][m][n] = (f32x4){0.f, 0.f, 0.f, 0.f};
    bf16x8 At[4][2], B0[2][2], B1[2][2];
    const char* cA = cur.A; const char* cB = cur.B;
    PG8_STAGE(PG8_SB(0, 0), cB, voffB); PG8_STAGE(PG8_SB(0, 1), cB + hstepB, voffB); PG8_STAGE(PG8_SA(0, 0), cA, voffA); PG8_STAGE(PG8_SA(0, 1), cA + hstepA, voffA);
    if (wr == 1) PG8_BAR;
    PG8_WAIT_V(2); PG8_BAR;
    PG8_STAGE(PG8_SB(1, 0), cB + kstep, voffB); PG8_STAGE(PG8_SA(1, 0), cA + kstep, voffA); PG8_STAGE(PG8_SB(1, 1), cB + hstepB + kstep, voffB);
    PG8_WAIT_V(6); PG8_BAR;
    for (;;) {
        const bool has_next = S.next(ui + 1, nxt);
        const char* nA = has_next ? nxt.A : cA; const char* nB = has_next ? nxt.B : cB;
        for (int t = 0; t < nt; t += 2) {
            const bool last = (t == nt - 2);
            const char* a1 = cA + (size_t)(t + 1) * kstep;
            const char* a2 = last ? nA : cA + (size_t)(t + 2) * kstep; const char* b2 = last ? nB : cB + (size_t)(t + 2) * kstep;
            const char* a3 = a2 + kstep; const char* b3 = b2 + kstep;
            PG8_LDB(B0, 0, 0); PG8_LDB(B1, 0, 1); PG8_SCHED; PG8_LDA(At, 0, 0); PG8_STAGE(PG8_SA(1, 1), a1 + hstepA, voffA);
            PG8_WAIT_V(8); PG8_WAIT_L(0); PG8_BAR; PG8_MMA(0, 0, At, B0); PG8_MMA(0, 1, At, B1); PG8_BAR; PG8_SCHED;
            PG8_LDA(At, 0, 1); PG8_STAGE(PG8_SB(0, 0), b2, voffB); PG8_STAGE(PG8_SB(0, 1), b2 + hstepB, voffB); PG8_STAGE(PG8_SA(0, 0), a2, voffA);
            PG8_WAIT_V(8); PG8_WAIT_L(0); PG8_BAR; PG8_MMA(1, 0, At, B0); PG8_MMA(1, 1, At, B1); PG8_BAR; PG8_SCHED;
            PG8_LDB(B0, 1, 0); PG8_LDB(B1, 1, 1); PG8_SCHED; PG8_LDA(At, 1, 0); PG8_STAGE(PG8_SA(0, 1), a2 + hstepA, voffA);
            PG8_WAIT_V(8); PG8_WAIT_L(0); PG8_BAR; PG8_MMA(0, 0, At, B0); PG8_MMA(0, 1, At, B1); PG8_BAR; PG8_SCHED;
            PG8_LDA(At, 1, 1); PG8_STAGE(PG8_SB(1, 0), b3, voffB); PG8_STAGE(PG8_SB(1, 1), b3 + hstepB, voffB); PG8_STAGE(PG8_SA(1, 0), a3, voffA);
            PG8_WAIT_V(8); PG8_WAIT_L(0); PG8_BAR; PG8_MMA(1, 0, At, B0); PG8_MMA(1, 1, At, B1); PG8_BAR; PG8_SCHED;
        }
        if (wr == 0) PG8_BAR;
        { int t2 = tid; asm volatile("" : "+v"(t2));
          const int l2 = t2 & 63; E(acc, cur, wr, wc, l2 & 15, l2 >> 4); }
        if (!has_next) break;
        if (!cur.keep) {
#pragma unroll
            for (int a = 0; a < 2; ++a)
#pragma unroll
                for (int b = 0; b < 2; ++b)
#pragma unroll
                    for (int m = 0; m < 4; ++m)
#pragma unroll
                        for (int n = 0; n < 2; ++n) acc[a][b][m][n] = (f32x4){0.f, 0.f, 0.f, 0.f};
        }
        cur = nxt; cA = nA; cB = nB; ++ui;
        if (wr == 1) PG8_BAR;
    }
    PG8_WAIT_V(0);
    PG8_BAR;
#undef PG8_SA
#undef PG8_SB
#undef PG8_STAGE
#undef PG8_LDA
#undef PG8_LDB
#undef PG8_MMA
#undef PG8_WAIT_V
#undef PG8_WAIT_L
#undef PG8_BAR
#undef PG8_SCHED
}

struct EpiSplit {
    static constexpr bool PERM = true;
    bf16_t* base;
    __device__ __forceinline__ void operator()(const f32x4 (&acc)[2][2][4][2], const Unit& u, int wr, int wc, int fr, int fq) const {
        const int row0 = u.pm * BM + wr * 64 + fr; const int colt = u.pn * BM; const int t = colt >> 10;
        bf16_t* b = base + (size_t)t * ((size_t)MTOK * 1024); const int col0 = (colt & 1023) + wc * 32 + 8 * fq;
#pragma unroll
        for (int ai = 0; ai < 2; ++ai)
#pragma unroll
            for (int m = 0; m < 4; ++m) { bf16_t* rowp = b + (size_t)(row0 + ai * HALF + m * 16) * 1024 + col0;
#pragma unroll
                for (int bj = 0; bj < 2; ++bj) { const f32x4 v0 = acc[ai][bj][m][0], v1 = acc[ai][bj][m][1];
                    u32x4 w; w.x = cvt_pk_bf16(v0[0], v0[1]); w.y = cvt_pk_bf16(v0[2], v0[3]); w.z = cvt_pk_bf16(v1[0], v1[1]); w.w = cvt_pk_bf16(v1[2], v1[3]);
                    gst<u32x4>(rowp + bj * HALF, w); } }
    }
};
struct EpiSig {
    static constexpr bool PERM = true;
    bf16_t* O; const float* bias;
    __device__ __forceinline__ void operator()(const f32x4 (&acc)[2][2][4][2], const Unit& u, int wr, int wc, int fr, int fq) const {
        const int row0 = u.pm * BM + wr * 64 + fr; const int col0 = u.pn * BM + wc * 32 + 8 * fq;
        f32x4 bv[2][2];
#pragma unroll
        for (int bj = 0; bj < 2; ++bj)
#pragma unroll
            for (int n = 0; n < 2; ++n) bv[bj][n] = gld<f32x4>(bias + col0 + bj * HALF + 4 * n);
#pragma unroll
        for (int ai = 0; ai < 2; ++ai)
#pragma unroll
            for (int m = 0; m < 4; ++m) { bf16_t* rowp = O + (size_t)(row0 + ai * HALF + m * 16) * 2048 + col0;
#pragma unroll
                for (int bj = 0; bj < 2; ++bj) { f32x4 v0 = acc[ai][bj][m][0] + bv[bj][0], v1 = acc[ai][bj][m][1] + bv[bj][1];
#pragma unroll
                    for (int j = 0; j < 4; ++j) { v0[j] = sigmoidf_(v0[j]); v1[j] = sigmoidf_(v1[j]); }
                    u32x4 w; w.x = cvt_pk_bf16(v0[0], v0[1]); w.y = cvt_pk_bf16(v0[2], v0[3]); w.z = cvt_pk_bf16(v1[0], v1[1]); w.w = cvt_pk_bf16(v1[2], v1[3]);
                    gst<u32x4>(rowp + bj * HALF, w); } }
    }
};
struct EpiPool {
    static constexpr bool PERM = true;
    bf16_t* GB; const float* scale; bool dry;
    __device__ __forceinline__ void operator()(const f32x4 (&acc)[2][2][4][2], const Unit& u, int wr, int wc, int fr, int fq) const {
        const int row0 = u.pm * BM + wr * 64 + fr; const int col0 = u.pn * BM + wc * 32 + 8 * fq;
        f32x4 sv[2][2];
#pragma unroll
        for (int bj = 0; bj < 2; ++bj)
#pragma unroll
            for (int n = 0; n < 2; ++n) sv[bj][n] = gld<f32x4>(scale + col0 + bj * HALF + 4 * n);
#pragma unroll
        for (int ai = 0; ai < 2; ++ai)
#pragma unroll
            for (int m = 0; m < 4; ++m) { bf16_t* rowp = GB + (size_t)(row0 + ai * HALF + m * 16) * 1024 + col0;
#pragma unroll
                for (int bj = 0; bj < 2; ++bj) { const u32x4 gw = gld<u32x4>(rowp + bj * HALF);
                    f32x4 v0 = acc[ai][bj][m][0] * sv[bj][0], v1 = acc[ai][bj][m][1] * sv[bj][1];
                    v0[0] *= siluf_(bf_lo(gw.x)); v0[1] *= siluf_(bf_hi(gw.x)); v0[2] *= siluf_(bf_lo(gw.y)); v0[3] *= siluf_(bf_hi(gw.y));
                    v1[0] *= siluf_(bf_lo(gw.z)); v1[1] *= siluf_(bf_hi(gw.z)); v1[2] *= siluf_(bf_lo(gw.w)); v1[3] *= siluf_(bf_hi(gw.w));
                    u32x4 w; w.x = cvt_pk_bf16(v0[0], v0[1]); w.y = cvt_pk_bf16(v0[2], v0[3]); w.z = cvt_pk_bf16(v1[0], v1[1]); w.w = cvt_pk_bf16(v1[2], v1[3]);
                    if (!dry) gst<u32x4>(rowp + bj * HALF, w); } }
    }
};
struct EpiProj {
    static constexpr bool PERM = true;
    const bf16_t* MG; bf16_t* O;
    __device__ __forceinline__ void operator()(f32x4 (&acc)[2][2][4][2], const Unit& u, int wr, int wc, int fr, int fq) const {
        const int row0 = u.pm * BM + wr * 64 + fr; const int col0 = u.pn * BM + wc * 32 + 8 * fq;
        if (u.kind == 0) {
#pragma unroll
            for (int ai = 0; ai < 2; ++ai)
#pragma unroll
                for (int m = 0; m < 4; ++m) { const bf16_t* gp = MG + (size_t)(row0 + ai * HALF + m * 16) * 2048 + col0;
#pragma unroll
                    for (int bj = 0; bj < 2; ++bj) { const u32x4 ga = gld<u32x4>(gp + bj * HALF), gb = gld<u32x4>(gp + 1024 + bj * HALF);
                        f32x4& v0 = acc[ai][bj][m][0]; f32x4& v1 = acc[ai][bj][m][1];
                        v0[0] *= bf_lo(ga.x) * __builtin_amdgcn_rcpf(bf_lo(gb.x)); v0[1] *= bf_hi(ga.x) * __builtin_amdgcn_rcpf(bf_hi(gb.x));
                        v0[2] *= bf_lo(ga.y) * __builtin_amdgcn_rcpf(bf_lo(gb.y)); v0[3] *= bf_hi(ga.y) * __builtin_amdgcn_rcpf(bf_hi(gb.y));
                        v1[0] *= bf_lo(ga.z) * __builtin_amdgcn_rcpf(bf_lo(gb.z)); v1[1] *= bf_hi(ga.z) * __builtin_amdgcn_rcpf(bf_hi(gb.z));
                        v1[2] *= bf_lo(ga.w) * __builtin_amdgcn_rcpf(bf_lo(gb.w)); v1[3] *= bf_hi(ga.w) * __builtin_amdgcn_rcpf(bf_hi(gb.w)); } }
        } else {
#pragma unroll
            for (int ai = 0; ai < 2; ++ai)
#pragma unroll
                for (int m = 0; m < 4; ++m) { const size_t r = (size_t)(row0 + ai * HALF + m * 16); const bf16_t* gp = MG + r * 2048 + 1024 + col0; bf16_t* rowp = O + r * 1024 + col0;
#pragma unroll
                    for (int bj = 0; bj < 2; ++bj) { const u32x4 gb = gld<u32x4>(gp + bj * HALF);
                        const f32x4 v0 = acc[ai][bj][m][0], v1 = acc[ai][bj][m][1];
                        u32x4 w; w.x = cvt_pk_bf16(v0[0] * bf_lo(gb.x), v0[1] * bf_hi(gb.x)); w.y = cvt_pk_bf16(v0[2] * bf_lo(gb.y), v0[3] * bf_hi(gb.y));
                        w.z = cvt_pk_bf16(v1[0] * bf_lo(gb.z), v1[1] * bf_hi(gb.z)); w.w = cvt_pk_bf16(v1[2] * bf_lo(gb.w), v1[3] * bf_hi(gb.w));
                        gst<u32x4>(rowp + bj * HALF, w); } }
        }
    }
};
struct EpiOut {
    static constexpr bool PERM = false;
    const float* xres; float* out; bool dry;
    __device__ __forceinline__ void operator()(const f32x4 (&acc)[2][2][4][2], const Unit& u, int wr, int wc, int fr, int fq) const {
        const int row0 = u.pm * BM + wr * 64 + fr, col0 = u.pn * BM + wc * 32 + 4 * fq;
#pragma unroll
        for (int ai = 0; ai < 2; ++ai)
#pragma unroll
            for (int m = 0; m < 4; ++m) { const size_t off = (size_t)(row0 + ai * HALF + m * 16) * 1024 + col0;
#pragma unroll
                for (int bj = 0; bj < 2; ++bj)
#pragma unroll
                    for (int n = 0; n < 2; ++n) { const f32x4 xs = gld<f32x4>(xres + off + bj * HALF + n * 16);
                        if (!dry) gst<f32x4>(out + off + bj * HALF + n * 16, xs * DN_ALPHA + acc[ai][bj][m][n]); } }
    }
};
}

struct Args { const float* in[13]; float* out; unsigned char* ws; int ph_lo, ph_hi; };
typedef const __attribute__((address_space(4))) Args CArgs;
struct Ctx { int tid, lane, wave, G, bid; };

__device__ __forceinline__ float wave_sum(float v) {
#pragma unroll
    for (int o = 1; o < 64; o <<= 1) v += __shfl_xor(v, o);
    return v;
}

__device__ __forceinline__ void transpose_item(const float* W, int ld_src, int col0, int nblk, int K, bf16_t* WT, int row_off, LAS float* scr, int item, int lane) {
    const int kb = item / nblk, nb = item % nblk, k0 = 64 * kb, n0 = 32 * nb;
#pragma unroll 8
    for (int i = 0; i < 32; ++i) { const int kk = 2 * i + (lane >> 5); scr[kk * 33 + (lane & 31)] = gld<float>(W + (size_t)(k0 + kk) * ld_src + col0 + n0 + (lane & 31)); }
    asm volatile("s_waitcnt lgkmcnt(0)" ::: "memory");
    const int c = lane & 7;
#pragma unroll
    for (int j = 0; j < 4; ++j) { const int n = (lane >> 3) + 8 * j; const LAS float* s = scr + (8 * c) * 33 + n;
        u32x4 o; o.x = cvt_pk_bf16(s[0 * 33], s[1 * 33]); o.y = cvt_pk_bf16(s[2 * 33], s[3 * 33]); o.z = cvt_pk_bf16(s[4 * 33], s[5 * 33]); o.w = cvt_pk_bf16(s[6 * 33], s[7 * 33]);
        gst<u32x4>(WT + (size_t)(row_off + n0 + n) * K + k0 + 8 * c, o); }
    asm volatile("s_waitcnt lgkmcnt(0)" ::: "memory");
}
__device__ __forceinline__ void convert_weights(CArgs& a, const Ctx& cx, LAS unsigned char* lds, int l) {
    LAS float* scr = (LAS float*)(lds + cx.wave * 8448);
    const int gw = cx.bid * 8 + cx.wave, NGW = cx.G * 8;
    unsigned char* ws = a.ws;
    const float* w_in = a.in[1] + (size_t)l * 1024 * INC;
    const float* w_pa = a.in[8] + (size_t)l * 1024 * 1024; const float* w_pb = a.in[9] + (size_t)l * 1024 * 1024; const float* w_o = a.in[10] + (size_t)l * 1024 * 1024;
    const float* w_g = a.in[5] + (size_t)l * 4 * 256 * 256;
    constexpr int I_A = 16 * 96, I_GB = 16 * 32, I_PIN = 16 * 32, I_M = 16 * 64, I_P = 16 * 32, I_G = 4 * 8;
    constexpr int NIT = I_A + I_GB + I_PIN + I_M + 3 * I_P + 4 * I_G;
    for (int it = gw; it < NIT; it += NGW) {
        int r = it;
        if (r < I_A) { transpose_item(w_in, INC, 0, 96, 1024, (bf16_t*)(ws + WS_W1A), 0, scr, r, cx.lane); continue; } r -= I_A;
        if (r < I_GB) { transpose_item(w_in, INC, 4112, 32, 1024, (bf16_t*)(ws + WS_W1A), 3072, scr, r, cx.lane); continue; } r -= I_GB;
        if (r < I_PIN) { transpose_item(w_in, INC, 3088, 32, 1024, (bf16_t*)(ws + WS_W1A), 4096, scr, r, cx.lane); continue; } r -= I_PIN;
        if (r < I_M) { transpose_item(w_in, INC, 5136, 64, 1024, (bf16_t*)(ws + WS_WM), 0, scr, r, cx.lane); continue; } r -= I_M;
        if (r < I_P) { transpose_item(w_pa, 1024, 0, 32, 1024, (bf16_t*)(ws + WS_WA), 0, scr, r, cx.lane); continue; } r -= I_P;
        if (r < I_P) { transpose_item(w_pb, 1024, 0, 32, 1024, (bf16_t*)(ws + WS_WB), 0, scr, r, cx.lane); continue; } r -= I_P;
        if (r < I_P) { transpose_item(w_o, 1024, 0, 32, 1024, (bf16_t*)(ws + WS_WO), 0, scr, r, cx.lane); continue; } r -= I_P;
        const int gi = r / I_G; r -= gi * I_G;
        transpose_item(w_g + (size_t)gi * 65536, 256, 0, 8, 256, (bf16_t*)(ws + WS_WG) + (size_t)gi * 65536, 0, scr, r, cx.lane);
    }
}

__device__ __forceinline__ void row_phase(const Ctx& cx, LAS unsigned char* lds, const float* src, float* dst, bf16_t* xbf, float* AL, const float* walpha  ,
                                          const float* lng, const float* lnb, bool do_ln, bool dry = false) {
    LAS float* WT = (LAS float*)lds;
    if (AL) {
        for (int idx = cx.tid; idx < 16384; idx += 512) { const int k = idx >> 4, c = idx & 15; WT[c * 1028 + k] = gld<float>(walpha + (size_t)k * INC + c); }
    }
    __syncthreads();
    const int gw = cx.bid * 8 + cx.wave, NGW = cx.G * 8, lane = cx.lane;
    f32x4 gj[4], bj[4];
#pragma unroll
    for (int j = 0; j < 4; ++j) { gj[j] = (f32x4){1.f, 1.f, 1.f, 1.f}; bj[j] = (f32x4){0.f, 0.f, 0.f, 0.f}; }
    if (do_ln) {
#pragma unroll
        for (int j = 0; j < 4; ++j) { gj[j] = gld<f32x4>(lng + 256 * j + 4 * lane); bj[j] = gld<f32x4>(lnb + 256 * j + 4 * lane); }
    }
    for (int rg = gw; rg < MTOK / 4; rg += NGW) {
        const size_t m0 = (size_t)rg * 4;
        f32x4 v[4][4];
#pragma unroll
        for (int r = 0; r < 4; ++r)
#pragma unroll
            for (int j = 0; j < 4; ++j) v[r][j] = gld<f32x4>(src + (m0 + r) * 1024 + 256 * j + 4 * lane);
        if (do_ln) {
#pragma unroll
            for (int r = 0; r < 4; ++r) {
                float s = 0.f;
#pragma unroll
                for (int j = 0; j < 4; ++j) s += (v[r][j][0] + v[r][j][1]) + (v[r][j][2] + v[r][j][3]);
                const float mean = wave_sum(s) * (1.f / 1024.f); float s2 = 0.f;
#pragma unroll
                for (int j = 0; j < 4; ++j) { v[r][j] = v[r][j] - mean; s2 += (v[r][j][0] * v[r][j][0] + v[r][j][1] * v[r][j][1]) + (v[r][j][2] * v[r][j][2] + v[r][j][3] * v[r][j][3]); }
                const float rstd = 1.0f / sqrtf(wave_sum(s2) * (1.f / 1024.f) + LN_EPS);
#pragma unroll
                for (int j = 0; j < 4; ++j) { v[r][j] = v[r][j] * rstd * gj[j] + bj[j]; if (!dry) gst<f32x4>(dst + (m0 + r) * 1024 + 256 * j + 4 * lane, v[r][j]); }
            }
        }
        if (xbf) {
#pragma unroll
            for (int r = 0; r < 4; ++r)
#pragma unroll
                for (int j = 0; j < 4; ++j) { u32x2 w; w.x = cvt_pk_bf16(v[r][j][0], v[r][j][1]); w.y = cvt_pk_bf16(v[r][j][2], v[r][j][3]);
                    if (!dry) gst<u32x2>(xbf + (m0 + r) * 1024 + 256 * j + 4 * lane, w); }
        }
        if (AL) {
            float acc[64];
#pragma unroll
            for (int i = 0; i < 64; ++i) acc[i] = 0.f;
#pragma unroll
            for (int c = 0; c < 16; ++c)
#pragma unroll
                for (int j = 0; j < 4; ++j) { const f32x4 w = *(const LAS f32x4*)(WT + c * 1028 + 256 * j + 4 * lane);
#pragma unroll
                    for (int r = 0; r < 4; ++r) acc[r * 16 + c] += (v[r][j][0] * w[0] + v[r][j][1] * w[1]) + (v[r][j][2] * w[2] + v[r][j][3] * w[3]); }
#pragma unroll
            for (int h = 32; h >= 1; h >>= 1) {
                const bool up = (lane & h) != 0;
#pragma unroll
                for (int i = 0; i < h; ++i) { const float keep = up ? acc[i + h] : acc[i]; const float send = up ? acc[i] : acc[i + h]; acc[i] = keep + __shfl_xor(send, h); }
            }
            if (!dry) gst<float>(AL + m0 * 16 + lane, acc[0]);
        }
    }
}

__device__ __forceinline__ void unpack8(const u32x4 w, float (&f)[8]) { f[0] = bf_lo(w.x); f[1] = bf_hi(w.x); f[2] = bf_lo(w.y); f[3] = bf_hi(w.y); f[4] = bf_lo(w.z); f[5] = bf_hi(w.z); f[6] = bf_lo(w.w); f[7] = bf_hi(w.w); }
__device__ __forceinline__ void pool_phase(const Ctx& cx, const bf16_t* pin, bf16_t* pooled) {
    const int NT = (MTOK / 32) * 128;
    for (int q = cx.bid * 512 + cx.tid; q < NT; q += cx.G * 512) {
        const int cg8 = q & 127, seg = q >> 7; const int g = cg8 >> 5; const int w = 2 << g;
        const int t0 = seg * 32, pos0 = t0 & (SEQ - 1);
        const bf16_t* base = pin + (size_t)t0 * 1024 + cg8 * 8;
        float sum[8];
#pragma unroll
        for (int e = 0; e < 8; ++e) sum[e] = 0.f;
        for (int j = 1; j < w; ++j) if (pos0 - j >= 0) { float f[8]; unpack8(gld<u32x4>(base - (size_t)j * 1024), f);
#pragma unroll
            for (int e = 0; e < 8; ++e) sum[e] += f[e]; }
        for (int i = 0; i < 32; ++i) {
            const int pos = pos0 + i; float x[8]; unpack8(gld<u32x4>(base + (size_t)i * 1024), x);
#pragma unroll
            for (int e = 0; e < 8; ++e) sum[e] += x[e];
            if (i > 0 && pos - w >= 0) { float f[8]; unpack8(gld<u32x4>(base + (size_t)(i - w) * 1024), f);
#pragma unroll
                for (int e = 0; e < 8; ++e) sum[e] -= f[e]; }
            const int cnt = (pos + 1 < w) ? (pos + 1) : w; const float inv = 1.0f / (float)cnt;
            u32x4 o; o.x = cvt_pk_bf16(sum[0] * inv - x[0], sum[1] * inv - x[1]); o.y = cvt_pk_bf16(sum[2] * inv - x[2], sum[3] * inv - x[3]);
            o.z = cvt_pk_bf16(sum[4] * inv - x[4], sum[5] * inv - x[5]); o.w = cvt_pk_bf16(sum[6] * inv - x[6], sum[7] * inv - x[7]);
            gst<u32x4>(pooled + (size_t)(t0 + i) * 1024 + cg8 * 8, o);
        }
    }
}

constexpr int L_AL = 0, L_GL = 4096, L_RS = 6144, L_KT = 8192  , L_VT1 = 26624  ;
constexpr int L_QA = 8192, L_KA = 25600, L_QB = 43008, L_KB = 60416, L_VT3 = 77824, L_P = 114688;

__device__ __forceinline__ void gla_G(LAS unsigned char* lds, const float (&w)[16], float bias, int d, int tg, float (&g)[16], float& total) {
    const LAS float* AL_s = (const LAS float*)(lds + L_AL); LAS float* GL_s = (LAS float*)(lds + L_GL);
    float run = 0.f;
#pragma unroll
    for (int tt = 0; tt < 16; ++tt) {
        const LAS f32x4* ap = (const LAS f32x4*)(AL_s + (tg * 16 + tt) * 16);
        const f32x4 a0 = ap[0], a1 = ap[1], a2 = ap[2], a3 = ap[3];
        float z = bias;
        z += a0[0] * w[0]; z += a0[1] * w[1]; z += a0[2] * w[2]; z += a0[3] * w[3];
        z += a1[0] * w[4]; z += a1[1] * w[5]; z += a1[2] * w[6]; z += a1[3] * w[7];
        z += a2[0] * w[8]; z += a2[1] * w[9]; z += a2[2] * w[10]; z += a2[3] * w[11];
        z += a3[0] * w[12]; z += a3[1] * w[13]; z += a3[2] * w[14]; z += a3[3] * w[15];
        const float ls = fminf(z, 0.f) - __logf(1.0f + __expf(-fabsf(z)));
        run += ls * (1.0f / 16.0f);
        g[tt] = run;
    }
    GL_s[tg * 128 + d] = run;
    __syncthreads();
    const float p0 = GL_s[d], p1 = GL_s[128 + d], p2 = GL_s[256 + d], p3 = GL_s[384 + d];
    const float prefix = (tg > 0 ? p0 : 0.f) + (tg > 1 ? p1 : 0.f) + (tg > 2 ? p2 : 0.f);
    total = (p0 + p1) + (p2 + p3);
#pragma unroll
    for (int tt = 0; tt < 16; ++tt) g[tt] += prefix;
}
__device__ __forceinline__ void gla_load_stage(const Ctx& cx, const float* AL, const bf16_t* Vb, int it, f32x4& alr, u32x4 (&vr)[2][2]) {
    const int b = it >> 9, c = (it >> 2) & 127, h = it & 3; const int row0 = b * SEQ + c * 64;
    if (cx.tid < 256) alr = gldo<f32x4>(AL + (size_t)row0 * 16, (unsigned)cx.tid * 16u);
    const bf16_t* vb = Vb + (size_t)row0 * 1024 + h * 256;
#pragma unroll
    for (int i = 0; i < 2; ++i) {
        const int q = cx.tid + 512 * i, tp = q & 31, ng = q >> 5;
        const unsigned off = (unsigned)((2 * tp) * 1024 + ng * 8) * 2u;
        vr[i][0] = gldo<u32x4>(vb, off); vr[i][1] = gldo<u32x4>(vb, off + 2048u);
    }
}
__device__ __forceinline__ void gla_write_stage(const Ctx& cx, LAS unsigned char* lds, int vt_off, const f32x4& alr, const u32x4 (&vr)[2][2]) {
    if (cx.tid < 256) ((LAS f32x4*)(lds + L_AL))[cx.tid] = alr;
    LAS unsigned* VT32 = (LAS unsigned*)(lds + vt_off);
#pragma unroll
    for (int i = 0; i < 2; ++i) {
        const int q = cx.tid + 512 * i, tp = q & 31, ng = q >> 5;
        const u32x4 r0 = vr[i][0], r1 = vr[i][1];
#pragma unroll
        for (int j = 0; j < 4; ++j) {
            VT32[(ng * 8 + 2 * j) * 36 + tp] = (r0[j] & 0xffffu) | (r1[j] << 16);
            VT32[(ng * 8 + 2 * j + 1) * 36 + tp] = (r0[j] >> 16) | (r1[j] & 0xffff0000u);
        }
    }
}

__device__ __forceinline__ void gla_p1(CArgs& a, const Ctx& cx, LAS unsigned char* lds, int l) {
    unsigned char* ws = a.ws;
    const float* AL = (const float*)(ws + WS_AL); const bf16_t* QKb = (const bf16_t*)(ws + WS_QK); const bf16_t* Vb = (const bf16_t*)(ws + WS_V);
    unsigned char* US = ws + WS_US; float* DF = (float*)(ws + WS_DF);
    const float* Wup = a.in[2] + (size_t)l * 16 * 512; const float* balpha = a.in[3] + (size_t)l * 512;
    const int tid = cx.tid, lane = cx.lane, wv = cx.wave, fr = lane & 15, fq = lane >> 4;
    const int d = tid & 127, tg = tid >> 7;
    f32x4 alr = (f32x4){0.f, 0.f, 0.f, 0.f}; u32x4 vr[2][2];
    float w[16], bias = 0.f; int prev_h = -1;
    if (cx.bid < 2048) gla_load_stage(cx, AL, Vb, cx.bid, alr, vr);
    for (int it = cx.bid; it < 2048; it += cx.G) {
        const int b = it >> 9, c = (it >> 2) & 127, h = it & 3; const int row0 = b * SEQ + c * 64; const int slot = (b * 4 + h) * NCH + c;
        __syncthreads();
        gla_write_stage(cx, lds, L_VT1, alr, vr);
        __syncthreads();
        const bf16_t* kb = QKb + (size_t)row0 * 1024 + 512 + h * 128; const unsigned koff = (unsigned)(tg * 16 * 1024 + d) * 2u;
        bf16_t kraw[16];
#pragma unroll
        for (int tt = 0; tt < 16; ++tt) kraw[tt] = gldo<bf16_t>(kb + (size_t)tt * 1024, koff);
        if (h != prev_h) { prev_h = h; bias = gldo<float>(balpha + h * 128, (unsigned)d * 4u);
#pragma unroll
            for (int r = 0; r < 16; ++r) w[r] = gldo<float>(Wup + r * 512 + h * 128, (unsigned)d * 4u); }
        if (it + cx.G < 2048) gla_load_stage(cx, AL, Vb, it + cx.G, alr, vr);
        float g[16], total;
        gla_G(lds, w, bias, d, tg, g, total);
        unsigned pk[8];
#pragma unroll
        for (int tt = 0; tt < 16; tt += 2) { const float k0 = bf2f(kraw[tt]) * __expf(total - g[tt]), k1 = bf2f(kraw[tt + 1]) * __expf(total - g[tt + 1]); pk[tt >> 1] = cvt_pk_bf16(k0, k1); }
        LAS u32x4* kt = (LAS u32x4*)(lds + L_KT + d * 144 + tg * 32);
        kt[0] = (u32x4){pk[0], pk[1], pk[2], pk[3]}; kt[1] = (u32x4){pk[4], pk[5], pk[6], pk[7]};
        if (tg == 0) gsto<float>(DF + (size_t)slot * 128, (unsigned)d * 4u, __expf(total));
        __syncthreads();
        f32x4 acc[8][2];
#pragma unroll
        for (int dt = 0; dt < 8; ++dt) { acc[dt][0] = (f32x4){0.f, 0.f, 0.f, 0.f}; acc[dt][1] = (f32x4){0.f, 0.f, 0.f, 0.f}; }
#pragma unroll
        for (int ks = 0; ks < 2; ++ks) {
            bf16x8 bfr[2];
#pragma unroll
            for (int nn = 0; nn < 2; ++nn) bfr[nn] = *(const LAS bf16x8*)(lds + L_VT1 + ((2 * wv + nn) * 16 + fr) * 144 + ks * 64 + fq * 16);
#pragma unroll
            for (int dt = 0; dt < 8; ++dt) { const bf16x8 af = *(const LAS bf16x8*)(lds + L_KT + (dt * 16 + fr) * 144 + ks * 64 + fq * 16);
#pragma unroll
                for (int nn = 0; nn < 2; ++nn) acc[dt][nn] = __builtin_amdgcn_mfma_f32_16x16x32_bf16(af, bfr[nn], acc[dt][nn], 0, 0, 0); }
        }
        unsigned char* up = US + (size_t)slot * 65536;
#pragma unroll
        for (int dt = 0; dt < 8; ++dt)
#pragma unroll
            for (int nn = 0; nn < 2; ++nn) { u32x2 o; o.x = cvt_pk_bf16(acc[dt][nn][0], acc[dt][nn][1]); o.y = cvt_pk_bf16(acc[dt][nn][2], acc[dt][nn][3]);
                gsto<u32x2>(up + ((2 * wv + nn) * 16) * 256 + (dt * 16) * 2, (unsigned)(fr * 256 + fq * 8), o); }
    }
}
__device__ __forceinline__ void gla_p2(CArgs& a, const Ctx& cx, bool dry) {
    unsigned char* US = a.ws + WS_US; const float* DF = (const float*)(a.ws + WS_DF);
    for (int q = cx.bid * 512 + cx.tid; q < 16 * 8192; q += cx.G * 512) {
        const int bh = q >> 13, within = q & 8191; const int dq = within & 31;
        unsigned char* p = US + (size_t)bh * NCH * 65536 + (size_t)within * 8;
        const float* dfp = DF + (size_t)bh * NCH * 128 + dq * 4;
        float s0 = 0.f, s1 = 0.f, s2 = 0.f, s3 = 0.f;
        for (int cb = 0; cb < NCH; cb += 16) {
            u32x2 u[16]; f32x4 df[16];
#pragma unroll
            for (int i = 0; i < 16; ++i) { u[i] = gld<u32x2>(p + (size_t)(cb + i) * 65536); df[i] = gld<f32x4>(dfp + (size_t)(cb + i) * 128); }
#pragma unroll
            for (int i = 0; i < 16; ++i) {
                s0 = df[i][0] * s0 + bf_lo(u[i].x); s1 = df[i][1] * s1 + bf_hi(u[i].x); s2 = df[i][2] * s2 + bf_lo(u[i].y); s3 = df[i][3] * s3 + bf_hi(u[i].y);
                u32x2 o; o.x = cvt_pk_bf16(s0, s1); o.y = cvt_pk_bf16(s2, s3);
                if (!dry) gst<u32x2>(p + (size_t)(cb + i) * 65536, o);
            }
        }
    }
}
__device__ __forceinline__ void gla_p3(CArgs& a, const Ctx& cx, LAS unsigned char* lds, int l, bool dry) {
    unsigned char* ws = a.ws;
    const float* AL = (const float*)(ws + WS_AL); const bf16_t* QKb = (const bf16_t*)(ws + WS_QK); const bf16_t* Vb = (const bf16_t*)(ws + WS_V);
    const unsigned char* US = ws + WS_US; bf16_t* GA = (bf16_t*)(ws + WS_GA);
    const float* Wup = a.in[2] + (size_t)l * 16 * 512; const float* balpha = a.in[3] + (size_t)l * 512; const float* gnorm = a.in[4] + (size_t)l * 1024;
    const int tid = cx.tid, lane = cx.lane, wv = cx.wave, fr = lane & 15, fq = lane >> 4;
    const int d = tid & 127, tg = tid >> 7;
    const int tp = wv & 1, nq = wv >> 1;
    f32x4 alr = (f32x4){0.f, 0.f, 0.f, 0.f}; u32x4 vr[2][2];
    if (cx.bid < 2048) gla_load_stage(cx, AL, Vb, cx.bid, alr, vr);
    for (int it = cx.bid; it < 2048; it += cx.G) {
        const int b = it >> 9, c = (it >> 2) & 127, h = it & 3; const int row0 = b * SEQ + c * 64; const int slot = (b * 4 + h) * NCH + c;
        __syncthreads();
        gla_write_stage(cx, lds, L_VT3, alr, vr);
        __syncthreads();
        const bf16_t* qb = QKb + (size_t)row0 * 1024 + h * 128; const unsigned qoff = (unsigned)(tg * 16 * 1024 + d) * 2u;
        bf16_t qraw[16], kraw[16];
#pragma unroll
        for (int tt = 0; tt < 16; ++tt) { qraw[tt] = gldo<bf16_t>(qb + (size_t)tt * 1024, qoff); kraw[tt] = gldo<bf16_t>(qb + 512 + (size_t)tt * 1024, qoff); }
        const unsigned char* sp = US + (size_t)(c > 0 ? slot - 1 : slot) * 65536 + nq * 64 * 256; const unsigned soff = (unsigned)(fr * 256 + fq * 16);
        bf16x8 sf[4][4];
        if (c > 0) {
#pragma unroll
            for (int nt = 0; nt < 4; ++nt)
#pragma unroll
                for (int ks = 0; ks < 4; ++ks) sf[nt][ks] = gldo<bf16x8>(sp + nt * 4096 + ks * 64, soff);
        }
        float g[16], total;
        {   float w[16]; const float bias = gldo<float>(balpha + h * 128, (unsigned)d * 4u);
#pragma unroll
            for (int r = 0; r < 16; ++r) w[r] = gldo<float>(Wup + r * 512 + h * 128, (unsigned)d * 4u);
            if (it + cx.G < 2048) gla_load_stage(cx, AL, Vb, it + cx.G, alr, vr);
            gla_G(lds, w, bias, d, tg, g, total); }
        {
            LAS bf16_t* QA = (LAS bf16_t*)(lds + L_QA); LAS bf16_t* KA = (LAS bf16_t*)(lds + L_KA); LAS bf16_t* QB = (LAS bf16_t*)(lds + L_QB); LAS bf16_t* KB = (LAS bf16_t*)(lds + L_KB);
#pragma unroll
            for (int tt = 0; tt < 16; ++tt) {
                const float qv = bf2f(qraw[tt]) * QSCALE, kv = bf2f(kraw[tt]); const float eg = __expf(g[tt]), ei = __expf(-g[tt]);
                const int o = (tg * 16 + tt) * 136 + d;
                const unsigned w0 = cvt_pk_bf16(qv * eg, kv * ei), w1 = cvt_pk_bf16(qv * ei, kv * eg);
                QA[o] = (bf16_t)(w0 & 0xffffu); KA[o] = (bf16_t)(w0 >> 16); QB[o] = (bf16_t)(w1 & 0xffffu); KB[o] = (bf16_t)(w1 >> 16);
            }
        }
        __syncthreads();
#pragma unroll
        for (int x = 0; x < 2; ++x) {
            const int tile = 2 * wv + x, tix = tile >> 2, si = tile & 3;
            f32x4 a1 = (f32x4){0.f, 0.f, 0.f, 0.f}, a2 = (f32x4){0.f, 0.f, 0.f, 0.f};
            if (tix >= si) {
#pragma unroll
                for (int ks = 0; ks < 4; ++ks) { const bf16x8 af = *(const LAS bf16x8*)(lds + L_KA + (si * 16 + fr) * 272 + ks * 64 + fq * 16), bfv = *(const LAS bf16x8*)(lds + L_QA + (tix * 16 + fr) * 272 + ks * 64 + fq * 16);
                    a1 = __builtin_amdgcn_mfma_f32_16x16x32_bf16(af, bfv, a1, 0, 0, 0); }
            }
            if (tix <= si) {
#pragma unroll
                for (int ks = 0; ks < 4; ++ks) { const bf16x8 af = *(const LAS bf16x8*)(lds + L_KB + (si * 16 + fr) * 272 + ks * 64 + fq * 16), bfv = *(const LAS bf16x8*)(lds + L_QB + (tix * 16 + fr) * 272 + ks * 64 + fq * 16);
                    a2 = __builtin_amdgcn_mfma_f32_16x16x32_bf16(af, bfv, a2, 0, 0, 0); }
            }
            const int t = tix * 16 + fr, s0 = si * 16 + fq * 4;
            const float p0 = (t >= s0) ? a1[0] : a2[0], p1 = (t >= s0 + 1) ? a1[1] : a2[1], p2 = (t >= s0 + 2) ? a1[2] : a2[2], p3 = (t >= s0 + 3) ? a1[3] : a2[3];
            u32x2 o; o.x = cvt_pk_bf16(p0, p1); o.y = cvt_pk_bf16(p2, p3);
            *(LAS u32x2*)(lds + L_P + t * 144 + s0 * 2) = o;
        }
        bf16_t* gp = GA + (size_t)row0 * 1024 + h * 256 + nq * 64; const unsigned goff = (unsigned)((2 * tp * 16 + fr) * 1024 + fq * 4) * 2u;
        u32x2 gwv[2][4];
#pragma unroll
        for (int x = 0; x < 2; ++x)
#pragma unroll
            for (int nt = 0; nt < 4; ++nt) gwv[x][nt] = gldo<u32x2>(gp + (size_t)x * 16 * 1024 + nt * 16, goff);
        __syncthreads();
        f32x4 acc[2][4];
#pragma unroll
        for (int x = 0; x < 2; ++x)
#pragma unroll
            for (int i = 0; i < 4; ++i) acc[x][i] = (f32x4){0.f, 0.f, 0.f, 0.f};
        bf16x8 bP[2][2], bQ[2][4];
#pragma unroll
        for (int x = 0; x < 2; ++x) {
#pragma unroll
            for (int ks = 0; ks < 2; ++ks) bP[x][ks] = *(const LAS bf16x8*)(lds + L_P + ((2 * tp + x) * 16 + fr) * 144 + ks * 64 + fq * 16);
#pragma unroll
            for (int ks = 0; ks < 4; ++ks) bQ[x][ks] = *(const LAS bf16x8*)(lds + L_QA + ((2 * tp + x) * 16 + fr) * 272 + ks * 64 + fq * 16);
        }
#pragma unroll
        for (int nt = 0; nt < 4; ++nt) {
            const int n = (nq * 4 + nt) * 16 + fr;
#pragma unroll
            for (int ks = 0; ks < 2; ++ks) { const bf16x8 af = *(const LAS bf16x8*)(lds + L_VT3 + n * 144 + ks * 64 + fq * 16);
#pragma unroll
                for (int x = 0; x < 2; ++x) acc[x][nt] = __builtin_amdgcn_mfma_f32_16x16x32_bf16(af, bP[x][ks], acc[x][nt], 0, 0, 0); }
        }
        if (c > 0) {
#pragma unroll
            for (int nt = 0; nt < 4; ++nt)
#pragma unroll
                for (int ks = 0; ks < 4; ++ks)
#pragma unroll
                    for (int x = 0; x < 2; ++x) acc[x][nt] = __builtin_amdgcn_mfma_f32_16x16x32_bf16(sf[nt][ks], bQ[x][ks], acc[x][nt], 0, 0, 0);
        }
        LAS float* RS = (LAS float*)(lds + L_RS);
#pragma unroll
        for (int x = 0; x < 2; ++x) {
            float ss = 0.f;
#pragma unroll
            for (int nt = 0; nt < 4; ++nt) ss += (acc[x][nt][0] * acc[x][nt][0] + acc[x][nt][1] * acc[x][nt][1]) + (acc[x][nt][2] * acc[x][nt][2] + acc[x][nt][3] * acc[x][nt][3]);
            ss += __shfl_xor(ss, 16); ss += __shfl_xor(ss, 32);
            if (fq == 0) RS[((2 * tp + x) * 16 + fr) * 4 + nq] = ss;
        }
        __syncthreads();
#pragma unroll
        for (int x = 0; x < 2; ++x) {
            const f32x4 r4 = *(const LAS f32x4*)(RS + ((2 * tp + x) * 16 + fr) * 4);
            const float rinv = 1.0f / sqrtf(((r4[0] + r4[1]) + (r4[2] + r4[3])) * (1.0f / 256.0f) + LN_EPS);
#pragma unroll
            for (int nt = 0; nt < 4; ++nt) {
                const f32x4 gn = gldo<f32x4>(gnorm + h * 256 + nq * 64 + nt * 16, (unsigned)(fq * 4) * 4u);
                const u32x2 gw = gwv[x][nt];
                const float y0 = acc[x][nt][0] * rinv * gn[0] * siluf_(bf_lo(gw.x)), y1 = acc[x][nt][1] * rinv * gn[1] * siluf_(bf_hi(gw.x));
                const float y2 = acc[x][nt][2] * rinv * gn[2] * siluf_(bf_lo(gw.y)), y3 = acc[x][nt][3] * rinv * gn[3] * siluf_(bf_hi(gw.y));
                u32x2 o; o.x = cvt_pk_bf16(y0, y1); o.y = cvt_pk_bf16(y2, y3);
                if (!dry) gsto<u32x2>(gp + (size_t)x * 16 * 1024 + nt * 16, goff, o);
            }
        }
    }
}

#define XB_TMO      128
#define XB_XCNT(j)  (256  + 64 * (j))
#define XB_XSUB(j)  (1280 + 64 * (j))
#define XB_XGEN(j)  (2304 + 64 * (j))
#define XB_TOP      3328
#define XB_TOPGEN   3392
#define XCD_BAR_WORDS 3456
#define XB_SPIN_CAP (1u << 22)
__device__ __forceinline__ unsigned xb_ld(unsigned* p)              { return __hip_atomic_load(p, __ATOMIC_RELAXED, __HIP_MEMORY_SCOPE_AGENT); }
__device__ __forceinline__ unsigned xb_add(unsigned* p, unsigned v) { return __hip_atomic_fetch_add(p, v, __ATOMIC_RELAXED, __HIP_MEMORY_SCOPE_AGENT); }
__device__ __forceinline__ unsigned xb_xcc_id() { return (unsigned)__builtin_amdgcn_s_getreg((3 << 11) | 20) & 0xFu; }
#define XB_SPIN(cond, bar) do { unsigned _sp = 0; while (cond) { __builtin_amdgcn_s_sleep(1); \
    if ((++_sp & 255u) == 0u) { if (xb_ld(&(bar)[XB_TMO])) break; if (_sp > XB_SPIN_CAP) { atomicAdd(&(bar)[XB_TMO], 1u); break; } } } } while (0)
struct XcdBarrier { unsigned* bar; unsigned x; volatile LAS unsigned* st; };
__device__ __forceinline__ XcdBarrier xcd_barrier_post(unsigned* bar, volatile LAS unsigned* st) {
    XcdBarrier b; b.bar = bar; b.x = xb_xcc_id(); b.st = st;
    if (threadIdx.x == 0) (void)xb_add(&bar[XB_XCNT(b.x)], 1u);
    return b;
}
__device__ __forceinline__ void xcd_barrier_complete(unsigned* bar, unsigned x, unsigned& nloc, unsigned& nx) {
    const unsigned G = gridDim.x * gridDim.y * gridDim.z;
    unsigned sum, cnt, mine, sp = 0u;
    for (;;) {
        sum = 0u; cnt = 0u; mine = 0u;
#pragma unroll
        for (unsigned j = 0; j < 16; ++j) { const unsigned c = xb_ld(&bar[XB_XCNT(j)]); sum += c; cnt += (c > 0u) ? 1u : 0u; mine = (j == x) ? c : mine; }
        if (sum == G) break;
        __builtin_amdgcn_s_sleep(1);
        if ((++sp & 255u) == 0u) { if (xb_ld(&bar[XB_TMO])) break; if (sp > XB_SPIN_CAP) { atomicAdd(&bar[XB_TMO], 1u); break; } }
    }
    nloc = mine > 0u ? mine : 1u; nx = cnt > 0u ? cnt : 1u;
}
__device__ __forceinline__ void xcd_barrier(const XcdBarrier& b) {
    asm volatile("s_waitcnt vmcnt(0)" ::: "memory");
    __syncthreads();
    if (threadIdx.x == 0) {
        unsigned* bar; { const unsigned long long v = (unsigned long long)b.bar;
            unsigned lo = (unsigned)__builtin_amdgcn_readfirstlane((unsigned)v), hi = (unsigned)__builtin_amdgcn_readfirstlane((unsigned)(v >> 32));
            asm volatile("" : "+s"(lo), "+s"(hi)); bar = (unsigned*)(((unsigned long long)hi << 32) | lo); }
        __builtin_amdgcn_s_waitcnt(0);
        unsigned nloc = b.st[0], nx = b.st[1];
        if (nloc == 0u) { xcd_barrier_complete(bar, b.x, nloc, nx); b.st[0] = nloc; b.st[1] = nx; }
        const unsigned old = xb_add(&bar[XB_XSUB(b.x)], 1u);
        const unsigned gen = old / nloc;
        if (old + 1u == (gen + 1u) * nloc) {
            __builtin_amdgcn_fence(__ATOMIC_RELEASE, "agent");
            asm volatile("s_waitcnt vmcnt(0)" ::: "memory");
            const unsigned og = xb_add(&bar[XB_TOP], 1u);
            const unsigned tg = og / nx;
            if (og + 1u == (tg + 1u) * nx) xb_add(&bar[XB_TOPGEN], 1u);
            else XB_SPIN(xb_ld(&bar[XB_TOPGEN]) == tg, bar);
            __builtin_amdgcn_fence(__ATOMIC_ACQUIRE, "agent");
            xb_add(&bar[XB_XGEN(b.x)], 1u);
            asm volatile("s_waitcnt vmcnt(0)" ::: "memory");
        } else {
            XB_SPIN(xb_ld(&bar[XB_XGEN(b.x)]) == gen, bar);
            __builtin_amdgcn_fence(__ATOMIC_ACQUIRE, "agent");
            asm volatile("s_waitcnt vmcnt(0)" ::: "memory");
        }
    }
    __syncthreads();
}

constexpr int PH_PER_LAYER = 10, N_PHASES = 1 + DEPTH * PH_PER_LAYER;

__device__ __forceinline__ void run_phase(CArgs& a, const Ctx& cx, LAS unsigned char* lds, int ph, bool dry) {
    unsigned char* ws = a.ws;
    if (ph == 0) {
        convert_weights(a, cx, lds, 0);
        __syncthreads();
        row_phase(cx, lds, a.in[0], nullptr, (bf16_t*)(ws + WS_X), (float*)(ws + WS_AL), a.in[1] + 3072, nullptr, nullptr, false);
        return;
    }
    const int l = (ph - 1) / PH_PER_LAYER; int sp = (ph - 1) % PH_PER_LAYER;
#ifdef ONLY_SP
    sp = ONLY_SP;
#endif
    pg8::Sched S; S.G = cx.G; S.c = cx.bid; S.chain = 1; S.A1 = nullptr; S.B1 = nullptr; S.a_pn = 0; S.nM = MTOK / 256;
    switch (sp) {
    case 0: {
        S.A0 = (const char*)(ws + WS_X); S.B0 = (const char*)(ws + WS_W1A); S.a_pm = (size_t)256 * 1024 * 2; S.b_pn = (size_t)256 * 1024 * 2; S.nN = 20; S.nwg = S.nM * S.nN;
        pg8::EpiSplit E{(bf16_t*)(ws + WS_QK)};
        pg8::gemm_phase<pg8::EpiSplit>(lds, cx.tid, pg8::Gemm{1024, 1024, 1024}, S, E);
    } break;
    case 1: pool_phase(cx, (const bf16_t*)(ws + WS_PIN), (bf16_t*)(ws + WS_F1)); break;
    case 2: {
        S.A0 = (const char*)(ws + WS_F1); S.B0 = (const char*)(ws + WS_WG); S.a_pm = (size_t)256 * 1024 * 2; S.a_pn = 256 * 2; S.b_pn = (size_t)65536 * 2; S.nN = 4; S.nwg = S.nM * S.nN;
        pg8::EpiPool E{(bf16_t*)(ws + WS_GB), a.in[6] + (size_t)l * 1024, dry};
        pg8::gemm_phase<pg8::EpiPool>(lds, cx.tid, pg8::Gemm{1024, 256, 256}, S, E);
    } break;
    case 3: gla_p1(a, cx, lds, l); break;
    case 4: gla_p2(a, cx, dry); break;
    case 5: gla_p3(a, cx, lds, l, dry); break;
    case 6: {
        S.A0 = (const char*)(ws + WS_X); S.B0 = (const char*)(ws + WS_WM); S.a_pm = (size_t)256 * 1024 * 2; S.b_pn = (size_t)256 * 1024 * 2; S.nN = 8; S.nwg = S.nM * S.nN;
        pg8::EpiSig E{(bf16_t*)(ws + WS_MG), a.in[7] + (size_t)l * 2048};
        pg8::gemm_phase<pg8::EpiSig>(lds, cx.tid, pg8::Gemm{1024, 1024, 1024}, S, E);
    } break;
    case 7: {
        S.chain = 2; S.A0 = (const char*)(ws + WS_GA); S.A1 = (const char*)(ws + WS_GB); S.B0 = (const char*)(ws + WS_WA); S.B1 = (const char*)(ws + WS_WB);
        S.a_pm = (size_t)256 * 1024 * 2; S.b_pn = (size_t)256 * 1024 * 2; S.nN = 4; S.nwg = S.nM * S.nN;
        pg8::EpiProj E{(const bf16_t*)(ws + WS_MG), (bf16_t*)(ws + WS_PIN)};
        pg8::gemm_phase<pg8::EpiProj>(lds, cx.tid, pg8::Gemm{1024, 1024, 1024}, S, E);
    } break;
    case 8: {
        S.A0 = (const char*)(ws + WS_PIN); S.B0 = (const char*)(ws + WS_WO); S.a_pm = (size_t)256 * 1024 * 2; S.b_pn = (size_t)256 * 1024 * 2; S.nN = 4; S.nwg = S.nM * S.nN;
        pg8::EpiOut E{l == 0 ? a.in[0] : a.out, a.out, dry};
        pg8::gemm_phase<pg8::EpiOut>(lds, cx.tid, pg8::Gemm{1024, 1024, 1024}, S, E);
    } break;
    default: {
        const bool more = (l + 1 < DEPTH);
        if (more) { convert_weights(a, cx, lds, l + 1); __syncthreads(); }
        row_phase(cx, lds, a.out, a.out, more ? (bf16_t*)(ws + WS_X) : nullptr, more ? (float*)(ws + WS_AL) : nullptr,
                  a.in[1] + (size_t)(more ? l + 1 : l) * 1024 * INC + 3072, a.in[11] + (size_t)l * 1024, a.in[12] + (size_t)l * 1024, true, dry);
    } break;
    }
}

__global__ void __launch_bounds__(512, 2) mega_fwd(Args a) {
    extern __shared__ __attribute__((aligned(16))) unsigned char lds_raw[];
    LAS unsigned char* lds = (LAS unsigned char*)lds_raw;
    cg::grid_group grid = cg::this_grid();
    if (threadIdx.x < 16) ((LAS unsigned*)(lds + LDS_PHASE))[threadIdx.x] = 0u;
    __syncthreads();
    const XcdBarrier bar = xcd_barrier_post((unsigned*)(a.ws + WS_BAR), (volatile LAS unsigned*)(lds + LDS_PHASE));
    constexpr int PPL = PH_PER_LAYER + (DUP_SP >= 0 ? 1 : 0);
    for (int idx = a.ph_lo; idx < a.ph_hi; ++idx) {
        if (idx > a.ph_lo) { if (a.ph_lo < 0) grid.sync();
            for (int r = 0; r < SYNC_REPS; ++r) xcd_barrier(bar); }
        int ph = 0; bool dry = false;
        if (idx > 0) { const int l = (idx - 1) / PPL, e = (idx - 1) % PPL; const int sp = (DUP_SP >= 0 && e > DUP_SP) ? e - 1 : e; ph = 1 + l * PH_PER_LAYER + sp; dry = (DUP_SP >= 0 && e == DUP_SP); }
        int tid = threadIdx.x; asm volatile("" : "+v"(tid));
        Ctx cx; cx.tid = tid; cx.lane = tid & 63; cx.wave = __builtin_amdgcn_readfirstlane(tid >> 6); cx.G = gridDim.x; cx.bid = blockIdx.x;
        CArgs* kp = (CArgs*)__builtin_amdgcn_kernarg_segment_ptr(); asm volatile("" : "+s"(kp));
        run_phase(*kp, cx, lds, ph, dry);
    }
}

extern "C" void kernel_launch(void* const* d_in, const int* in_sizes, int n_in, void* d_out, int out_size, void* d_ws, size_t ws_size, hipStream_t stream) {
    static int grid = 0;
    if (grid == 0) {
        if (n_in != 13 || in_sizes[0] != MTOK * DM || out_size != MTOK * DM || ws_size < WS_END) {
            fprintf(stderr, "kernel_launch: unexpected shapes (n_in %d, in0 %d, out %d, ws %zu, need %zu); nothing launched\n", n_in, n_in > 0 ? in_sizes[0] : -1, out_size, ws_size, (size_t)WS_END); grid = -1; return; }
        int dev = 0, cus = 0, per_cu = 0;
        if (hipGetDevice(&dev) != hipSuccess || hipDeviceGetAttribute(&cus, hipDeviceAttributeMultiprocessorCount, dev) != hipSuccess) { grid = -1; return; }
        if (hipFuncSetAttribute((const void*)mega_fwd, hipFuncAttributeMaxDynamicSharedMemorySize, LDS_BYTES) != hipSuccess) { fprintf(stderr, "kernel_launch: hipFuncSetAttribute failed\n"); grid = -1; return; }
        if (hipOccupancyMaxActiveBlocksPerMultiprocessor(&per_cu, (const void*)mega_fwd, 512, LDS_BYTES) != hipSuccess || per_cu < 1) { fprintf(stderr, "kernel_launch: occupancy query says %d\n", per_cu); per_cu = 1; }
        (void)hipGetLastError();
        grid = cus;
    }
    if (grid < 0) return;
    Args a{};
    for (int i = 0; i < 13; ++i) a.in[i] = (const float*)d_in[i];
    a.out = (float*)d_out; a.ws = (unsigned char*)d_ws;
#if N_LAUNCH_MODE == 1
    for (int ph = 0; ph < N_PHASES; ++ph) {
        a.ph_lo = ph; a.ph_hi = ph + 1;
        hipLaunchKernelGGL(mega_fwd, dim3(grid), dim3(512), LDS_BYTES, stream, a);
    }
#else
    if (hipMemsetAsync((unsigned char*)d_ws + WS_BAR, 0, BAR_BYTES, stream) != hipSuccess) { fprintf(stderr, "kernel_launch: memset of barrier words failed\n"); return; }
    a.ph_lo = 0; a.ph_hi = 1 + DEPTH * (PH_PER_LAYER + (DUP_SP >= 0 ? 1 : 0));
    void* args[] = {&a};
    hipError_t e = hipLaunchCooperativeKernel((const void*)mega_fwd, dim3(grid), dim3(512), args, LDS_BYTES, stream);
    if (e != hipSuccess) fprintf(stderr, "cooperative launch failed: %s (grid %d)\n", hipGetErrorString(e), grid);
#endif
}
```

```cpp
#include <hip/hip_runtime.h>
#include <hip/hip_cooperative_groups.h>
#include <cstdio>
#include <cstdint>
namespace cg = cooperative_groups;

#ifndef N_LAUNCH_MODE
#define N_LAUNCH_MODE 0
#endif

#ifndef DUP_SP
#define DUP_SP -1
#endif
#ifndef PROBE_SP
#define PROBE_SP -1
#endif
#ifndef SYNC_REPS
#define SYNC_REPS 1
#endif
#define LAS __attribute__((address_space(3)))
typedef unsigned short bf16_t;
typedef short bf16x8 __attribute__((ext_vector_type(8)));
typedef float f32x4 __attribute__((ext_vector_type(4)));
typedef float f32x2 __attribute__((ext_vector_type(2)));
typedef unsigned u32x4 __attribute__((ext_vector_type(4)));
typedef unsigned u32x2 __attribute__((ext_vector_type(2)));

constexpr int MTOK = 32768, DM = 1024, SEQ = 8192, DEPTH = 4, INC = 7184;
constexpr int NCH = 128;
constexpr float LN_EPS = 1e-5f;
constexpr float DN_ALPHA = 1.6817928305074290f;
constexpr float QSCALE = 0.08838834764831845f;
constexpr size_t UNITB = (size_t)MTOK * 1024 * 2;
constexpr size_t WS_X = 0, WS_QK = 1 * UNITB, WS_V = 2 * UNITB, WS_GA = 3 * UNITB, WS_GB = 4 * UNITB, WS_PIN = 5 * UNITB, WS_F1 = 6 * UNITB, WS_F2 = 7 * UNITB;
constexpr size_t WS_MG = WS_QK;
constexpr size_t WS_US = WS_PIN;
constexpr size_t WS_W1A = WS_F2;
constexpr size_t WS_WM = WS_W1A + (size_t)5120 * 1024 * 2;
constexpr size_t WS_WA = WS_WM + (size_t)2048 * 1024 * 2;
constexpr size_t WS_WB = WS_WA + (size_t)1024 * 1024 * 2;
constexpr size_t WS_WO = WS_WB + (size_t)1024 * 1024 * 2;
constexpr size_t WS_WG = WS_WO + (size_t)1024 * 1024 * 2;
constexpr size_t WSET_BYTES = WS_WG + (size_t)4 * 256 * 256 * 2 - WS_W1A;
constexpr size_t WS_AL = WS_W1A + 2 * WSET_BYTES;
constexpr size_t WS_DF = WS_AL + (size_t)MTOK * 16 * 4;
constexpr size_t WS_BAR = WS_DF + (size_t)2048 * 128 * 4;
constexpr size_t BAR_BYTES = 5 * 16384;
constexpr size_t WS_CTR = WS_BAR + BAR_BYTES;
constexpr size_t CTR_BYTES = 1024;
constexpr size_t WS_END = WS_CTR + CTR_BYTES;
constexpr int LDS_PHASE = 135168, LDS_BYTES = LDS_PHASE + 64;

#define GAS __attribute__((address_space(1)))
template <class T> __device__ __forceinline__ T gld(const void* p) { return *(const GAS T*)p; }
template <class T> __device__ __forceinline__ void gst(void* p, const T v) { *(GAS T*)p = v; }
template <class T> __device__ __forceinline__ T gldo(const void* ubase, unsigned off) { return *(const GAS T*)((const GAS char*)ubase + off); }
template <class T> __device__ __forceinline__ void gsto(void* ubase, unsigned off, const T v) { *(GAS T*)((GAS char*)ubase + off) = v; }
typedef __bf16 bf16x2_t __attribute__((ext_vector_type(2)));
__device__ __forceinline__ size_t us_off(int b, int h, int c) { return (size_t)(h >> 1) * UNITB + (size_t)b * ((size_t)16 << 20) + (size_t)((h & 1) * NCH + c) * 65536; }
__device__ __forceinline__ unsigned cvt_pk_bf16_n(float lo, float hi) { const f32x2 v = {lo, hi}; const bf16x2_t b = __builtin_convertvector(v, bf16x2_t); return __builtin_bit_cast(unsigned, b); }
__device__ __forceinline__ unsigned cvt_pk_bf16(float lo, float hi) { unsigned r; asm volatile("s_nop 0\n\tv_cvt_pk_bf16_f32 %0, %1, %2" : "=v"(r) : "v"(lo), "v"(hi)); return r; }
__device__ __forceinline__ float bf_lo(unsigned w) { return __uint_as_float(w << 16); }
__device__ __forceinline__ float bf_hi(unsigned w) { return __uint_as_float(w & 0xffff0000u); }
__device__ __forceinline__ float bf2f(bf16_t b) { return __uint_as_float((unsigned)b << 16); }
__device__ __forceinline__ float sigmoidf_(float z) { return __builtin_amdgcn_rcpf(1.0f + __expf(-z)); }
__device__ __forceinline__ float siluf_(float z) { return z * __builtin_amdgcn_rcpf(1.0f + __expf(-z)); }

namespace pg8 {
constexpr int BM = 256, BK = 64, HALF = 128, HTB = HALF * BK * 2, STAGE_BYTES = 8 * HTB, NXCD = 8, WGM = 8;
__host__ __device__ __forceinline__ int lds_byte(int r, int c) { const int st = (r >> 4) * 2 + (c >> 5), rr = r & 15, cc = c & 31, ob = rr * 64 + cc * 2; return st * 1024 + (ob ^ (((ob >> 9) & 1) << 5)); }
__host__ __device__ __forceinline__ void stage_rc(int b, int& R, int& C) { const int st = b / 1024, sb = b % 1024, swz = sb ^ (((sb >> 9) & 1) << 5); R = (st >> 1) * 16 + swz / 64; C = (st & 1) * 32 + (swz % 64) / 2; }
__host__ __device__ __forceinline__ int perm32(int rho) { const int n = rho >> 4, i = rho & 15; return 8 * (i >> 2) + 4 * n + (i & 3); }

struct Unit { const char* A; const char* B; int pm, pn, kind, keep; };
struct Gemm { int lda, ldb, K; };

struct Sched {
    const char *A0, *A1, *B0, *B1; size_t a_pm, a_pn, b_pn; int nM, nN, nwg, G, c, chain;
    __device__ __forceinline__ bool next(int i, Unit& u) const {
        const int ti = (chain == 2) ? (i >> 1) : i, which = (chain == 2) ? (i & 1) : 0;
        const long L = (long)ti * G + c; if (L >= nwg) return false;
        int wgid = (int)L; { const int q = nwg / NXCD, r = nwg % NXCD, xcd = wgid % NXCD, off = wgid / NXCD; wgid = (xcd < r ? xcd * (q + 1) : r * (q + 1) + (xcd - r) * q) + off; }
        const int nig = WGM * nN, gid = wgid / nig, fm = gid * WGM, gsz = (nM - fm) < WGM ? (nM - fm) : WGM;
        u.pm = fm + ((wgid % nig) % gsz); u.pn = (wgid % nig) / gsz;
        u.A = (which ? A1 : A0) + (size_t)u.pm * a_pm + (size_t)u.pn * a_pn; u.B = (which ? B1 : B0) + (size_t)u.pn * b_pn;
        u.kind = which; u.keep = (chain == 2 && which == 0) ? 1 : 0; return true;
    }
};

template <class Epi>
__device__ __forceinline__ void gemm_phase(LAS unsigned char* lds, const int tid, const Gemm g, const Sched& S, const Epi& E) {
    const int wid = __builtin_amdgcn_readfirstlane(tid >> 6), lane = tid & 63, wr = wid >> 2, wc = wid & 3, fr = lane & 15, fq = lane >> 4;
    const int K = g.K, nt = K / BK;
    unsigned voffA[2], voffB[2];
#pragma unroll
    for (int i = 0; i < 2; ++i) { int R, C; stage_rc(tid * 16 + i * 8192, R, C); const int Rb = Epi::PERM ? ((R & ~31) + perm32(R & 31)) : R;
        voffA[i] = (unsigned)(R * g.lda + C) * 2u; voffB[i] = (unsigned)(Rb * g.ldb + C) * 2u; }
    const size_t kstep = (size_t)(BK * 2);
    const size_t hstepA = (size_t)HALF * g.lda * 2, hstepB = (size_t)HALF * g.ldb * 2;
    const unsigned ldsw = (unsigned)wid * 1024u;
    const int aoff = lds_byte(wr * 64 + fr, fq * 8), boff = lds_byte(wc * 32 + fr, fq * 8);
#define PG8_SA(b, h) (((b) * 2 + (h)) * HTB)
#define PG8_SB(b, h) ((4 + (b) * 2 + (h)) * HTB)
#define PG8_STAGE(bufoff, gbase, voff) do { _Pragma("unroll") for (int _i = 0; _i < 2; ++_i) \
        __builtin_amdgcn_global_load_lds((const unsigned*)((const char*)(gbase) + (voff)[_i]), (LAS unsigned*)(lds + (bufoff) + ldsw + _i * 8192), 16, 0, 0); } while (0)
#define PG8_LDA(dst, b, h) do { _Pragma("unroll") for (int m = 0; m < 4; ++m) _Pragma("unroll") for (int k = 0; k < 2; ++k) dst[m][k] = *(const LAS bf16x8*)(lds + PG8_SA(b, h) + aoff + m * 2048 + k * 1024); } while (0)
#define PG8_LDB(dst, b, h) do { _Pragma("unroll") for (int n = 0; n < 2; ++n) _Pragma("unroll") for (int k = 0; k < 2; ++k) dst[n][k] = *(const LAS bf16x8*)(lds + PG8_SB(b, h) + boff + n * 2048 + k * 1024); } while (0)
#define PG8_MMA(ai, bj, At, Bt) do { __builtin_amdgcn_s_setprio(1); _Pragma("unroll") for (int m = 0; m < 4; ++m) _Pragma("unroll") for (int n = 0; n < 2; ++n) _Pragma("unroll") for (int k = 0; k < 2; ++k) \
        acc[ai][bj][m][n] = __builtin_amdgcn_mfma_f32_16x16x32_bf16(Bt[n][k], At[m][k], acc[ai][bj][m][n], 0, 0, 0); __builtin_amdgcn_s_setprio(0); } while (0)
#define PG8_WAIT_V(n) asm volatile("s_waitcnt vmcnt(" #n ")" ::: "memory")
#define PG8_WAIT_L(n) asm volatile("s_waitcnt lgkmcnt(" #n ")" ::: "memory")
#define PG8_BAR __builtin_amdgcn_s_barrier()
#define PG8_SCHED __builtin_amdgcn_sched_barrier(0)
    Unit cur, nxt; int ui = 0;
    if (!S.next(0, cur)) return;
    f32x4 acc[2][2][4][2];
#pragma unroll
    for (int a = 0; a < 2; ++a)
#pragma unroll
        for (int b = 0; b < 2; ++b)
#pragma unroll
            for (int m = 0; m < 4; ++m)
#pragma unroll
                for (int n = 0; n < 2; ++n) acc[a][b][m][n] = (f32x4){0.f, 0.f, 0.f, 0.f};
    bf16x8 At[4][2], B0[2][2], B1[2][2];
    const char* cA = cur.A; const char* cB = cur.B;
    PG8_STAGE(PG8_SB(0, 0), cB, voffB); PG8_STAGE(PG8_SB(0, 1), cB + hstepB, voffB); PG8_STAGE(PG8_SA(0, 0), cA, voffA); PG8_STAGE(PG8_SA(0, 1), cA + hstepA, voffA);
    if (wr == 1) PG8_BAR;
    PG8_WAIT_V(2); PG8_BAR;
    PG8_STAGE(PG8_SB(1, 0), cB + kstep, voffB); PG8_STAGE(PG8_SA(1, 0), cA + kstep, voffA); PG8_STAGE(PG8_SB(1, 1), cB + hstepB + kstep, voffB);
    PG8_WAIT_V(6); PG8_BAR;
    for (;;) {
        const bool has_next = S.next(ui + 1, nxt);
        const char* nA = has_next ? nxt.A : cA; const char* nB = has_next ? nxt.B : cB;
        for (int t = 0; t < nt; t += 2) {
            const bool last = (t == nt - 2);
            const char* a1 = cA + (size_t)(t + 1) * kstep;
            const char* a2 = last ? nA : cA + (size_t)(t + 2) * kstep; const char* b2 = last ? nB : cB + (size_t)(t + 2) * kstep;
            const char* a3 = a2 + kstep; const char* b3 = b2 + kstep;
            PG8_LDB(B0, 0, 0); PG8_LDB(B1, 0, 1); PG8_SCHED; PG8_LDA(At, 0, 0); PG8_STAGE(PG8_SA(1, 1), a1 + hstepA, voffA);
            PG8_WAIT_V(8); PG8_WAIT_L(0); PG8_BAR; PG8_MMA(0, 0, At, B0); PG8_MMA(0, 1, At, B1); PG8_BAR; PG8_SCHED;
            PG8_LDA(At, 0, 1); PG8_STAGE(PG8_SB(0, 0), b2, voffB); PG8_STAGE(PG8_SB(0, 1), b2 + hstepB, voffB); PG8_STAGE(PG8_SA(0, 0), a2, voffA);
            PG8_WAIT_V(8); PG8_WAIT_L(0); PG8_BAR; PG8_MMA(1, 0, At, B0); PG8_MMA(1, 1, At, B1); PG8_BAR; PG8_SCHED;
            PG8_LDB(B0, 1, 0); PG8_LDB(B1, 1, 1); PG8_SCHED; PG8_LDA(At, 1, 0); PG8_STAGE(PG8_SA(0, 1), a2 + hstepA, voffA);
            PG8_WAIT_V(8); PG8_WAIT_L(0); PG8_BAR; PG8_MMA(0, 0, At, B0); PG8_MMA(0, 1, At, B1); PG8_BAR; PG8_SCHED;
            PG8_LDA(At, 1, 1); PG8_STAGE(PG8_SB(1, 0), b3, voffB); PG8_STAGE(PG8_SB(1, 1), b3 + hstepB, voffB); PG8_STAGE(PG8_SA(1, 0), a3, voffA);
            PG8_WAIT_V(8); PG8_WAIT_L(0); PG8_BAR; PG8_MMA(1, 0, At, B0); PG8_MMA(1, 1, At, B1); PG8_BAR; PG8_SCHED;
        }
        if (wr == 0) PG8_BAR;
        asm volatile("s_nop 7\n\ts_nop 7" ::: "memory");
        { int t2 = tid; asm volatile("" : "+v"(t2));
          const int l2 = t2 & 63; E(acc, cur, wr, wc, l2 & 15, l2 >> 4); }
        if (!has_next) break;
        if (!cur.keep) {
#pragma unroll
            for (int a = 0; a < 2; ++a)
#pragma unroll
                for (int b = 0; b < 2; ++b)
#pragma unroll
                    for (int m = 0; m < 4; ++m)
#pragma unroll
                        for (int n = 0; n < 2; ++n) acc[a][b][m][n] = (f32x4){0.f, 0.f, 0.f, 0.f};
        }
        cur = nxt; cA = nA; cB = nB; ++ui;
        if (wr == 1) PG8_BAR;
    }
    PG8_WAIT_V(0);
    PG8_BAR;
#undef PG8_SA
#undef PG8_SB
#undef PG8_STAGE
#undef PG8_LDA
#undef PG8_LDB
#undef PG8_MMA
#undef PG8_WAIT_V
#undef PG8_WAIT_L
#undef PG8_BAR
#undef PG8_SCHED
}

struct EpiSplit {
    static constexpr bool PERM = true;
    bf16_t* base;
    __device__ __forceinline__ void operator()(const f32x4 (&acc)[2][2][4][2], const Unit& u, int wr, int wc, int fr, int fq) const {
        const int row0 = u.pm * BM + wr * 64 + fr; const int colt = u.pn * BM; const int t = colt >> 10;
        bf16_t* b = base + (size_t)t * ((size_t)MTOK * 1024); const int col0 = (colt & 1023) + wc * 32 + 8 * fq;
#pragma unroll
        for (int ai = 0; ai < 2; ++ai)
#pragma unroll
            for (int m = 0; m < 4; ++m) { bf16_t* rowp = b + (size_t)(row0 + ai * HALF + m * 16) * 1024 + col0;
#pragma unroll
                for (int bj = 0; bj < 2; ++bj) { const f32x4 v0 = acc[ai][bj][m][0], v1 = acc[ai][bj][m][1];
                    u32x4 w; w.x = cvt_pk_bf16(v0[0], v0[1]); w.y = cvt_pk_bf16(v0[2], v0[3]); w.z = cvt_pk_bf16(v1[0], v1[1]); w.w = cvt_pk_bf16(v1[2], v1[3]);
                    gst<u32x4>(rowp + bj * HALF, w); } }
    }
};
struct EpiSig {
    static constexpr bool PERM = true;
    bf16_t* O; const float* bias;
    __device__ __forceinline__ void operator()(const f32x4 (&acc)[2][2][4][2], const Unit& u, int wr, int wc, int fr, int fq) const {
        const int row0 = u.pm * BM + wr * 64 + fr; const int col0 = u.pn * BM + wc * 32 + 8 * fq;
        f32x4 bv[2][2];
#pragma unroll
        for (int bj = 0; bj < 2; ++bj)
#pragma unroll
            for (int n = 0; n < 2; ++n) bv[bj][n] = gld<f32x4>(bias + col0 + bj * HALF + 4 * n);
        bf16_t* Oh = O + (size_t)(col0 >> 10) * ((size_t)MTOK * 1024) + (col0 & 1023);
#pragma unroll
        for (int ai = 0; ai < 2; ++ai)
#pragma unroll
            for (int m = 0; m < 4; ++m) { bf16_t* rowp = Oh + (size_t)(row0 + ai * HALF + m * 16) * 1024;
#pragma unroll
                for (int bj = 0; bj < 2; ++bj) { f32x4 v0 = acc[ai][bj][m][0] + bv[bj][0], v1 = acc[ai][bj][m][1] + bv[bj][1];
#pragma unroll
                    for (int j = 0; j < 4; ++j) { v0[j] = sigmoidf_(v0[j]); v1[j] = sigmoidf_(v1[j]); }
                    u32x4 w; w.x = cvt_pk_bf16(v0[0], v0[1]); w.y = cvt_pk_bf16(v0[2], v0[3]); w.z = cvt_pk_bf16(v1[0], v1[1]); w.w = cvt_pk_bf16(v1[2], v1[3]);
                    gst<u32x4>(rowp + bj * HALF, w); } }
    }
};
struct EpiPool {
    static constexpr bool PERM = true;
    bf16_t* GB; const float* scale;
    __device__ __forceinline__ void operator()(const f32x4 (&acc)[2][2][4][2], const Unit& u, int wr, int wc, int fr, int fq) const {
        const int row0 = u.pm * BM + wr * 64 + fr; const int col0 = u.pn * BM + wc * 32 + 8 * fq;
        f32x4 sv[2][2];
#pragma unroll
        for (int bj = 0; bj < 2; ++bj)
#pragma unroll
            for (int n = 0; n < 2; ++n) sv[bj][n] = gld<f32x4>(scale + col0 + bj * HALF + 4 * n);
#pragma unroll
        for (int ai = 0; ai < 2; ++ai)
#pragma unroll
            for (int m = 0; m < 4; ++m) { bf16_t* rowp = GB + (size_t)(row0 + ai * HALF + m * 16) * 1024 + col0;
#pragma unroll
                for (int bj = 0; bj < 2; ++bj) { const u32x4 gw = gld<u32x4>(rowp + bj * HALF);
                    f32x4 v0 = acc[ai][bj][m][0] * sv[bj][0], v1 = acc[ai][bj][m][1] * sv[bj][1];
                    v0[0] *= siluf_(bf_lo(gw.x)); v0[1] *= siluf_(bf_hi(gw.x)); v0[2] *= siluf_(bf_lo(gw.y)); v0[3] *= siluf_(bf_hi(gw.y));
                    v1[0] *= siluf_(bf_lo(gw.z)); v1[1] *= siluf_(bf_hi(gw.z)); v1[2] *= siluf_(bf_lo(gw.w)); v1[3] *= siluf_(bf_hi(gw.w));
                    u32x4 w; w.x = cvt_pk_bf16(v0[0], v0[1]); w.y = cvt_pk_bf16(v0[2], v0[3]); w.z = cvt_pk_bf16(v1[0], v1[1]); w.w = cvt_pk_bf16(v1[2], v1[3]);
                    gst<u32x4>(rowp + bj * HALF, w); } }
    }
};
struct EpiProj {
    static constexpr bool PERM = true;
    const bf16_t* MG; bf16_t* O;
    __device__ __forceinline__ void operator()(f32x4 (&acc)[2][2][4][2], const Unit& u, int wr, int wc, int fr, int fq) const {
        const int row0 = u.pm * BM + wr * 64 + fr; const int col0 = u.pn * BM + wc * 32 + 8 * fq;
        if (u.kind == 0) {
#pragma unroll
            for (int ai = 0; ai < 2; ++ai)
#pragma unroll
                for (int m = 0; m < 4; ++m) { const bf16_t* gp = MG + (size_t)(row0 + ai * HALF + m * 16) * 1024 + col0;
#pragma unroll
                    for (int bj = 0; bj < 2; ++bj) { const u32x4 ga = gld<u32x4>(gp + bj * HALF), gb = gld<u32x4>(gp + (size_t)MTOK * 1024 + bj * HALF);
                        f32x4& v0 = acc[ai][bj][m][0]; f32x4& v1 = acc[ai][bj][m][1];
                        v0[0] *= bf_lo(ga.x) * __builtin_amdgcn_rcpf(bf_lo(gb.x)); v0[1] *= bf_hi(ga.x) * __builtin_amdgcn_rcpf(bf_hi(gb.x));
                        v0[2] *= bf_lo(ga.y) * __builtin_amdgcn_rcpf(bf_lo(gb.y)); v0[3] *= bf_hi(ga.y) * __builtin_amdgcn_rcpf(bf_hi(gb.y));
                        v1[0] *= bf_lo(ga.z) * __builtin_amdgcn_rcpf(bf_lo(gb.z)); v1[1] *= bf_hi(ga.z) * __builtin_amdgcn_rcpf(bf_hi(gb.z));
                        v1[2] *= bf_lo(ga.w) * __builtin_amdgcn_rcpf(bf_lo(gb.w)); v1[3] *= bf_hi(ga.w) * __builtin_amdgcn_rcpf(bf_hi(gb.w)); } }
        } else {
#pragma unroll
            for (int ai = 0; ai < 2; ++ai)
#pragma unroll
                for (int m = 0; m < 4; ++m) { const size_t r = (size_t)(row0 + ai * HALF + m * 16); const bf16_t* gp = MG + (size_t)MTOK * 1024 + r * 1024 + col0; bf16_t* rowp = O + r * 1024 + col0;
#pragma unroll
                    for (int bj = 0; bj < 2; ++bj) { const u32x4 gb = gld<u32x4>(gp + bj * HALF);
                        const f32x4 v0 = acc[ai][bj][m][0], v1 = acc[ai][bj][m][1];
                        u32x4 w; w.x = cvt_pk_bf16(v0[0] * bf_lo(gb.x), v0[1] * bf_hi(gb.x)); w.y = cvt_pk_bf16(v0[2] * bf_lo(gb.y), v0[3] * bf_hi(gb.y));
                        w.z = cvt_pk_bf16(v1[0] * bf_lo(gb.z), v1[1] * bf_hi(gb.z)); w.w = cvt_pk_bf16(v1[2] * bf_lo(gb.w), v1[3] * bf_hi(gb.w));
                        gst<u32x4>(rowp + bj * HALF, w); } }
        }
    }
};
struct EpiOut {
    static constexpr bool PERM = false;
    const float* xres; float* out;
    __device__ __forceinline__ void operator()(const f32x4 (&acc)[2][2][4][2], const Unit& u, int wr, int wc, int fr, int fq) const {
        const int row0 = u.pm * BM + wr * 64 + fr, col0 = u.pn * BM + wc * 32 + 4 * fq;
#pragma unroll
        for (int ai = 0; ai < 2; ++ai)
#pragma unroll
            for (int m = 0; m < 4; ++m) { const size_t off = (size_t)(row0 + ai * HALF + m * 16) * 1024 + col0;
#pragma unroll
                for (int bj = 0; bj < 2; ++bj)
#pragma unroll
                    for (int n = 0; n < 2; ++n) { const f32x4 xs = gld<f32x4>(xres + off + bj * HALF + n * 16);
                        gst<f32x4>(out + off + bj * HALF + n * 16, xs * DN_ALPHA + acc[ai][bj][m][n]); } }
    }
};
}

struct Args { const float* in[13]; float* out; unsigned char* ws; int ph_lo, ph_hi; };
typedef const __attribute__((address_space(4))) Args CArgs;
struct Ctx { int tid, lane, wave, G, bid; int grp, gj, gs, bpg; };

__device__ __forceinline__ float wave_sum(float v) {
#pragma unroll
    for (int o = 1; o < 64; o <<= 1) v += __shfl_xor(v, o);
    return v;
}

__device__ __forceinline__ void transpose_item(const float* W, int ld_src, int col0, int nblk, int K, bf16_t* WT, int row_off, LAS float* scr, int item, int lane) {
    const int kb = item / nblk, nb = item % nblk, k0 = 64 * kb, n0 = 32 * nb;
    {   float tv[32];
        const float* wp = W + (size_t)(k0 + (lane >> 5)) * ld_src + col0 + n0 + (lane & 31);
#pragma unroll
        for (int i = 0; i < 32; ++i) tv[i] = gld<float>(wp + (size_t)(2 * i) * ld_src);
#pragma unroll
        for (int i = 0; i < 32; ++i) scr[(2 * i + (lane >> 5)) * 33 + (lane & 31)] = tv[i]; }
    asm volatile("s_waitcnt lgkmcnt(0)" ::: "memory");
    const int c = lane & 7;
#pragma unroll
    for (int j = 0; j < 4; ++j) { const int n = (lane >> 3) + 8 * j; const LAS float* s = scr + (8 * c) * 33 + n;
        u32x4 o; o.x = cvt_pk_bf16(s[0 * 33], s[1 * 33]); o.y = cvt_pk_bf16(s[2 * 33], s[3 * 33]); o.z = cvt_pk_bf16(s[4 * 33], s[5 * 33]); o.w = cvt_pk_bf16(s[6 * 33], s[7 * 33]);
        gst<u32x4>(WT + (size_t)(row_off + n0 + n) * K + k0 + 8 * c, o); }
    asm volatile("s_waitcnt lgkmcnt(0)" ::: "memory");
}
__device__ __forceinline__ void compose_item(const float* w_in  , const float* w_g  , bf16_t* WT  , LAS float* scr, int item, int lane) {
    const int kb = item >> 5, nb = item & 31, k0 = 16 * kb, ng = nb * 32 + (lane & 31), g = ng >> 8, o = ng & 255, kh = lane >> 5;
    const float* arow = w_in + (size_t)k0 * INC + 3088 + g * 256;
#pragma unroll
    for (int r = 0; r < 16; ++r) *(LAS f32x4*)(scr + r * 256 + 4 * lane) = gld<f32x4>(arow + (size_t)r * INC + 4 * lane);
    asm volatile("s_waitcnt lgkmcnt(0)" ::: "memory");
    const float* bcol = w_g + (size_t)g * 65536 + o;
    float acc[8];
#pragma unroll
    for (int j = 0; j < 8; ++j) acc[j] = 0.f;
    float bv[16], bn[16];
#pragma unroll
    for (int e = 0; e < 16; ++e) bv[e] = gld<float>(bcol + (size_t)e * 256);
#pragma unroll 1
    for (int i0 = 0; i0 < 256; i0 += 16) {
        const int inext = (i0 + 16 < 256) ? i0 + 16 : i0;
#pragma unroll
        for (int e = 0; e < 16; ++e) bn[e] = gld<float>(bcol + (size_t)(inext + e) * 256);
#pragma unroll
        for (int q = 0; q < 4; ++q)
#pragma unroll
            for (int j = 0; j < 8; ++j) { const f32x4 av = *(const LAS f32x4*)(scr + (kh * 8 + j) * 256 + i0 + 4 * q);
                acc[j] += (av[0] * bv[4 * q] + av[1] * bv[4 * q + 1]) + (av[2] * bv[4 * q + 2] + av[3] * bv[4 * q + 3]); }
#pragma unroll
        for (int e = 0; e < 16; ++e) bv[e] = bn[e];
    }
    u32x4 ov; ov.x = cvt_pk_bf16(acc[0], acc[1]); ov.y = cvt_pk_bf16(acc[2], acc[3]); ov.z = cvt_pk_bf16(acc[4], acc[5]); ov.w = cvt_pk_bf16(acc[6], acc[7]);
    gst<u32x4>(WT + (size_t)ng * 1024 + k0 + kh * 8, ov);
    asm volatile("s_waitcnt lgkmcnt(0)" ::: "memory");
}
__device__ __forceinline__ void convert_weights(CArgs& a, const Ctx& cx, LAS unsigned char* lds, int l) {
    LAS float* scr = (LAS float*)(lds + cx.wave * 16384);
    const int gw = cx.bid * 8 + cx.wave, NGW = cx.G * 8;
    unsigned char* ws = a.ws + (size_t)(l & 1) * WSET_BYTES;
    const float* w_in = a.in[1] + (size_t)l * 1024 * INC;
    const float* w_pa = a.in[8] + (size_t)l * 1024 * 1024; const float* w_pb = a.in[9] + (size_t)l * 1024 * 1024; const float* w_o = a.in[10] + (size_t)l * 1024 * 1024;
    const float* w_g = a.in[5] + (size_t)l * 4 * 256 * 256;
    constexpr int I_A = 16 * 96, I_GB = 16 * 32, I_M = 16 * 64, I_P = 16 * 32, I_C = 64 * 32;
    constexpr int NIT = I_A + I_GB + I_M + 3 * I_P + I_C;
    unsigned* ctr = (unsigned*)(a.ws + WS_CTR) + 64 * l;
    volatile LAS unsigned* tw = (volatile LAS unsigned*)(lds + 8 * 16384);
    (void)gw; (void)NGW;
    unsigned tk = 0u;
    if (cx.tid == 0) tk = __hip_atomic_fetch_add(ctr, 8u, __ATOMIC_RELAXED, __HIP_MEMORY_SCOPE_AGENT);
    for (int rnd = 0; ; ++rnd) {
        if (cx.tid == 0) tw[rnd & 1] = tk;
        __syncthreads();
        const int base = (int)tw[rnd & 1];
        if (base >= NIT) break;
        if (cx.tid == 0) tk = __hip_atomic_fetch_add(ctr, 8u, __ATOMIC_RELAXED, __HIP_MEMORY_SCOPE_AGENT);
        int r = base + cx.wave;
        if (r < NIT) {
        if (r < I_C) { compose_item(w_in, w_g, (bf16_t*)(ws + WS_W1A) + (size_t)4096 * 1024, scr, r, cx.lane); }
        else { r -= I_C;
        if (r < I_A) { transpose_item(w_in, INC, 0, 96, 1024, (bf16_t*)(ws + WS_W1A), 0, scr, r, cx.lane); }
        else { r -= I_A;
        if (r < I_GB) { transpose_item(w_in, INC, 4112, 32, 1024, (bf16_t*)(ws + WS_W1A), 3072, scr, r, cx.lane); }
        else { r -= I_GB;
        if (r < I_M) { transpose_item(w_in, INC, 5136, 64, 1024, (bf16_t*)(ws + WS_WM), 0, scr, r, cx.lane); }
        else { r -= I_M;
        if (r < I_P) { transpose_item(w_pa, 1024, 0, 32, 1024, (bf16_t*)(ws + WS_WA), 0, scr, r, cx.lane); }
        else { r -= I_P;
        if (r < I_P) { transpose_item(w_pb, 1024, 0, 32, 1024, (bf16_t*)(ws + WS_WB), 0, scr, r, cx.lane); }
        else { r -= I_P; transpose_item(w_o, 1024, 0, 32, 1024, (bf16_t*)(ws + WS_WO), 0, scr, r, cx.lane); } } } } } }
        }
    }
}

__device__ __forceinline__ void row_phase(const Ctx& cx, LAS unsigned char* lds, const float* src, float* dst, bf16_t* xbf, float* AL, const float* walpha  ,
                                          const float* lng, const float* lnb, bool do_ln, bool dry = false) {
    LAS float* WT = (LAS float*)lds;
    if (AL) {
        for (int idx = cx.tid; idx < 16384; idx += 512) { const int k = idx >> 4, c = idx & 15; WT[c * 1028 + k] = gld<float>(walpha + (size_t)k * INC + c); }
    }
    __syncthreads();
    const int gw = cx.gj * 8 + cx.wave, NGW = cx.gs * 8, lane = cx.lane; const int rg0 = cx.grp * cx.bpg * 2048, nrg = cx.bpg * 2048;
    f32x4 gj[4], bj[4];
#pragma unroll
    for (int j = 0; j < 4; ++j) { gj[j] = (f32x4){1.f, 1.f, 1.f, 1.f}; bj[j] = (f32x4){0.f, 0.f, 0.f, 0.f}; }
    if (do_ln) {
#pragma unroll
        for (int j = 0; j < 4; ++j) { gj[j] = gld<f32x4>(lng + 256 * j + 4 * lane); bj[j] = gld<f32x4>(lnb + 256 * j + 4 * lane); }
    }
    for (int rl = gw; rl < nrg; rl += NGW) {
        const size_t m0 = (size_t)(rg0 + rl) * 4;
        f32x4 v[4][4];
#pragma unroll
        for (int r = 0; r < 4; ++r)
#pragma unroll
            for (int j = 0; j < 4; ++j) v[r][j] = gld<f32x4>(src + (m0 + r) * 1024 + 256 * j + 4 * lane);
        if (do_ln) {
#pragma unroll
            for (int r = 0; r < 4; ++r) {
                float s = 0.f;
#pragma unroll
                for (int j = 0; j < 4; ++j) s += (v[r][j][0] + v[r][j][1]) + (v[r][j][2] + v[r][j][3]);
                const float mean = wave_sum(s) * (1.f / 1024.f); float s2 = 0.f;
#pragma unroll
                for (int j = 0; j < 4; ++j) { v[r][j] = v[r][j] - mean; s2 += (v[r][j][0] * v[r][j][0] + v[r][j][1] * v[r][j][1]) + (v[r][j][2] * v[r][j][2] + v[r][j][3] * v[r][j][3]); }
                const float rstd = __builtin_amdgcn_rsqf(wave_sum(s2) * (1.f / 1024.f) + LN_EPS);
#pragma unroll
                for (int j = 0; j < 4; ++j) { v[r][j] = v[r][j] * rstd * gj[j] + bj[j]; if (!dry) gst<f32x4>(dst + (m0 + r) * 1024 + 256 * j + 4 * lane, v[r][j]); }
            }
        }
        if (xbf) {
#pragma unroll
            for (int r = 0; r < 4; ++r)
#pragma unroll
                for (int j = 0; j < 4; ++j) { u32x2 w; w.x = cvt_pk_bf16(v[r][j][0], v[r][j][1]); w.y = cvt_pk_bf16(v[r][j][2], v[r][j][3]);
                    if (!dry) gst<u32x2>(xbf + (m0 + r) * 1024 + 256 * j + 4 * lane, w); }
        }
        if (AL) {
            float acc[64];
#pragma unroll
            for (int i = 0; i < 64; ++i) acc[i] = 0.f;
#pragma unroll
            for (int c = 0; c < 16; ++c)
#pragma unroll
                for (int j = 0; j < 4; ++j) { const f32x4 w = *(const LAS f32x4*)(WT + c * 1028 + 256 * j + 4 * lane);
#pragma unroll
                    for (int r = 0; r < 4; ++r) acc[r * 16 + c] += (v[r][j][0] * w[0] + v[r][j][1] * w[1]) + (v[r][j][2] * w[2] + v[r][j][3] * w[3]); }
#pragma unroll
            for (int h = 32; h >= 1; h >>= 1) {
                const bool up = (lane & h) != 0;
#pragma unroll
                for (int i = 0; i < h; ++i) { const float keep = up ? acc[i + h] : acc[i]; const float send = up ? acc[i] : acc[i + h]; acc[i] = keep + __shfl_xor(send, h); }
            }
            if (!dry) gst<float>(AL + m0 * 16 + lane, acc[0]);
        }
    }
}

__device__ __forceinline__ void unpack8(const u32x4 w, float (&f)[8]) { f[0] = bf_lo(w.x); f[1] = bf_hi(w.x); f[2] = bf_lo(w.y); f[3] = bf_hi(w.y); f[4] = bf_lo(w.z); f[5] = bf_hi(w.z); f[6] = bf_lo(w.w); f[7] = bf_hi(w.w); }
__device__ __forceinline__ void pool_phase(const Ctx& cx, const bf16_t* pin, bf16_t* gbuf, const float* scale) {
    const int NT = cx.bpg * 32768, q0 = cx.grp * cx.bpg * 32768;
    for (int ql = cx.gj * 512 + cx.tid; ql < NT; ql += cx.gs * 512) { const int q = q0 + ql;
        const int cg8 = q & 127, seg = q >> 7; const int g = cg8 >> 5; const int w = 2 << g;
        const int t0 = seg * 32, pos0 = t0 & (SEQ - 1);
        const bf16_t* base = pin + (size_t)t0 * 1024 + cg8 * 8;
        float sum[8], sc[8];
        { const f32x4 s0 = gld<f32x4>(scale + cg8 * 8), s1 = gld<f32x4>(scale + cg8 * 8 + 4); sc[0] = s0[0]; sc[1] = s0[1]; sc[2] = s0[2]; sc[3] = s0[3]; sc[4] = s1[0]; sc[5] = s1[1]; sc[6] = s1[2]; sc[7] = s1[3]; }
        bf16_t* gb = gbuf + (size_t)t0 * 1024 + cg8 * 8;
#pragma unroll
        for (int e = 0; e < 8; ++e) sum[e] = 0.f;
        if (pos0 > 0) {
#pragma unroll 1
            for (int jb = 0; jb < 16; jb += 8) {
                u32x4 hv[8];
#pragma unroll
                for (int j = 0; j < 8; ++j) hv[j] = gld<u32x4>(base - (size_t)(jb + j + 1) * 1024);
#pragma unroll
                for (int j = 0; j < 8; ++j) { float f[8]; unpack8(hv[j], f); const float m = (jb + j + 1 <= w) ? 1.f : 0.f;
#pragma unroll
                    for (int e = 0; e < 8; ++e) sum[e] += m * f[e]; }
            }
        }
#pragma unroll 1
        for (int ib = 0; ib < 32; ib += 4) {
            u32x4 xv[4], ov[4], gv[4];
#pragma unroll
            for (int i = 0; i < 4; ++i) { xv[i] = gld<u32x4>(base + (size_t)(ib + i) * 1024); gv[i] = gld<u32x4>(gb + (size_t)(ib + i) * 1024);
                const int back = (pos0 + ib + i - w >= 0) ? w : 0;
                ov[i] = gld<u32x4>(base + (size_t)(ib + i - back) * 1024); }
#pragma unroll
            for (int i = 0; i < 4; ++i) {
                const int pos = pos0 + ib + i; float x[8], f[8], gt[8]; unpack8(xv[i], x); unpack8(ov[i], f); unpack8(gv[i], gt);
                const float m = (pos - w >= 0) ? 1.f : 0.f;
#pragma unroll
                for (int e = 0; e < 8; ++e) sum[e] += x[e] - m * f[e];
                const int cnt = (pos + 1 < w) ? (pos + 1) : w; const float inv = __builtin_amdgcn_rcpf((float)cnt);
                float y[8];
#pragma unroll
                for (int e = 0; e < 8; ++e) y[e] = (sum[e] * inv - x[e]) * sc[e] * siluf_(gt[e]);
                u32x4 o; o.x = cvt_pk_bf16(y[0], y[1]); o.y = cvt_pk_bf16(y[2], y[3]); o.z = cvt_pk_bf16(y[4], y[5]); o.w = cvt_pk_bf16(y[6], y[7]);
                gst<u32x4>(gb + (size_t)(ib + i) * 1024, o);
            }
        }
    }
}

constexpr int L_AL = 0, L_GL = 4096, L_RS = 6144, L_KT = 8192  , L_VT1 = 26624  ;
constexpr int L_UST = 63488;
constexpr int L_QA = 8192, L_KA = 25600, L_QB = 43008, L_KB = 60416, L_VT3 = 77824, L_P = 114688;

__device__ __forceinline__ void gla_G(LAS unsigned char* lds, const float (&w)[16], float bias, int d, int tg, float (&g)[16], float& total) {
    const LAS float* AL_s = (const LAS float*)(lds + L_AL); LAS float* GL_s = (LAS float*)(lds + L_GL);
    float run = 0.f;
#pragma unroll
    for (int tt = 0; tt < 16; ++tt) {
        const LAS f32x4* ap = (const LAS f32x4*)(AL_s + (tg * 16 + tt) * 16);
        const f32x4 a0 = ap[0], a1 = ap[1], a2 = ap[2], a3 = ap[3];
        float z = bias;
        z += a0[0] * w[0]; z += a0[1] * w[1]; z += a0[2] * w[2]; z += a0[3] * w[3];
        z += a1[0] * w[4]; z += a1[1] * w[5]; z += a1[2] * w[6]; z += a1[3] * w[7];
        z += a2[0] * w[8]; z += a2[1] * w[9]; z += a2[2] * w[10]; z += a2[3] * w[11];
        z += a3[0] * w[12]; z += a3[1] * w[13]; z += a3[2] * w[14]; z += a3[3] * w[15];
        const float ls = fminf(z, 0.f) - __logf(1.0f + __expf(-fabsf(z)));
        run += ls * (1.0f / 16.0f);
        g[tt] = run;
    }
    GL_s[tg * 128 + d] = run;
    __syncthreads();
    const float p0 = GL_s[d], p1 = GL_s[128 + d], p2 = GL_s[256 + d], p3 = GL_s[384 + d];
    const float prefix = (tg > 0 ? p0 : 0.f) + (tg > 1 ? p1 : 0.f) + (tg > 2 ? p2 : 0.f);
    total = (p0 + p1) + (p2 + p3);
#pragma unroll
    for (int tt = 0; tt < 16; ++tt) g[tt] += prefix;
}
__device__ __forceinline__ void gla_load_stage(const Ctx& cx, const float* AL, const bf16_t* Vb, int it, f32x4& alr, u32x4 (&vr)[2][2]) {
    const int b = it >> 9, c = (it >> 2) & 127, h = it & 3; const int row0 = b * SEQ + c * 64;
    if (cx.tid < 256) alr = gldo<f32x4>(AL + (size_t)row0 * 16, (unsigned)cx.tid * 16u);
    const bf16_t* vb = Vb + (size_t)row0 * 1024 + h * 256;
#pragma unroll
    for (int i = 0; i < 2; ++i) {
        const int q = cx.tid + 512 * i, tp = q & 31, ng = q >> 5;
        const unsigned off = (unsigned)((2 * tp) * 1024 + ng * 8) * 2u;
        vr[i][0] = gldo<u32x4>(vb, off); vr[i][1] = gldo<u32x4>(vb, off + 2048u);
    }
}
__device__ __forceinline__ void gla_write_stage(const Ctx& cx, LAS unsigned char* lds, int vt_off, const f32x4& alr, const u32x4 (&vr)[2][2]) {
    if (cx.tid < 256) ((LAS f32x4*)(lds + L_AL))[cx.tid] = alr;
    LAS unsigned* VT32 = (LAS unsigned*)(lds + vt_off);
#pragma unroll
    for (int i = 0; i < 2; ++i) {
        const int q = cx.tid + 512 * i, tp = q & 31, ng = q >> 5;
        const u32x4 r0 = vr[i][0], r1 = vr[i][1];
#pragma unroll
        for (int j = 0; j < 4; ++j) {
            VT32[(ng * 8 + 2 * j) * 36 + tp] = (r0[j] & 0xffffu) | (r1[j] << 16);
            VT32[(ng * 8 + 2 * j + 1) * 36 + tp] = (r0[j] >> 16) | (r1[j] & 0xffff0000u);
        }
    }
}

__device__ __forceinline__ void gla_p1(CArgs& a, const Ctx& cx, LAS unsigned char* lds, int l) {
    unsigned char* ws = a.ws;
    const float* AL = (const float*)(ws + WS_AL); const bf16_t* QKb = (const bf16_t*)(ws + WS_QK); const bf16_t* Vb = (const bf16_t*)(ws + WS_V);
    unsigned char* US = ws + WS_US; float* DF = (float*)(ws + WS_DF);
    const float* Wup = a.in[2] + (size_t)l * 16 * 512; const float* balpha = a.in[3] + (size_t)l * 512;
    const int tid = cx.tid, lane = cx.lane, wv = cx.wave, fr = lane & 15, fq = lane >> 4;
    const int d = tid & 127, tg = tid >> 7;
    f32x4 alr = (f32x4){0.f, 0.f, 0.f, 0.f}; u32x4 vr[2][2];
    float w[16], bias = 0.f; int prev_h = -1;
    const int it0 = cx.grp * cx.bpg * 512 + cx.gj, itend = (cx.grp + 1) * cx.bpg * 512;
    if (it0 < itend) gla_load_stage(cx, AL, Vb, it0, alr, vr);
    for (int it = it0; it < itend; it += cx.gs) {
        const int b = it >> 9, c = (it >> 2) & 127, h = it & 3; const int row0 = b * SEQ + c * 64; const int slot = (b * 4 + h) * NCH + c;
        __syncthreads();
        gla_write_stage(cx, lds, L_VT1, alr, vr);
        __syncthreads();
        const bf16_t* kb = QKb + (size_t)row0 * 1024 + 512 + h * 128; const unsigned koff = (unsigned)(tg * 16 * 1024 + d) * 2u;
        bf16_t kraw[16];
#pragma unroll
        for (int tt = 0; tt < 16; ++tt) kraw[tt] = gldo<bf16_t>(kb + (size_t)tt * 1024, koff);
        if (h != prev_h) { prev_h = h; bias = gldo<float>(balpha + h * 128, (unsigned)d * 4u);
#pragma unroll
            for (int r = 0; r < 16; ++r) w[r] = gldo<float>(Wup + r * 512 + h * 128, (unsigned)d * 4u); }
        if (it + cx.gs < itend) gla_load_stage(cx, AL, Vb, it + cx.gs, alr, vr);
        float g[16], total;
        gla_G(lds, w, bias, d, tg, g, total);
        unsigned pk[8];
#pragma unroll
        for (int tt = 0; tt < 16; tt += 2) { const float k0 = bf2f(kraw[tt]) * __expf(total - g[tt]), k1 = bf2f(kraw[tt + 1]) * __expf(total - g[tt + 1]); pk[tt >> 1] = cvt_pk_bf16(k0, k1); }
        LAS u32x4* kt = (LAS u32x4*)(lds + L_KT + d * 144 + tg * 32);
        kt[0] = (u32x4){pk[0], pk[1], pk[2], pk[3]}; kt[1] = (u32x4){pk[4], pk[5], pk[6], pk[7]};
        if (tg == 0) gsto<float>(DF + (size_t)slot * 128, (unsigned)d * 4u, __expf(total));
        __syncthreads();
        f32x4 acc[8][2];
#pragma unroll
        for (int dt = 0; dt < 8; ++dt) { acc[dt][0] = (f32x4){0.f, 0.f, 0.f, 0.f}; acc[dt][1] = (f32x4){0.f, 0.f, 0.f, 0.f}; }
#pragma unroll
        for (int ks = 0; ks < 2; ++ks) {
            bf16x8 bfr[2];
#pragma unroll
            for (int nn = 0; nn < 2; ++nn) bfr[nn] = *(const LAS bf16x8*)(lds + L_VT1 + ((2 * wv + nn) * 16 + fr) * 144 + ks * 64 + fq * 16);
#pragma unroll
            for (int dt = 0; dt < 8; ++dt) { const bf16x8 af = *(const LAS bf16x8*)(lds + L_KT + (dt * 16 + fr) * 144 + ks * 64 + fq * 16);
#pragma unroll
                for (int nn = 0; nn < 2; ++nn) acc[dt][nn] = __builtin_amdgcn_mfma_f32_16x16x32_bf16(af, bfr[nn], acc[dt][nn], 0, 0, 0); }
        }
#pragma unroll
        for (int dt = 0; dt < 8; ++dt)
#pragma unroll
            for (int nn = 0; nn < 2; ++nn) { u32x2 o; o.x = cvt_pk_bf16_n(acc[dt][nn][0], acc[dt][nn][1]); o.y = cvt_pk_bf16_n(acc[dt][nn][2], acc[dt][nn][3]);
                *(LAS u32x2*)(lds + L_UST + ((2 * wv + nn) * 16 + fr) * 272 + (dt * 16 + fq * 4) * 2) = o; }
        __syncthreads();
        unsigned char* up = US + us_off(b, h, c);
#pragma unroll
        for (int i = 0; i < 8; ++i) { const int j = tid + 512 * i;
            const u32x4 v = *(const LAS u32x4*)(lds + L_UST + (j >> 4) * 272 + (j & 15) * 16);
            gsto<u32x4>(up + i * 8192, (unsigned)tid * 16u, v); }
    }
}
__device__ __forceinline__ void gla_p2(CArgs& a, const Ctx& cx, bool dry) {
    unsigned char* US = a.ws + WS_US; const float* DF = (const float*)(a.ws + WS_DF);
    const int NT2 = cx.bpg * 32768, q20 = cx.grp * cx.bpg * 32768;
    for (int ql = cx.gj * 512 + cx.tid; ql < NT2; ql += cx.gs * 512) { const int q = q20 + ql;
        const int bh = q >> 13, within = q & 8191; const int dq = within & 31;
        unsigned char* p = US + us_off(bh >> 2, bh & 3, 0) + (size_t)within * 8;
        const float* dfp = DF + (size_t)bh * NCH * 128 + dq * 4;
        float s0 = 0.f, s1 = 0.f, s2 = 0.f, s3 = 0.f;
        for (int cb = 0; cb < NCH; cb += 16) {
            u32x2 u[16]; f32x4 df[16];
#pragma unroll
            for (int i = 0; i < 16; ++i) { u[i] = gld<u32x2>(p + (size_t)(cb + i) * 65536); df[i] = gld<f32x4>(dfp + (size_t)(cb + i) * 128); }
#pragma unroll
            for (int i = 0; i < 16; ++i) {
                s0 = df[i][0] * s0 + bf_lo(u[i].x); s1 = df[i][1] * s1 + bf_hi(u[i].x); s2 = df[i][2] * s2 + bf_lo(u[i].y); s3 = df[i][3] * s3 + bf_hi(u[i].y);
                u32x2 o; o.x = cvt_pk_bf16(s0, s1); o.y = cvt_pk_bf16(s2, s3);
                if (!dry) gst<u32x2>(p + (size_t)(cb + i) * 65536, o);
            }
        }
    }
}
__device__ __forceinline__ void gla_p3(CArgs& a, const Ctx& cx, LAS unsigned char* lds, int l, bool dry) {
    unsigned char* ws = a.ws;
    const float* AL = (const float*)(ws + WS_AL); const bf16_t* QKb = (const bf16_t*)(ws + WS_QK); const bf16_t* Vb = (const bf16_t*)(ws + WS_V);
    const unsigned char* US = ws + WS_US; bf16_t* GA = (bf16_t*)(ws + WS_GA);
    const float* Wup = a.in[2] + (size_t)l * 16 * 512; const float* balpha = a.in[3] + (size_t)l * 512; const float* gnorm = a.in[4] + (size_t)l * 1024;
    const int tid = cx.tid, lane = cx.lane, wv = cx.wave, fr = lane & 15, fq = lane >> 4;
    const int d = tid & 127, tg = tid >> 7;
    const int tp = wv & 1, nq = wv >> 1;
    f32x4 alr = (f32x4){0.f, 0.f, 0.f, 0.f}; u32x4 vr[2][2];
    const int it0 = cx.grp * cx.bpg * 512 + cx.gj, itend = (cx.grp + 1) * cx.bpg * 512;
    if (it0 < itend) gla_load_stage(cx, AL, Vb, it0, alr, vr);
    for (int it = it0; it < itend; it += cx.gs) {
        const int b = it >> 9, c = (it >> 2) & 127, h = it & 3; const int row0 = b * SEQ + c * 64; const int slot = (b * 4 + h) * NCH + c;
        __syncthreads();
        gla_write_stage(cx, lds, L_VT3, alr, vr);
        __syncthreads();
        const bf16_t* qb = QKb + (size_t)row0 * 1024 + h * 128; const unsigned qoff = (unsigned)(tg * 16 * 1024 + d) * 2u;
        bf16_t qraw[16], kraw[16];
#pragma unroll
        for (int tt = 0; tt < 16; ++tt) { qraw[tt] = gldo<bf16_t>(qb + (size_t)tt * 1024, qoff); kraw[tt] = gldo<bf16_t>(qb + 512 + (size_t)tt * 1024, qoff); }
        const unsigned char* sp = US + us_off(b, h, c > 0 ? c - 1 : c) + nq * 64 * 256; const unsigned soff = (unsigned)(fr * 256 + fq * 16);
        bf16x8 sf[4][4];
        if (c > 0) {
#pragma unroll
            for (int nt = 0; nt < 4; ++nt)
#pragma unroll
                for (int ks = 0; ks < 4; ++ks) sf[nt][ks] = gldo<bf16x8>(sp + nt * 4096 + ks * 64, soff);
        }
        float g[16], total;
        {   float w[16]; const float bias = gldo<float>(balpha + h * 128, (unsigned)d * 4u);
#pragma unroll
            for (int r = 0; r < 16; ++r) w[r] = gldo<float>(Wup + r * 512 + h * 128, (unsigned)d * 4u);
            if (it + cx.gs < itend) gla_load_stage(cx, AL, Vb, it + cx.gs, alr, vr);
            gla_G(lds, w, bias, d, tg, g, total); }
        {
            LAS bf16_t* QA = (LAS bf16_t*)(lds + L_QA); LAS bf16_t* KA = (LAS bf16_t*)(lds + L_KA); LAS bf16_t* QB = (LAS bf16_t*)(lds + L_QB); LAS bf16_t* KB = (LAS bf16_t*)(lds + L_KB);
#pragma unroll
            for (int tt = 0; tt < 16; ++tt) {
                const float qv = bf2f(qraw[tt]) * QSCALE, kv = bf2f(kraw[tt]); const float eg = __expf(g[tt]), ei = __expf(-g[tt]);
                const int o = (tg * 16 + tt) * 136 + d;
                const unsigned w0 = cvt_pk_bf16(qv * eg, kv * ei), w1 = cvt_pk_bf16(qv * ei, kv * eg);
                QA[o] = (bf16_t)(w0 & 0xffffu); KA[o] = (bf16_t)(w0 >> 16); QB[o] = (bf16_t)(w1 & 0xffffu); KB[o] = (bf16_t)(w1 >> 16);
            }
        }
        __syncthreads();
#pragma unroll
        for (int x = 0; x < 2; ++x) {
            const int tile = 2 * wv + x, tix = tile >> 2, si = tile & 3;
            f32x4 a1 = (f32x4){0.f, 0.f, 0.f, 0.f}, a2 = (f32x4){0.f, 0.f, 0.f, 0.f};
            if (tix >= si) {
#pragma unroll
                for (int ks = 0; ks < 4; ++ks) { const bf16x8 af = *(const LAS bf16x8*)(lds + L_KA + (si * 16 + fr) * 272 + ks * 64 + fq * 16), bfv = *(const LAS bf16x8*)(lds + L_QA + (tix * 16 + fr) * 272 + ks * 64 + fq * 16);
                    a1 = __builtin_amdgcn_mfma_f32_16x16x32_bf16(af, bfv, a1, 0, 0, 0); }
            }
            if (tix <= si) {
#pragma unroll
                for (int ks = 0; ks < 4; ++ks) { const bf16x8 af = *(const LAS bf16x8*)(lds + L_KB + (si * 16 + fr) * 272 + ks * 64 + fq * 16), bfv = *(const LAS bf16x8*)(lds + L_QB + (tix * 16 + fr) * 272 + ks * 64 + fq * 16);
                    a2 = __builtin_amdgcn_mfma_f32_16x16x32_bf16(af, bfv, a2, 0, 0, 0); }
            }
            const int t = tix * 16 + fr, s0 = si * 16 + fq * 4;
            const float p0 = (t >= s0) ? a1[0] : a2[0], p1 = (t >= s0 + 1) ? a1[1] : a2[1], p2 = (t >= s0 + 2) ? a1[2] : a2[2], p3 = (t >= s0 + 3) ? a1[3] : a2[3];
            u32x2 o; o.x = cvt_pk_bf16_n(p0, p1); o.y = cvt_pk_bf16_n(p2, p3);
            *(LAS u32x2*)(lds + L_P + t * 144 + s0 * 2) = o;
        }
        bf16_t* gp = GA + (size_t)row0 * 1024 + h * 256 + nq * 64; const unsigned goff = (unsigned)((2 * tp * 16 + fr) * 1024 + fq * 4) * 2u;
        u32x2 gwv[2][4];
#pragma unroll
        for (int x = 0; x < 2; ++x)
#pragma unroll
            for (int nt = 0; nt < 4; ++nt) gwv[x][nt] = gldo<u32x2>(gp + (size_t)x * 16 * 1024 + nt * 16, goff);
        __syncthreads();
        f32x4 acc[2][4];
#pragma unroll
        for (int x = 0; x < 2; ++x)
#pragma unroll
            for (int i = 0; i < 4; ++i) acc[x][i] = (f32x4){0.f, 0.f, 0.f, 0.f};
        bf16x8 bP[2][2], bQ[2][4];
#pragma unroll
        for (int x = 0; x < 2; ++x) {
#pragma unroll
            for (int ks = 0; ks < 2; ++ks) bP[x][ks] = *(const LAS bf16x8*)(lds + L_P + ((2 * tp + x) * 16 + fr) * 144 + ks * 64 + fq * 16);
#pragma unroll
            for (int ks = 0; ks < 4; ++ks) bQ[x][ks] = *(const LAS bf16x8*)(lds + L_QA + ((2 * tp + x) * 16 + fr) * 272 + ks * 64 + fq * 16);
        }
#pragma unroll
        for (int nt = 0; nt < 4; ++nt) {
            const int n = (nq * 4 + nt) * 16 + fr;
#pragma unroll
            for (int ks = 0; ks < 2; ++ks) { const bf16x8 af = *(const LAS bf16x8*)(lds + L_VT3 + n * 144 + ks * 64 + fq * 16);
#pragma unroll
                for (int x = 0; x < 2; ++x) acc[x][nt] = __builtin_amdgcn_mfma_f32_16x16x32_bf16(af, bP[x][ks], acc[x][nt], 0, 0, 0); }
        }
        if (c > 0) {
#pragma unroll
            for (int nt = 0; nt < 4; ++nt)
#pragma unroll
                for (int ks = 0; ks < 4; ++ks)
#pragma unroll
                    for (int x = 0; x < 2; ++x) acc[x][nt] = __builtin_amdgcn_mfma_f32_16x16x32_bf16(sf[nt][ks], bQ[x][ks], acc[x][nt], 0, 0, 0);
        }
        LAS float* RS = (LAS float*)(lds + L_RS);
#pragma unroll
        for (int x = 0; x < 2; ++x) {
            float ss = 0.f;
#pragma unroll
            for (int nt = 0; nt < 4; ++nt) ss += (acc[x][nt][0] * acc[x][nt][0] + acc[x][nt][1] * acc[x][nt][1]) + (acc[x][nt][2] * acc[x][nt][2] + acc[x][nt][3] * acc[x][nt][3]);
            ss += __shfl_xor(ss, 16); ss += __shfl_xor(ss, 32);
            if (fq == 0) RS[((2 * tp + x) * 16 + fr) * 4 + nq] = ss;
        }
        __syncthreads();
#pragma unroll
        for (int x = 0; x < 2; ++x) {
            const f32x4 r4 = *(const LAS f32x4*)(RS + ((2 * tp + x) * 16 + fr) * 4);
            const float rinv = __builtin_amdgcn_rsqf(((r4[0] + r4[1]) + (r4[2] + r4[3])) * (1.0f / 256.0f) + LN_EPS);
#pragma unroll
            for (int nt = 0; nt < 4; ++nt) {
                const f32x4 gn = gldo<f32x4>(gnorm + h * 256 + nq * 64 + nt * 16, (unsigned)(fq * 4) * 4u);
                const u32x2 gw = gwv[x][nt];
                const float y0 = acc[x][nt][0] * rinv * gn[0] * siluf_(bf_lo(gw.x)), y1 = acc[x][nt][1] * rinv * gn[1] * siluf_(bf_hi(gw.x));
                const float y2 = acc[x][nt][2] * rinv * gn[2] * siluf_(bf_lo(gw.y)), y3 = acc[x][nt][3] * rinv * gn[3] * siluf_(bf_hi(gw.y));
                u32x2 o; o.x = cvt_pk_bf16_n(y0, y1); o.y = cvt_pk_bf16_n(y2, y3);
                if (!dry) gsto<u32x2>(gp + (size_t)x * 16 * 1024 + nt * 16, goff, o);
            }
        }
    }
}

#define XB_TMO      128
#define XB_XCNT(j)  (256  + 64 * (j))
#define XB_XSUB(j)  (1280 + 64 * (j))
#define XB_XGEN(j)  (2304 + 64 * (j))
#define XB_TOP      3328
#define XB_TOPGEN   3392
#define XCD_BAR_WORDS 3456
#define XB_SPIN_CAP (1u << 22)
__device__ __forceinline__ unsigned xb_ld(unsigned* p)              { return __hip_atomic_load(p, __ATOMIC_RELAXED, __HIP_MEMORY_SCOPE_AGENT); }
__device__ __forceinline__ unsigned xb_add(unsigned* p, unsigned v) { return __hip_atomic_fetch_add(p, v, __ATOMIC_RELAXED, __HIP_MEMORY_SCOPE_AGENT); }
__device__ __forceinline__ unsigned xb_xcc_id() { return (unsigned)__builtin_amdgcn_s_getreg((3 << 11) | 20) & 0xFu; }
#define XB_SPIN(cond, bar) do { unsigned _sp = 0; while (cond) { __builtin_amdgcn_s_sleep(1); \
    if ((++_sp & 255u) == 0u) { if (xb_ld(&(bar)[XB_TMO])) break; if (_sp > XB_SPIN_CAP) { atomicAdd(&(bar)[XB_TMO], 1u); break; } } } } while (0)
struct XcdBarrier { unsigned* bar; unsigned x; volatile LAS unsigned* st; unsigned gs; };
__device__ __forceinline__ XcdBarrier xcd_barrier_post(unsigned* bar, volatile LAS unsigned* st, unsigned gs) {
    XcdBarrier b; b.bar = bar; b.x = xb_xcc_id(); b.st = st; b.gs = gs;
    if (threadIdx.x == 0) (void)xb_add(&bar[XB_XCNT(b.x)], 1u);
    return b;
}
__device__ __forceinline__ void xcd_barrier_complete(unsigned* bar, unsigned x, unsigned& nloc, unsigned& nx, const unsigned G) {
    unsigned sum, cnt, mine, sp = 0u;
    for (;;) {
        sum = 0u; cnt = 0u; mine = 0u;
#pragma unroll
        for (unsigned j = 0; j < 16; ++j) { const unsigned c = xb_ld(&bar[XB_XCNT(j)]); sum += c; cnt += (c > 0u) ? 1u : 0u; mine = (j == x) ? c : mine; }
        if (sum == G) break;
        __builtin_amdgcn_s_sleep(1);
        if ((++sp & 255u) == 0u) { if (xb_ld(&bar[XB_TMO])) break; if (sp > XB_SPIN_CAP) { atomicAdd(&bar[XB_TMO], 1u); break; } }
    }
    nloc = mine > 0u ? mine : 1u; nx = cnt > 0u ? cnt : 1u;
}
__device__ __forceinline__ void xcd_barrier(const XcdBarrier& b) {
    asm volatile("s_waitcnt vmcnt(0)" ::: "memory");
    __syncthreads();
    if (threadIdx.x == 0) {
        unsigned* bar; { const unsigned long long v = (unsigned long long)b.bar;
            unsigned lo = (unsigned)__builtin_amdgcn_readfirstlane((unsigned)v), hi = (unsigned)__builtin_amdgcn_readfirstlane((unsigned)(v >> 32));
            asm volatile("" : "+s"(lo), "+s"(hi)); bar = (unsigned*)(((unsigned long long)hi << 32) | lo); }
        __builtin_amdgcn_s_waitcnt(0);
        unsigned nloc = b.st[0], nx = b.st[1];
        if (nloc == 0u) { xcd_barrier_complete(bar, b.x, nloc, nx, b.gs); b.st[0] = nloc; b.st[1] = nx; }
        const unsigned old = xb_add(&bar[XB_XSUB(b.x)], 1u);
        const unsigned gen = old / nloc;
        if (old + 1u == (gen + 1u) * nloc) {
            __builtin_amdgcn_fence(__ATOMIC_RELEASE, "agent");
            asm volatile("s_waitcnt vmcnt(0)" ::: "memory");
            const unsigned og = xb_add(&bar[XB_TOP], 1u);
            const unsigned tg = og / nx;
            if (og + 1u == (tg + 1u) * nx) xb_add(&bar[XB_TOPGEN], 1u);
            else XB_SPIN(xb_ld(&bar[XB_TOPGEN]) == tg, bar);
            __builtin_amdgcn_fence(__ATOMIC_ACQUIRE, "agent");
            xb_add(&bar[XB_XGEN(b.x)], 1u);
            asm volatile("s_waitcnt vmcnt(0)" ::: "memory");
        } else {
            XB_SPIN(xb_ld(&bar[XB_XGEN(b.x)]) == gen, bar);
            __builtin_amdgcn_fence(__ATOMIC_ACQUIRE, "agent");
            asm volatile("s_waitcnt vmcnt(0)" ::: "memory");
        }
    }
    __syncthreads();
}

constexpr int PH_PER_LAYER = 9, N_PHASES = 1 + DEPTH * PH_PER_LAYER;

__device__ __forceinline__ void run_phase(CArgs& a, const Ctx& cx, LAS unsigned char* lds, int ph, bool dry) {
    unsigned char* ws = a.ws;
    if (ph == 0) {
        row_phase(cx, lds, a.in[0], nullptr, (bf16_t*)(ws + WS_X), (float*)(ws + WS_AL), a.in[1] + 3072, nullptr, nullptr, false);
        __syncthreads();
        convert_weights(a, cx, lds, 0);
        return;
    }
    const int l = (ph - 1) / PH_PER_LAYER; int sp = (ph - 1) % PH_PER_LAYER;
#ifdef ONLY_SP
    sp = ONLY_SP;
#endif
    const unsigned char* wsw = ws + (size_t)(l & 1) * WSET_BYTES;
    pg8::Sched S; S.G = cx.G; S.c = cx.bid; S.chain = 1; S.A1 = nullptr; S.B1 = nullptr; S.a_pn = 0; S.nM = MTOK / 256;
    switch (sp) {
    case 0: {
        S.A0 = (const char*)(ws + WS_X); S.B0 = (const char*)(wsw + WS_W1A); S.a_pm = (size_t)256 * 1024 * 2; S.b_pn = (size_t)256 * 1024 * 2; S.nN = 20; S.nwg = S.nM * S.nN;
        pg8::EpiSplit E{(bf16_t*)(ws + WS_QK)};
        pg8::gemm_phase<pg8::EpiSplit>(lds, cx.tid, pg8::Gemm{1024, 1024, 1024}, S, E);
    } break;
    case 1: pool_phase(cx, (const bf16_t*)(ws + WS_PIN), (bf16_t*)(ws + WS_GB), a.in[6] + (size_t)l * 1024); break;
    case 2: gla_p1(a, cx, lds, l); break;
    case 3: gla_p2(a, cx, dry); break;
    case 4: gla_p3(a, cx, lds, l, dry); break;
    case 5: {
        S.A0 = (const char*)(ws + WS_X); S.B0 = (const char*)(wsw + WS_WM); S.a_pm = (size_t)256 * 1024 * 2; S.b_pn = (size_t)256 * 1024 * 2; S.nN = 8; S.nwg = S.nM * S.nN;
        pg8::EpiSig E{(bf16_t*)(ws + WS_MG), a.in[7] + (size_t)l * 2048};
        pg8::gemm_phase<pg8::EpiSig>(lds, cx.tid, pg8::Gemm{1024, 1024, 1024}, S, E);
    } break;
    case 6: {
        S.chain = 2; S.A0 = (const char*)(ws + WS_GA); S.A1 = (const char*)(ws + WS_GB); S.B0 = (const char*)(wsw + WS_WA); S.B1 = (const char*)(wsw + WS_WB);
        S.a_pm = (size_t)256 * 1024 * 2; S.b_pn = (size_t)256 * 1024 * 2; S.nN = 4; S.nwg = S.nM * S.nN;
        pg8::EpiProj E{(const bf16_t*)(ws + WS_MG), (bf16_t*)(ws + WS_PIN)};
        pg8::gemm_phase<pg8::EpiProj>(lds, cx.tid, pg8::Gemm{1024, 1024, 1024}, S, E);
    } break;
    case 7: {
        S.A0 = (const char*)(ws + WS_PIN); S.B0 = (const char*)(wsw + WS_WO); S.a_pm = (size_t)256 * 1024 * 2; S.b_pn = (size_t)256 * 1024 * 2; S.nN = 4; S.nwg = S.nM * S.nN;
        pg8::EpiOut E{l == 0 ? a.in[0] : a.out, a.out};
        pg8::gemm_phase<pg8::EpiOut>(lds, cx.tid, pg8::Gemm{1024, 1024, 1024}, S, E);
    } break;
    default: {
        const bool more = (l + 1 < DEPTH);
        row_phase(cx, lds, a.out, a.out, more ? (bf16_t*)(ws + WS_X) : nullptr, more ? (float*)(ws + WS_AL) : nullptr,
                  a.in[1] + (size_t)(more ? l + 1 : l) * 1024 * INC + 3072, a.in[11] + (size_t)l * 1024, a.in[12] + (size_t)l * 1024, true, dry);
        if (more) { __syncthreads(); convert_weights(a, cx, lds, l + 1); }
    } break;
    }
}

__global__ void __launch_bounds__(512, 2) mega_fwd(Args a) {
    extern __shared__ __attribute__((aligned(16))) unsigned char lds_raw[];
    LAS unsigned char* lds = (LAS unsigned char*)lds_raw;
    cg::grid_group grid = cg::this_grid();
    if (threadIdx.x < 16) ((LAS unsigned*)(lds + LDS_PHASE))[threadIdx.x] = 0u;
    __syncthreads();
    const int ngrp = ((gridDim.x & 7) == 0) ? 4 : 1;
    const int my_grp = (ngrp == 4) ? (int)((blockIdx.x & 7) >> 1) : 0, my_gs = (int)gridDim.x / ngrp, my_gj = (ngrp == 4) ? (int)((blockIdx.x >> 3) * 2 + (blockIdx.x & 1)) : (int)blockIdx.x;
    const XcdBarrier bar = xcd_barrier_post((unsigned*)(a.ws + WS_BAR), (volatile LAS unsigned*)(lds + LDS_PHASE), gridDim.x);
    const XcdBarrier gbar = xcd_barrier_post((unsigned*)(a.ws + WS_BAR) + 4096 * (1 + my_grp), (volatile LAS unsigned*)(lds + LDS_PHASE + 32), (unsigned)my_gs);
    constexpr int PPL = PH_PER_LAYER + (DUP_SP >= 0 ? 1 : 0);
    unsigned long long pr_acc = 0, pr_t0 = 0;
    for (int idx = a.ph_lo; idx < a.ph_hi; ++idx) {
        if (idx > a.ph_lo) { if (a.ph_lo < 0) grid.sync();
            if (PROBE_SP == 11) pr_t0 = __builtin_amdgcn_s_memrealtime();
            const int pph = (idx - 1 == 0) ? 0 : 1 + ((idx - 2) / PPL) * PH_PER_LAYER + ((idx - 2) % PPL);
            const bool wide = (pph == 0) || ((pph - 1) % PH_PER_LAYER == PH_PER_LAYER - 1);
            for (int r = 0; r < SYNC_REPS; ++r) { if (wide) xcd_barrier(bar); else xcd_barrier(gbar); }
            if (PROBE_SP == 11) pr_acc += __builtin_amdgcn_s_memrealtime() - pr_t0; }
        int ph = 0; bool dry = false;
        if (idx > 0) { const int l = (idx - 1) / PPL, e = (idx - 1) % PPL; const int sp = (DUP_SP >= 0 && e > DUP_SP) ? e - 1 : e; ph = 1 + l * PH_PER_LAYER + sp; dry = (DUP_SP >= 0 && e == DUP_SP); }
        int tid = threadIdx.x; asm volatile("" : "+v"(tid));
        Ctx cx; cx.tid = tid; cx.lane = tid & 63; cx.wave = __builtin_amdgcn_readfirstlane(tid >> 6); { int bid_ = blockIdx.x, g_ = gridDim.x; asm volatile("" : "+s"(bid_), "+s"(g_)); cx.G = g_; cx.bid = bid_; }
        { int a_ = __builtin_amdgcn_readfirstlane(my_grp), b_ = __builtin_amdgcn_readfirstlane(my_gj), c_ = __builtin_amdgcn_readfirstlane(my_gs); asm volatile("" : "+s"(a_), "+s"(b_), "+s"(c_)); cx.grp = a_; cx.gj = b_; cx.gs = c_; cx.bpg = 4 / ngrp; }
        CArgs* kp = (CArgs*)__builtin_amdgcn_kernarg_segment_ptr(); asm volatile("" : "+s"(kp));
        const bool pr_on = (PROBE_SP >= 0 && PROBE_SP <= 10) && ((ph == 0) ? (PROBE_SP == 10) : ((ph - 1) % PH_PER_LAYER == PROBE_SP));
        if (pr_on) pr_t0 = __builtin_amdgcn_s_memrealtime();
        run_phase(*kp, cx, lds, ph, dry);
        if (pr_on) { __syncthreads(); pr_acc += __builtin_amdgcn_s_memrealtime() - pr_t0; }
    }
    if (PROBE_SP >= 0 && blockIdx.x == 0) { const unsigned long long t1 = __builtin_amdgcn_s_memrealtime(); while (__builtin_amdgcn_s_memrealtime() - t1 < 9ull * pr_acc) __builtin_amdgcn_s_sleep(8); }
}

extern "C" void kernel_launch(void* const* d_in, const int* in_sizes, int n_in, void* d_out, int out_size, void* d_ws, size_t ws_size, hipStream_t stream) {
    static int grid = 0;
    if (grid == 0) {
        if (n_in != 13 || in_sizes[0] != MTOK * DM || out_size != MTOK * DM || ws_size < WS_END) {
            fprintf(stderr, "kernel_launch: unexpected shapes (n_in %d, in0 %d, out %d, ws %zu, need %zu); nothing launched\n", n_in, n_in > 0 ? in_sizes[0] : -1, out_size, ws_size, (size_t)WS_END); grid = -1; return; }
        int dev = 0, cus = 0, per_cu = 0;
        if (hipGetDevice(&dev) != hipSuccess || hipDeviceGetAttribute(&cus, hipDeviceAttributeMultiprocessorCount, dev) != hipSuccess) { grid = -1; return; }
        if (hipFuncSetAttribute((const void*)mega_fwd, hipFuncAttributeMaxDynamicSharedMemorySize, LDS_BYTES) != hipSuccess) { fprintf(stderr, "kernel_launch: hipFuncSetAttribute failed\n"); grid = -1; return; }
        if (hipOccupancyMaxActiveBlocksPerMultiprocessor(&per_cu, (const void*)mega_fwd, 512, LDS_BYTES) != hipSuccess || per_cu < 1) { fprintf(stderr, "kernel_launch: occupancy query says %d\n", per_cu); per_cu = 1; }
        (void)hipGetLastError();
        grid = cus;
    }
    if (grid < 0) return;
    Args a{};
    for (int i = 0; i < 13; ++i) a.in[i] = (const float*)d_in[i];
    a.out = (float*)d_out; a.ws = (unsigned char*)d_ws;
#if N_LAUNCH_MODE == 1
    for (int ph = 0; ph < N_PHASES; ++ph) {
        a.ph_lo = ph; a.ph_hi = ph + 1;
        hipLaunchKernelGGL(mega_fwd, dim3(grid), dim3(512), LDS_BYTES, stream, a);
    }
#else
    if (hipMemsetAsync((unsigned char*)d_ws + WS_BAR, 0, BAR_BYTES + CTR_BYTES, stream) != hipSuccess) { fprintf(stderr, "kernel_launch: memset of barrier words failed\n"); return; }
    a.ph_lo = 0; a.ph_hi = 1 + DEPTH * (PH_PER_LAYER + (DUP_SP >= 0 ? 1 : 0));
    void* args[] = {&a};
    hipError_t e = hipLaunchCooperativeKernel((const void*)mega_fwd, dim3(grid), dim3(512), args, LDS_BYTES, stream);
    if (e != hipSuccess) fprintf(stderr, "cooperative launch failed: %s (grid %d)\n", hipGetErrorString(e), grid);
#endif
}
```

```cpp
#include <hip/hip_runtime.h>
#include <hip/hip_cooperative_groups.h>
#include <cstdio>
#include <cstdint>
namespace cg = cooperative_groups;

#ifndef N_LAUNCH_MODE
#define N_LAUNCH_MODE 0
#endif

#ifndef DUP_SP
#define DUP_SP -1
#endif
#ifndef PROBE_SP
#define PROBE_SP -1
#endif
#ifndef SYNC_REPS
#define SYNC_REPS 1
#endif
#define LAS __attribute__((address_space(3)))
typedef unsigned short bf16_t;
typedef short bf16x8 __attribute__((ext_vector_type(8)));
typedef float f32x4 __attribute__((ext_vector_type(4)));
typedef float f32x2 __attribute__((ext_vector_type(2)));
typedef unsigned u32x4 __attribute__((ext_vector_type(4)));
typedef unsigned u32x2 __attribute__((ext_vector_type(2)));

constexpr int MTOK = 32768, DM = 1024, SEQ = 8192, DEPTH = 4, INC = 7184;
constexpr int NCH = 128;
constexpr float LN_EPS = 1e-5f;
constexpr float DN_ALPHA = 1.6817928305074290f;
constexpr float QSCALE = 0.08838834764831845f;
constexpr size_t UNITB = (size_t)MTOK * 1024 * 2;
constexpr size_t WS_X = 0, WS_QK = 1 * UNITB, WS_V = 2 * UNITB, WS_GA = 3 * UNITB, WS_GB = 4 * UNITB, WS_PIN = 5 * UNITB, WS_F1 = 6 * UNITB, WS_F2 = 7 * UNITB;
constexpr size_t WS_MG = WS_QK;
constexpr size_t WS_US = WS_PIN;
constexpr size_t WS_W1A = WS_F2;
constexpr size_t WS_WM = WS_W1A + (size_t)5120 * 1024 * 2;
constexpr size_t WS_WA = WS_WM + (size_t)2048 * 1024 * 2;
constexpr size_t WS_WB = WS_WA + (size_t)1024 * 1024 * 2;
constexpr size_t WS_WO = WS_WB + (size_t)1024 * 1024 * 2;
constexpr size_t WS_WG = WS_WO + (size_t)1024 * 1024 * 2;
constexpr size_t WSET_BYTES = WS_WG + (size_t)4 * 256 * 256 * 2 - WS_W1A;
constexpr size_t WS_AL = WS_W1A + 2 * WSET_BYTES;
constexpr size_t WS_DF = WS_AL + (size_t)MTOK * 16 * 4;
constexpr size_t WS_BAR = WS_DF + (size_t)2048 * 128 * 4;
constexpr size_t BAR_BYTES = 21 * 16384;
constexpr size_t WS_END = WS_BAR + BAR_BYTES;
constexpr int LDS_PHASE = 135168, LDS_BYTES = LDS_PHASE + 64;

#define GAS __attribute__((address_space(1)))
template <class T> __device__ __forceinline__ T gld(const void* p) { return *(const GAS T*)p; }
template <class T> __device__ __forceinline__ void gst(void* p, const T v) { *(GAS T*)p = v; }
template <class T> __device__ __forceinline__ T gldo(const void* ubase, unsigned off) { return *(const GAS T*)((const GAS char*)ubase + off); }
template <class T> __device__ __forceinline__ void gsto(void* ubase, unsigned off, const T v) { *(GAS T*)((GAS char*)ubase + off) = v; }
typedef __bf16 bf16x2_t __attribute__((ext_vector_type(2)));
__device__ __forceinline__ size_t us_off(int b, int h, int c) { return (size_t)(h >> 1) * UNITB + (size_t)b * ((size_t)16 << 20) + (size_t)((h & 1) * NCH + c) * 65536; }
__device__ __forceinline__ unsigned cvt_pk_bf16_n(float lo, float hi) { const f32x2 v = {lo, hi}; const bf16x2_t b = __builtin_convertvector(v, bf16x2_t); return __builtin_bit_cast(unsigned, b); }
__device__ __forceinline__ unsigned cvt_pk_bf16(float lo, float hi) { unsigned r; asm volatile("s_nop 0\n\tv_cvt_pk_bf16_f32 %0, %1, %2" : "=v"(r) : "v"(lo), "v"(hi)); return r; }
__device__ __forceinline__ float bf_lo(unsigned w) { return __uint_as_float(w << 16); }
__device__ __forceinline__ float bf_hi(unsigned w) { return __uint_as_float(w & 0xffff0000u); }
__device__ __forceinline__ float bf2f(bf16_t b) { return __uint_as_float((unsigned)b << 16); }
__device__ __forceinline__ float sigmoidf_(float z) { return __builtin_amdgcn_rcpf(1.0f + __expf(-z)); }
__device__ __forceinline__ float siluf_(float z) { return z * __builtin_amdgcn_rcpf(1.0f + __expf(-z)); }

namespace pg8 {
constexpr int BM = 256, BK = 64, HALF = 128, HTB = HALF * BK * 2, STAGE_BYTES = 8 * HTB, NXCD = 8, WGM = 8;
__host__ __device__ __forceinline__ int lds_byte(int r, int c) { const int st = (r >> 4) * 2 + (c >> 5), rr = r & 15, cc = c & 31, ob = rr * 64 + cc * 2; return st * 1024 + (ob ^ (((ob >> 9) & 1) << 5)); }
__host__ __device__ __forceinline__ void stage_rc(int b, int& R, int& C) { const int st = b / 1024, sb = b % 1024, swz = sb ^ (((sb >> 9) & 1) << 5); R = (st >> 1) * 16 + swz / 64; C = (st & 1) * 32 + (swz % 64) / 2; }
__host__ __device__ __forceinline__ int perm32(int rho) { const int n = rho >> 4, i = rho & 15; return 8 * (i >> 2) + 4 * n + (i & 3); }

struct Unit { const char* A; const char* B; int pm, pn, kind, keep; };
struct Gemm { int lda, ldb, K; };

struct Sched {
    const char *A0, *A1, *B0, *B1; size_t a_pm, a_pn, b_pn; int nM, nN, nwg, G, c, chain;
    __device__ __forceinline__ bool next(int i, Unit& u) const {
        const int ti = (chain == 2) ? (i >> 1) : i, which = (chain == 2) ? (i & 1) : 0;
        const long L = (long)ti * G + c; if (L >= nwg) return false;
        int wgid = (int)L; { const int q = nwg / NXCD, r = nwg % NXCD, xcd = wgid % NXCD, off = wgid / NXCD; wgid = (xcd < r ? xcd * (q + 1) : r * (q + 1) + (xcd - r) * q) + off; }
        const int nig = WGM * nN, gid = wgid / nig, fm = gid * WGM, gsz = (nM - fm) < WGM ? (nM - fm) : WGM;
        u.pm = fm + ((wgid % nig) % gsz); u.pn = (wgid % nig) / gsz;
        u.A = (which ? A1 : A0) + (size_t)u.pm * a_pm + (size_t)u.pn * a_pn; u.B = (which ? B1 : B0) + (size_t)u.pn * b_pn;
        u.kind = which; u.keep = (chain == 2 && which == 0) ? 1 : 0; return true;
    }
};

template <class Epi>
__device__ __forceinline__ void gemm_phase(LAS unsigned char* lds, const int tid, const Gemm g, const Sched& S, const Epi& E) {
    const int wid = __builtin_amdgcn_readfirstlane(tid >> 6), lane = tid & 63, wr = wid >> 2, wc = wid & 3, fr = lane & 15, fq = lane >> 4;
    const int K = g.K, nt = K / BK;
    unsigned voffA[2], voffB[2];
#pragma unroll
    for (int i = 0; i < 2; ++i) { int R, C; stage_rc(tid * 16 + i * 8192, R, C); const int Rb = Epi::PERM ? ((R & ~31) + perm32(R & 31)) : R;
        voffA[i] = (unsigned)(R * g.lda + C) * 2u; voffB[i] = (unsigned)(Rb * g.ldb + C) * 2u; }
    const size_t kstep = (size_t)(BK * 2);
    const size_t hstepA = (size_t)HALF * g.lda * 2, hstepB = (size_t)HALF * g.ldb * 2;
    const unsigned ldsw = (unsigned)wid * 1024u;
    const int aoff = lds_byte(wr * 64 + fr, fq * 8), boff = lds_byte(wc * 32 + fr, fq * 8);
#define PG8_SA(b, h) (((b) * 2 + (h)) * HTB)
#define PG8_SB(b, h) ((4 + (b) * 2 + (h)) * HTB)
#define PG8_STAGE(bufoff, gbase, voff) do { _Pragma("unroll") for (int _i = 0; _i < 2; ++_i) \
        __builtin_amdgcn_global_load_lds((const unsigned*)((const char*)(gbase) + (voff)[_i]), (LAS unsigned*)(lds + (bufoff) + ldsw + _i * 8192), 16, 0, 0); } while (0)
#define PG8_LDA(dst, b, h) do { _Pragma("unroll") for (int m = 0; m < 4; ++m) _Pragma("unroll") for (int k = 0; k < 2; ++k) dst[m][k] = *(const LAS bf16x8*)(lds + PG8_SA(b, h) + aoff + m * 2048 + k * 1024); } while (0)
#define PG8_LDB(dst, b, h) do { _Pragma("unroll") for (int n = 0; n < 2; ++n) _Pragma("unroll") for (int k = 0; k < 2; ++k) dst[n][k] = *(const LAS bf16x8*)(lds + PG8_SB(b, h) + boff + n * 2048 + k * 1024); } while (0)
#define PG8_MMA(ai, bj, At, Bt) do { __builtin_amdgcn_s_setprio(1); _Pragma("unroll") for (int m = 0; m < 4; ++m) _Pragma("unroll") for (int n = 0; n < 2; ++n) _Pragma("unroll") for (int k = 0; k < 2; ++k) \
        acc[ai][bj][m][n] = __builtin_amdgcn_mfma_f32_16x16x32_bf16(Bt[n][k], At[m][k], acc[ai][bj][m][n], 0, 0, 0); __builtin_amdgcn_s_setprio(0); } while (0)
#define PG8_WAIT_V(n) asm volatile("s_waitcnt vmcnt(" #n ")" ::: "memory")
#define PG8_WAIT_L(n) asm volatile("s_waitcnt lgkmcnt(" #n ")" ::: "memory")
#define PG8_BAR __builtin_amdgcn_s_barrier()
#define PG8_SCHED __builtin_amdgcn_sched_barrier(0)
    Unit cur, nxt; int ui = 0;
    if (!S.next(0, cur)) return;
    f32x4 acc[2][2][4][2];
#pragma unroll
    for (int a = 0; a < 2; ++a)
#pragma unroll
        for (int b = 0; b < 2; ++b)
#pragma unroll
            for (int m = 0; m < 4; ++m)
#pragma unroll
                for (int n = 0; n < 2; ++n) acc[a][b][m][n] = (f32x4){0.f, 0.f, 0.f, 0.f};
    bf16x8 At[4][2], B0[2][2], B1[2][2];
    const char* cA = cur.A; const char* cB = cur.B;
    PG8_STAGE(PG8_SB(0, 0), cB, voffB); PG8_STAGE(PG8_SB(0, 1), cB + hstepB, voffB); PG8_STAGE(PG8_SA(0, 0), cA, voffA); PG8_STAGE(PG8_SA(0, 1), cA + hstepA, voffA);
    if (wr == 1) PG8_BAR;
    PG8_WAIT_V(2); PG8_BAR;
    PG8_STAGE(PG8_SB(1, 0), cB + kstep, voffB); PG8_STAGE(PG8_SA(1, 0), cA + kstep, voffA); PG8_STAGE(PG8_SB(1, 1), cB + hstepB + kstep, voffB);
    PG8_WAIT_V(6); PG8_BAR;
    for (;;) {
        const bool has_next = S.next(ui + 1, nxt);
        const char* nA = has_next ? nxt.A : cA; const char* nB = has_next ? nxt.B : cB;
        for (int t = 0; t < nt; t += 2) {
            const bool last = (t == nt - 2);
            const char* a1 = cA + (size_t)(t + 1) * kstep;
            const char* a2 = last ? nA : cA + (size_t)(t + 2) * kstep; const char* b2 = last ? nB : cB + (size_t)(t + 2) * kstep;
            const char* a3 = a2 + kstep; const char* b3 = b2 + kstep;
            PG8_LDB(B0, 0, 0); PG8_LDB(B1, 0, 1); PG8_SCHED; PG8_LDA(At, 0, 0); PG8_STAGE(PG8_SA(1, 1), a1 + hstepA, voffA);
            PG8_WAIT_V(8); PG8_WAIT_L(0); PG8_BAR; PG8_MMA(0, 0, At, B0); PG8_MMA(0, 1, At, B1); PG8_BAR; PG8_SCHED;
            PG8_LDA(At, 0, 1); PG8_STAGE(PG8_SB(0, 0), b2, voffB); PG8_STAGE(PG8_SB(0, 1), b2 + hstepB, voffB); PG8_STAGE(PG8_SA(0, 0), a2, voffA);
            PG8_WAIT_V(8); PG8_WAIT_L(0); PG8_BAR; PG8_MMA(1, 0, At, B0); PG8_MMA(1, 1, At, B1); PG8_BAR; PG8_SCHED;
            PG8_LDB(B0, 1, 0); PG8_LDB(B1, 1, 1); PG8_SCHED; PG8_LDA(At, 1, 0); PG8_STAGE(PG8_SA(0, 1), a2 + hstepA, voffA);
            PG8_WAIT_V(8); PG8_WAIT_L(0); PG8_BAR; PG8_MMA(0, 0, At, B0); PG8_MMA(0, 1, At, B1); PG8_BAR; PG8_SCHED;
            PG8_LDA(At, 1, 1); PG8_STAGE(PG8_SB(1, 0), b3, voffB); PG8_STAGE(PG8_SB(1, 1), b3 + hstepB, voffB); PG8_STAGE(PG8_SA(1, 0), a3, voffA);
            PG8_WAIT_V(8); PG8_WAIT_L(0); PG8_BAR; PG8_MMA(1, 0, At, B0); PG8_MMA(1, 1, At, B1); PG8_BAR; PG8_SCHED;
        }
        if (wr == 0) PG8_BAR;
        asm volatile("s_nop 7\n\ts_nop 7" ::: "memory");
        { int t2 = tid; asm volatile("" : "+v"(t2));
          const int l2 = t2 & 63; E(acc, cur, wr, wc, l2 & 15, l2 >> 4); }
        if (!has_next) break;
        if (!cur.keep) {
#pragma unroll
            for (int a = 0; a < 2; ++a)
#pragma unroll
                for (int b = 0; b < 2; ++b)
#pragma unroll
                    for (int m = 0; m < 4; ++m)
#pragma unroll
                        for (int n = 0; n < 2; ++n) acc[a][b][m][n] = (f32x4){0.f, 0.f, 0.f, 0.f};
        }
        cur = nxt; cA = nA; cB = nB; ++ui;
        if (wr == 1) PG8_BAR;
    }
    PG8_WAIT_V(0);
    PG8_BAR;
#undef PG8_SA
#undef PG8_SB
#undef PG8_STAGE
#undef PG8_LDA
#undef PG8_LDB
#undef PG8_MMA
#undef PG8_WAIT_V
#undef PG8_WAIT_L
#undef PG8_BAR
#undef PG8_SCHED
}

struct EpiSplit {
    static constexpr bool PERM = true;
    bf16_t* base;
    __device__ __forceinline__ void operator()(const f32x4 (&acc)[2][2][4][2], const Unit& u, int wr, int wc, int fr, int fq) const {
        const int row0 = u.pm * BM + wr * 64 + fr; const int colt = u.pn * BM; const int t = colt >> 10;
        bf16_t* b = base + (size_t)t * ((size_t)MTOK * 1024); const int col0 = (colt & 1023) + wc * 32 + 8 * fq;
#pragma unroll
        for (int ai = 0; ai < 2; ++ai)
#pragma unroll
            for (int m = 0; m < 4; ++m) { bf16_t* rowp = b + (size_t)(row0 + ai * HALF + m * 16) * 1024 + col0;
#pragma unroll
                for (int bj = 0; bj < 2; ++bj) { const f32x4 v0 = acc[ai][bj][m][0], v1 = acc[ai][bj][m][1];
                    u32x4 w; w.x = cvt_pk_bf16(v0[0], v0[1]); w.y = cvt_pk_bf16(v0[2], v0[3]); w.z = cvt_pk_bf16(v1[0], v1[1]); w.w = cvt_pk_bf16(v1[2], v1[3]);
                    gst<u32x4>(rowp + bj * HALF, w); } }
    }
};
struct EpiSig {
    static constexpr bool PERM = true;
    bf16_t* O; const float* bias;
    __device__ __forceinline__ void operator()(const f32x4 (&acc)[2][2][4][2], const Unit& u, int wr, int wc, int fr, int fq) const {
        const int row0 = u.pm * BM + wr * 64 + fr; const int col0 = u.pn * BM + wc * 32 + 8 * fq;
        f32x4 bv[2][2];
#pragma unroll
        for (int bj = 0; bj < 2; ++bj)
#pragma unroll
            for (int n = 0; n < 2; ++n) bv[bj][n] = gld<f32x4>(bias + col0 + bj * HALF + 4 * n);
        bf16_t* Oh = O + (size_t)(col0 >> 10) * ((size_t)MTOK * 1024) + (col0 & 1023);
#pragma unroll
        for (int ai = 0; ai < 2; ++ai)
#pragma unroll
            for (int m = 0; m < 4; ++m) { bf16_t* rowp = Oh + (size_t)(row0 + ai * HALF + m * 16) * 1024;
#pragma unroll
                for (int bj = 0; bj < 2; ++bj) { f32x4 v0 = acc[ai][bj][m][0] + bv[bj][0], v1 = acc[ai][bj][m][1] + bv[bj][1];
#pragma unroll
                    for (int j = 0; j < 4; ++j) { v0[j] = sigmoidf_(v0[j]); v1[j] = sigmoidf_(v1[j]); }
                    u32x4 w; w.x = cvt_pk_bf16(v0[0], v0[1]); w.y = cvt_pk_bf16(v0[2], v0[3]); w.z = cvt_pk_bf16(v1[0], v1[1]); w.w = cvt_pk_bf16(v1[2], v1[3]);
                    gst<u32x4>(rowp + bj * HALF, w); } }
    }
};
struct EpiPool {
    static constexpr bool PERM = true;
    bf16_t* GB; const float* scale;
    __device__ __forceinline__ void operator()(const f32x4 (&acc)[2][2][4][2], const Unit& u, int wr, int wc, int fr, int fq) const {
        const int row0 = u.pm * BM + wr * 64 + fr; const int col0 = u.pn * BM + wc * 32 + 8 * fq;
        f32x4 sv[2][2];
#pragma unroll
        for (int bj = 0; bj < 2; ++bj)
#pragma unroll
            for (int n = 0; n < 2; ++n) sv[bj][n] = gld<f32x4>(scale + col0 + bj * HALF + 4 * n);
#pragma unroll
        for (int ai = 0; ai < 2; ++ai)
#pragma unroll
            for (int m = 0; m < 4; ++m) { bf16_t* rowp = GB + (size_t)(row0 + ai * HALF + m * 16) * 1024 + col0;
#pragma unroll
                for (int bj = 0; bj < 2; ++bj) { const u32x4 gw = gld<u32x4>(rowp + bj * HALF);
                    f32x4 v0 = acc[ai][bj][m][0] * sv[bj][0], v1 = acc[ai][bj][m][1] * sv[bj][1];
                    v0[0] *= siluf_(bf_lo(gw.x)); v0[1] *= siluf_(bf_hi(gw.x)); v0[2] *= siluf_(bf_lo(gw.y)); v0[3] *= siluf_(bf_hi(gw.y));
                    v1[0] *= siluf_(bf_lo(gw.z)); v1[1] *= siluf_(bf_hi(gw.z)); v1[2] *= siluf_(bf_lo(gw.w)); v1[3] *= siluf_(bf_hi(gw.w));
                    u32x4 w; w.x = cvt_pk_bf16(v0[0], v0[1]); w.y = cvt_pk_bf16(v0[2], v0[3]); w.z = cvt_pk_bf16(v1[0], v1[1]); w.w = cvt_pk_bf16(v1[2], v1[3]);
                    gst<u32x4>(rowp + bj * HALF, w); } }
    }
};
struct EpiProj {
    static constexpr bool PERM = true;
    const bf16_t* MG; bf16_t* O;
    __device__ __forceinline__ void operator()(f32x4 (&acc)[2][2][4][2], const Unit& u, int wr, int wc, int fr, int fq) const {
        const int row0 = u.pm * BM + wr * 64 + fr; const int col0 = u.pn * BM + wc * 32 + 8 * fq;
        if (u.kind == 0) {
#pragma unroll
            for (int ai = 0; ai < 2; ++ai)
#pragma unroll
                for (int m = 0; m < 4; ++m) { const bf16_t* gp = MG + (size_t)(row0 + ai * HALF + m * 16) * 1024 + col0;
#pragma unroll
                    for (int bj = 0; bj < 2; ++bj) { const u32x4 ga = gld<u32x4>(gp + bj * HALF), gb = gld<u32x4>(gp + (size_t)MTOK * 1024 + bj * HALF);
                        f32x4& v0 = acc[ai][bj][m][0]; f32x4& v1 = acc[ai][bj][m][1];
                        v0[0] *= bf_lo(ga.x) * __builtin_amdgcn_rcpf(bf_lo(gb.x)); v0[1] *= bf_hi(ga.x) * __builtin_amdgcn_rcpf(bf_hi(gb.x));
                        v0[2] *= bf_lo(ga.y) * __builtin_amdgcn_rcpf(bf_lo(gb.y)); v0[3] *= bf_hi(ga.y) * __builtin_amdgcn_rcpf(bf_hi(gb.y));
                        v1[0] *= bf_lo(ga.z) * __builtin_amdgcn_rcpf(bf_lo(gb.z)); v1[1] *= bf_hi(ga.z) * __builtin_amdgcn_rcpf(bf_hi(gb.z));
                        v1[2] *= bf_lo(ga.w) * __builtin_amdgcn_rcpf(bf_lo(gb.w)); v1[3] *= bf_hi(ga.w) * __builtin_amdgcn_rcpf(bf_hi(gb.w)); } }
        } else {
#pragma unroll
            for (int ai = 0; ai < 2; ++ai)
#pragma unroll
                for (int m = 0; m < 4; ++m) { const size_t r = (size_t)(row0 + ai * HALF + m * 16); const bf16_t* gp = MG + (size_t)MTOK * 1024 + r * 1024 + col0; bf16_t* rowp = O + r * 1024 + col0;
#pragma unroll
                    for (int bj = 0; bj < 2; ++bj) { const u32x4 gb = gld<u32x4>(gp + bj * HALF);
                        const f32x4 v0 = acc[ai][bj][m][0], v1 = acc[ai][bj][m][1];
                        u32x4 w; w.x = cvt_pk_bf16(v0[0] * bf_lo(gb.x), v0[1] * bf_hi(gb.x)); w.y = cvt_pk_bf16(v0[2] * bf_lo(gb.y), v0[3] * bf_hi(gb.y));
                        w.z = cvt_pk_bf16(v1[0] * bf_lo(gb.z), v1[1] * bf_hi(gb.z)); w.w = cvt_pk_bf16(v1[2] * bf_lo(gb.w), v1[3] * bf_hi(gb.w));
                        gst<u32x4>(rowp + bj * HALF, w); } }
        }
    }
};
struct EpiOut {
    static constexpr bool PERM = false;
    const float* xres; float* out;
    __device__ __forceinline__ void operator()(const f32x4 (&acc)[2][2][4][2], const Unit& u, int wr, int wc, int fr, int fq) const {
        const int row0 = u.pm * BM + wr * 64 + fr, col0 = u.pn * BM + wc * 32 + 4 * fq;
#pragma unroll
        for (int ai = 0; ai < 2; ++ai)
#pragma unroll
            for (int m = 0; m < 4; ++m) { const size_t off = (size_t)(row0 + ai * HALF + m * 16) * 1024 + col0;
#pragma unroll
                for (int bj = 0; bj < 2; ++bj)
#pragma unroll
                    for (int n = 0; n < 2; ++n) { const f32x4 xs = gld<f32x4>(xres + off + bj * HALF + n * 16);
                        gst<f32x4>(out + off + bj * HALF + n * 16, xs * DN_ALPHA + acc[ai][bj][m][n]); } }
    }
};
}

struct Args { const float* in[13]; float* out; unsigned char* ws; int ph_lo, ph_hi; };
typedef const __attribute__((address_space(4))) Args CArgs;
struct Ctx { int tid, lane, wave, G, bid; int grp, gj, gs, bpg; int team; };

__device__ __forceinline__ float wave_sum(float v) {
#pragma unroll
    for (int o = 1; o < 64; o <<= 1) v += __shfl_xor(v, o);
    return v;
}

__device__ __forceinline__ void transpose_item(const float* W, int ld_src, int col0, int nblk, int K, bf16_t* WT, int row_off, LAS float* scr, int item, int lane) {
    const int kb = item / nblk, nb = item % nblk, k0 = 64 * kb, n0 = 32 * nb;
    {   float tv[32];
        const float* wp = W + (size_t)(k0 + (lane >> 5)) * ld_src + col0 + n0 + (lane & 31);
#pragma unroll
        for (int i = 0; i < 32; ++i) tv[i] = gld<float>(wp + (size_t)(2 * i) * ld_src);
#pragma unroll
        for (int i = 0; i < 32; ++i) scr[(2 * i + (lane >> 5)) * 33 + (lane & 31)] = tv[i]; }
    asm volatile("s_waitcnt lgkmcnt(0)" ::: "memory");
    const int c = lane & 7;
#pragma unroll
    for (int j = 0; j < 4; ++j) { const int n = (lane >> 3) + 8 * j; const LAS float* s = scr + (8 * c) * 33 + n;
        u32x4 o; o.x = cvt_pk_bf16(s[0 * 33], s[1 * 33]); o.y = cvt_pk_bf16(s[2 * 33], s[3 * 33]); o.z = cvt_pk_bf16(s[4 * 33], s[5 * 33]); o.w = cvt_pk_bf16(s[6 * 33], s[7 * 33]);
        gst<u32x4>(WT + (size_t)(row_off + n0 + n) * K + k0 + 8 * c, o); }
    asm volatile("s_waitcnt lgkmcnt(0)" ::: "memory");
}
__device__ __forceinline__ void compose_item(const float* w_in  , const float* w_g  , bf16_t* WT  , LAS float* scr, int item, int lane) {
    const int kb = item >> 5, nb = item & 31, k0 = 16 * kb, ng = nb * 32 + (lane & 31), g = ng >> 8, o = ng & 255, kh = lane >> 5;
    const float* arow = w_in + (size_t)k0 * INC + 3088 + g * 256;
#pragma unroll
    for (int r = 0; r < 16; ++r) *(LAS f32x4*)(scr + r * 256 + 4 * lane) = gld<f32x4>(arow + (size_t)r * INC + 4 * lane);
    asm volatile("s_waitcnt lgkmcnt(0)" ::: "memory");
    const float* bcol = w_g + (size_t)g * 65536 + o;
    float acc[8];
#pragma unroll
    for (int j = 0; j < 8; ++j) acc[j] = 0.f;
    float bv[16], bn[16];
#pragma unroll
    for (int e = 0; e < 16; ++e) bv[e] = gld<float>(bcol + (size_t)e * 256);
#pragma unroll 1
    for (int i0 = 0; i0 < 256; i0 += 16) {
        const int inext = (i0 + 16 < 256) ? i0 + 16 : i0;
#pragma unroll
        for (int e = 0; e < 16; ++e) bn[e] = gld<float>(bcol + (size_t)(inext + e) * 256);
#pragma unroll
        for (int q = 0; q < 4; ++q)
#pragma unroll
            for (int j = 0; j < 8; ++j) { const f32x4 av = *(const LAS f32x4*)(scr + (kh * 8 + j) * 256 + i0 + 4 * q);
                acc[j] += (av[0] * bv[4 * q] + av[1] * bv[4 * q + 1]) + (av[2] * bv[4 * q + 2] + av[3] * bv[4 * q + 3]); }
#pragma unroll
        for (int e = 0; e < 16; ++e) bv[e] = bn[e];
    }
    u32x4 ov; ov.x = cvt_pk_bf16(acc[0], acc[1]); ov.y = cvt_pk_bf16(acc[2], acc[3]); ov.z = cvt_pk_bf16(acc[4], acc[5]); ov.w = cvt_pk_bf16(acc[6], acc[7]);
    gst<u32x4>(WT + (size_t)ng * 1024 + k0 + kh * 8, ov);
    asm volatile("s_waitcnt lgkmcnt(0)" ::: "memory");
}
__device__ __forceinline__ void convert_weights(CArgs& a, const Ctx& cx, LAS unsigned char* lds, int l) {
    LAS float* scr = (LAS float*)(lds + cx.wave * 16384);
    const int gw = cx.bid * 8 + cx.wave, NGW = cx.G * 8;
    unsigned char* ws = a.ws + (size_t)(l & 1) * WSET_BYTES;
    const float* w_in = a.in[1] + (size_t)l * 1024 * INC;
    const float* w_pa = a.in[8] + (size_t)l * 1024 * 1024; const float* w_pb = a.in[9] + (size_t)l * 1024 * 1024; const float* w_o = a.in[10] + (size_t)l * 1024 * 1024;
    const float* w_g = a.in[5] + (size_t)l * 4 * 256 * 256;
    constexpr int I_A = 16 * 96, I_GB = 16 * 32, I_M = 16 * 64, I_P = 16 * 32, I_C = 64 * 32;
    constexpr int NIT = I_A + I_GB + I_M + 3 * I_P + I_C;
    for (int it = gw; it < NIT; it += NGW) {
        int r = it;
        if (r < I_A) { transpose_item(w_in, INC, 0, 96, 1024, (bf16_t*)(ws + WS_W1A), 0, scr, r, cx.lane); continue; } r -= I_A;
        if (r < I_GB) { transpose_item(w_in, INC, 4112, 32, 1024, (bf16_t*)(ws + WS_W1A), 3072, scr, r, cx.lane); continue; } r -= I_GB;
        if (r < I_M) { transpose_item(w_in, INC, 5136, 64, 1024, (bf16_t*)(ws + WS_WM), 0, scr, r, cx.lane); continue; } r -= I_M;
        if (r < I_P) { transpose_item(w_pa, 1024, 0, 32, 1024, (bf16_t*)(ws + WS_WA), 0, scr, r, cx.lane); continue; } r -= I_P;
        if (r < I_P) { transpose_item(w_pb, 1024, 0, 32, 1024, (bf16_t*)(ws + WS_WB), 0, scr, r, cx.lane); continue; } r -= I_P;
        if (r < I_P) { transpose_item(w_o, 1024, 0, 32, 1024, (bf16_t*)(ws + WS_WO), 0, scr, r, cx.lane); continue; } r -= I_P;
        compose_item(w_in, w_g, (bf16_t*)(ws + WS_W1A) + (size_t)4096 * 1024, scr, r, cx.lane);
    }
}

__device__ __forceinline__ void row_phase(const Ctx& cx, LAS unsigned char* lds, const float* src, float* dst, bf16_t* xbf, float* AL, const float* walpha  ,
                                          const float* lng, const float* lnb, bool do_ln, bool dry = false) {
    LAS float* WT = (LAS float*)lds;
    if (AL) {
        for (int idx = cx.tid; idx < 16384; idx += 512) { const int k = idx >> 4, c = idx & 15; WT[c * 1028 + k] = gld<float>(walpha + (size_t)k * INC + c); }
    }
    __syncthreads();
    const int gw = cx.gj * 8 + cx.wave, NGW = cx.gs * 8, lane = cx.lane; const int rg0 = cx.grp * cx.bpg * 2048, nrg = cx.bpg * 2048;
    f32x4 gj[4], bj[4];
#pragma unroll
    for (int j = 0; j < 4; ++j) { gj[j] = (f32x4){1.f, 1.f, 1.f, 1.f}; bj[j] = (f32x4){0.f, 0.f, 0.f, 0.f}; }
    if (do_ln) {
#pragma unroll
        for (int j = 0; j < 4; ++j) { gj[j] = gld<f32x4>(lng + 256 * j + 4 * lane); bj[j] = gld<f32x4>(lnb + 256 * j + 4 * lane); }
    }
    for (int rl = gw; rl < nrg; rl += NGW) {
        const size_t m0 = (size_t)(rg0 + rl) * 4;
        f32x4 v[4][4];
#pragma unroll
        for (int r = 0; r < 4; ++r)
#pragma unroll
            for (int j = 0; j < 4; ++j) v[r][j] = gld<f32x4>(src + (m0 + r) * 1024 + 256 * j + 4 * lane);
        if (do_ln) {
#pragma unroll
            for (int r = 0; r < 4; ++r) {
                float s = 0.f;
#pragma unroll
                for (int j = 0; j < 4; ++j) s += (v[r][j][0] + v[r][j][1]) + (v[r][j][2] + v[r][j][3]);
                const float mean = wave_sum(s) * (1.f / 1024.f); float s2 = 0.f;
#pragma unroll
                for (int j = 0; j < 4; ++j) { v[r][j] = v[r][j] - mean; s2 += (v[r][j][0] * v[r][j][0] + v[r][j][1] * v[r][j][1]) + (v[r][j][2] * v[r][j][2] + v[r][j][3] * v[r][j][3]); }
                const float rstd = __builtin_amdgcn_rsqf(wave_sum(s2) * (1.f / 1024.f) + LN_EPS);
#pragma unroll
                for (int j = 0; j < 4; ++j) { v[r][j] = v[r][j] * rstd * gj[j] + bj[j]; if (!dry) gst<f32x4>(dst + (m0 + r) * 1024 + 256 * j + 4 * lane, v[r][j]); }
            }
        }
        if (xbf) {
#pragma unroll
            for (int r = 0; r < 4; ++r)
#pragma unroll
                for (int j = 0; j < 4; ++j) { u32x2 w; w.x = cvt_pk_bf16(v[r][j][0], v[r][j][1]); w.y = cvt_pk_bf16(v[r][j][2], v[r][j][3]);
                    if (!dry) gst<u32x2>(xbf + (m0 + r) * 1024 + 256 * j + 4 * lane, w); }
        }
        if (AL) {
            float acc[64];
#pragma unroll
            for (int i = 0; i < 64; ++i) acc[i] = 0.f;
#pragma unroll
            for (int c = 0; c < 16; ++c)
#pragma unroll
                for (int j = 0; j < 4; ++j) { const f32x4 w = *(const LAS f32x4*)(WT + c * 1028 + 256 * j + 4 * lane);
#pragma unroll
                    for (int r = 0; r < 4; ++r) acc[r * 16 + c] += (v[r][j][0] * w[0] + v[r][j][1] * w[1]) + (v[r][j][2] * w[2] + v[r][j][3] * w[3]); }
#pragma unroll
            for (int h = 32; h >= 1; h >>= 1) {
                const bool up = (lane & h) != 0;
#pragma unroll
                for (int i = 0; i < h; ++i) { const float keep = up ? acc[i + h] : acc[i]; const float send = up ? acc[i] : acc[i + h]; acc[i] = keep + __shfl_xor(send, h); }
            }
            if (!dry) gst<float>(AL + m0 * 16 + lane, acc[0]);
        }
    }
}

__device__ __forceinline__ void unpack8(const u32x4 w, float (&f)[8]) { f[0] = bf_lo(w.x); f[1] = bf_hi(w.x); f[2] = bf_lo(w.y); f[3] = bf_hi(w.y); f[4] = bf_lo(w.z); f[5] = bf_hi(w.z); f[6] = bf_lo(w.w); f[7] = bf_hi(w.w); }
__device__ __forceinline__ void pool_phase(const Ctx& cx, const bf16_t* pin, bf16_t* gbuf, const float* scale) {
    const int NT = cx.bpg * 32768, q0 = cx.grp * cx.bpg * 32768;
    for (int ql = cx.gj * 512 + cx.tid; ql < NT; ql += cx.gs * 512) { const int q = q0 + ql;
        const int cg8 = q & 127, seg = q >> 7; const int g = cg8 >> 5; const int w = 2 << g;
        const int t0 = seg * 32, pos0 = t0 & (SEQ - 1);
        const bf16_t* base = pin + (size_t)t0 * 1024 + cg8 * 8;
        float sum[8], sc[8];
        { const f32x4 s0 = gld<f32x4>(scale + cg8 * 8), s1 = gld<f32x4>(scale + cg8 * 8 + 4); sc[0] = s0[0]; sc[1] = s0[1]; sc[2] = s0[2]; sc[3] = s0[3]; sc[4] = s1[0]; sc[5] = s1[1]; sc[6] = s1[2]; sc[7] = s1[3]; }
        bf16_t* gb = gbuf + (size_t)t0 * 1024 + cg8 * 8;
#pragma unroll
        for (int e = 0; e < 8; ++e) sum[e] = 0.f;
        if (pos0 > 0) {
#pragma unroll 1
            for (int jb = 0; jb < 16; jb += 8) {
                u32x4 hv[8];
#pragma unroll
                for (int j = 0; j < 8; ++j) hv[j] = gld<u32x4>(base - (size_t)(jb + j + 1) * 1024);
#pragma unroll
                for (int j = 0; j < 8; ++j) { float f[8]; unpack8(hv[j], f); const float m = (jb + j + 1 <= w) ? 1.f : 0.f;
#pragma unroll
                    for (int e = 0; e < 8; ++e) sum[e] += m * f[e]; }
            }
        }
#pragma unroll 1
        for (int ib = 0; ib < 32; ib += 4) {
            u32x4 xv[4], ov[4], gv[4];
#pragma unroll
            for (int i = 0; i < 4; ++i) { xv[i] = gld<u32x4>(base + (size_t)(ib + i) * 1024); gv[i] = gld<u32x4>(gb + (size_t)(ib + i) * 1024);
                const int back = (pos0 + ib + i - w >= 0) ? w : 0;
                ov[i] = gld<u32x4>(base + (size_t)(ib + i - back) * 1024); }
#pragma unroll
            for (int i = 0; i < 4; ++i) {
                const int pos = pos0 + ib + i; float x[8], f[8], gt[8]; unpack8(xv[i], x); unpack8(ov[i], f); unpack8(gv[i], gt);
                const float m = (pos - w >= 0) ? 1.f : 0.f;
#pragma unroll
                for (int e = 0; e < 8; ++e) sum[e] += x[e] - m * f[e];
                const int cnt = (pos + 1 < w) ? (pos + 1) : w; const float inv = __builtin_amdgcn_rcpf((float)cnt);
                float y[8];
#pragma unroll
                for (int e = 0; e < 8; ++e) y[e] = (sum[e] * inv - x[e]) * sc[e] * siluf_(gt[e]);
                u32x4 o; o.x = cvt_pk_bf16(y[0], y[1]); o.y = cvt_pk_bf16(y[2], y[3]); o.z = cvt_pk_bf16(y[4], y[5]); o.w = cvt_pk_bf16(y[6], y[7]);
                gst<u32x4>(gb + (size_t)(ib + i) * 1024, o);
            }
        }
    }
}

constexpr int L_AL = 0, L_GL = 4096, L_RS = 6144, L_KT = 8192  , L_VT1 = 26624  ;
constexpr int L_UST = 63488;
constexpr int L_QA = 8192, L_KA = 25600, L_QB = 43008, L_KB = 60416, L_VT3 = 77824, L_P = 114688;

__device__ __forceinline__ void gla_G(LAS unsigned char* lds, const float (&w)[16], float bias, int d, int tg, float (&g)[16], float& total) {
    const LAS float* AL_s = (const LAS float*)(lds + L_AL); LAS float* GL_s = (LAS float*)(lds + L_GL);
    float run = 0.f;
#pragma unroll
    for (int tt = 0; tt < 16; ++tt) {
        const LAS f32x4* ap = (const LAS f32x4*)(AL_s + (tg * 16 + tt) * 16);
        const f32x4 a0 = ap[0], a1 = ap[1], a2 = ap[2], a3 = ap[3];
        float z = bias;
        z += a0[0] * w[0]; z += a0[1] * w[1]; z += a0[2] * w[2]; z += a0[3] * w[3];
        z += a1[0] * w[4]; z += a1[1] * w[5]; z += a1[2] * w[6]; z += a1[3] * w[7];
        z += a2[0] * w[8]; z += a2[1] * w[9]; z += a2[2] * w[10]; z += a2[3] * w[11];
        z += a3[0] * w[12]; z += a3[1] * w[13]; z += a3[2] * w[14]; z += a3[3] * w[15];
        const float ls = fminf(z, 0.f) - __logf(1.0f + __expf(-fabsf(z)));
        run += ls * (1.0f / 16.0f);
        g[tt] = run;
    }
    GL_s[tg * 128 + d] = run;
    __syncthreads();
    const float p0 = GL_s[d], p1 = GL_s[128 + d], p2 = GL_s[256 + d], p3 = GL_s[384 + d];
    const float prefix = (tg > 0 ? p0 : 0.f) + (tg > 1 ? p1 : 0.f) + (tg > 2 ? p2 : 0.f);
    total = (p0 + p1) + (p2 + p3);
#pragma unroll
    for (int tt = 0; tt < 16; ++tt) g[tt] += prefix;
}
__device__ __forceinline__ void gla_load_stage(const Ctx& cx, const float* AL, const bf16_t* Vb, int it, f32x4& alr, u32x4 (&vr)[2][2]) {
    const int b = it >> 9, c = (it >> 2) & 127, h = it & 3; const int row0 = b * SEQ + c * 64;
    if (cx.tid < 256) alr = gldo<f32x4>(AL + (size_t)row0 * 16, (unsigned)cx.tid * 16u);
    const bf16_t* vb = Vb + (size_t)row0 * 1024 + h * 256;
#pragma unroll
    for (int i = 0; i < 2; ++i) {
        const int q = cx.tid + 512 * i, tp = q & 31, ng = q >> 5;
        const unsigned off = (unsigned)((2 * tp) * 1024 + ng * 8) * 2u;
        vr[i][0] = gldo<u32x4>(vb, off); vr[i][1] = gldo<u32x4>(vb, off + 2048u);
    }
}
__device__ __forceinline__ void gla_write_stage(const Ctx& cx, LAS unsigned char* lds, int vt_off, const f32x4& alr, const u32x4 (&vr)[2][2]) {
    if (cx.tid < 256) ((LAS f32x4*)(lds + L_AL))[cx.tid] = alr;
    LAS unsigned* VT32 = (LAS unsigned*)(lds + vt_off);
#pragma unroll
    for (int i = 0; i < 2; ++i) {
        const int q = cx.tid + 512 * i, tp = q & 31, ng = q >> 5;
        const u32x4 r0 = vr[i][0], r1 = vr[i][1];
#pragma unroll
        for (int j = 0; j < 4; ++j) {
            VT32[(ng * 8 + 2 * j) * 36 + tp] = (r0[j] & 0xffffu) | (r1[j] << 16);
            VT32[(ng * 8 + 2 * j + 1) * 36 + tp] = (r0[j] >> 16) | (r1[j] & 0xffff0000u);
        }
    }
}

__device__ __forceinline__ void gla_p1(CArgs& a, const Ctx& cx, LAS unsigned char* lds, int l) {
    unsigned char* ws = a.ws;
    const float* AL = (const float*)(ws + WS_AL); const bf16_t* QKb = (const bf16_t*)(ws + WS_QK); const bf16_t* Vb = (const bf16_t*)(ws + WS_V);
    unsigned char* US = ws + WS_US; float* DF = (float*)(ws + WS_DF);
    const float* Wup = a.in[2] + (size_t)l * 16 * 512; const float* balpha = a.in[3] + (size_t)l * 512;
    const int tid = cx.tid, lane = cx.lane, wv = cx.wave, fr = lane & 15, fq = lane >> 4;
    const int d = tid & 127, tg = tid >> 7;
    f32x4 alr = (f32x4){0.f, 0.f, 0.f, 0.f}; u32x4 vr[2][2];
    float w[16], bias = 0.f; int prev_h = -1;
    const int it0 = cx.grp * cx.bpg * 512 + cx.gj, itend = (cx.grp + 1) * cx.bpg * 512;
    if (it0 < itend) gla_load_stage(cx, AL, Vb, it0, alr, vr);
    for (int it = it0; it < itend; it += cx.gs) {
        const int b = it >> 9, c = (it >> 2) & 127, h = it & 3; const int row0 = b * SEQ + c * 64; const int slot = (b * 4 + h) * NCH + c;
        __syncthreads();
        gla_write_stage(cx, lds, L_VT1, alr, vr);
        __syncthreads();
        const bf16_t* kb = QKb + (size_t)row0 * 1024 + 512 + h * 128; const unsigned koff = (unsigned)(tg * 16 * 1024 + d) * 2u;
        bf16_t kraw[16];
#pragma unroll
        for (int tt = 0; tt < 16; ++tt) kraw[tt] = gldo<bf16_t>(kb + (size_t)tt * 1024, koff);
        if (h != prev_h) { prev_h = h; bias = gldo<float>(balpha + h * 128, (unsigned)d * 4u);
#pragma unroll
            for (int r = 0; r < 16; ++r) w[r] = gldo<float>(Wup + r * 512 + h * 128, (unsigned)d * 4u); }
        if (it + cx.gs < itend) gla_load_stage(cx, AL, Vb, it + cx.gs, alr, vr);
        float g[16], total;
        gla_G(lds, w, bias, d, tg, g, total);
        unsigned pk[8];
#pragma unroll
        for (int tt = 0; tt < 16; tt += 2) { const float k0 = bf2f(kraw[tt]) * __expf(total - g[tt]), k1 = bf2f(kraw[tt + 1]) * __expf(total - g[tt + 1]); pk[tt >> 1] = cvt_pk_bf16(k0, k1); }
        LAS u32x4* kt = (LAS u32x4*)(lds + L_KT + d * 144 + tg * 32);
        kt[0] = (u32x4){pk[0], pk[1], pk[2], pk[3]}; kt[1] = (u32x4){pk[4], pk[5], pk[6], pk[7]};
        if (tg == 0) gsto<float>(DF + (size_t)slot * 128, (unsigned)d * 4u, __expf(total));
        __syncthreads();
        f32x4 acc[8][2];
#pragma unroll
        for (int dt = 0; dt < 8; ++dt) { acc[dt][0] = (f32x4){0.f, 0.f, 0.f, 0.f}; acc[dt][1] = (f32x4){0.f, 0.f, 0.f, 0.f}; }
#pragma unroll
        for (int ks = 0; ks < 2; ++ks) {
            bf16x8 bfr[2];
#pragma unroll
            for (int nn = 0; nn < 2; ++nn) bfr[nn] = *(const LAS bf16x8*)(lds + L_VT1 + ((2 * wv + nn) * 16 + fr) * 144 + ks * 64 + fq * 16);
#pragma unroll
            for (int dt = 0; dt < 8; ++dt) { const bf16x8 af = *(const LAS bf16x8*)(lds + L_KT + (dt * 16 + fr) * 144 + ks * 64 + fq * 16);
#pragma unroll
                for (int nn = 0; nn < 2; ++nn) acc[dt][nn] = __builtin_amdgcn_mfma_f32_16x16x32_bf16(af, bfr[nn], acc[dt][nn], 0, 0, 0); }
        }
#pragma unroll
        for (int dt = 0; dt < 8; ++dt)
#pragma unroll
            for (int nn = 0; nn < 2; ++nn) { u32x2 o; o.x = cvt_pk_bf16_n(acc[dt][nn][0], acc[dt][nn][1]); o.y = cvt_pk_bf16_n(acc[dt][nn][2], acc[dt][nn][3]);
                *(LAS u32x2*)(lds + L_UST + ((2 * wv + nn) * 16 + fr) * 272 + (dt * 16 + fq * 4) * 2) = o; }
        __syncthreads();
        unsigned char* up = US + us_off(b, h, c);
#pragma unroll
        for (int i = 0; i < 8; ++i) { const int j = tid + 512 * i;
            const u32x4 v = *(const LAS u32x4*)(lds + L_UST + (j >> 4) * 272 + (j & 15) * 16);
            gsto<u32x4>(up + i * 8192, (unsigned)tid * 16u, v); }
    }
}
__device__ __forceinline__ void gla_p2(CArgs& a, const Ctx& cx, bool dry) {
    unsigned char* US = a.ws + WS_US; const float* DF = (const float*)(a.ws + WS_DF);
    const int NT2 = cx.team ? 8192 : cx.bpg * 32768, q20 = cx.team ? (cx.grp * 4 + (cx.gj & 3)) * 8192 : cx.grp * cx.bpg * 32768;
    const int j2 = cx.team ? (cx.gj >> 2) : cx.gj, s2 = cx.team ? (cx.gs >> 2) : cx.gs;
    for (int ql = j2 * 512 + cx.tid; ql < NT2; ql += s2 * 512) { const int q = q20 + ql;
        const int bh = q >> 13, within = q & 8191; const int dq = within & 31;
        unsigned char* p = US + us_off(bh >> 2, bh & 3, 0) + (size_t)within * 8;
        const float* dfp = DF + (size_t)bh * NCH * 128 + dq * 4;
        float s0 = 0.f, s1 = 0.f, s2 = 0.f, s3 = 0.f;
        for (int cb = 0; cb < NCH; cb += 16) {
            u32x2 u[16]; f32x4 df[16];
#pragma unroll
            for (int i = 0; i < 16; ++i) { u[i] = gld<u32x2>(p + (size_t)(cb + i) * 65536); df[i] = gld<f32x4>(dfp + (size_t)(cb + i) * 128); }
#pragma unroll
            for (int i = 0; i < 16; ++i) {
                s0 = df[i][0] * s0 + bf_lo(u[i].x); s1 = df[i][1] * s1 + bf_hi(u[i].x); s2 = df[i][2] * s2 + bf_lo(u[i].y); s3 = df[i][3] * s3 + bf_hi(u[i].y);
                u32x2 o; o.x = cvt_pk_bf16(s0, s1); o.y = cvt_pk_bf16(s2, s3);
                if (!dry) gst<u32x2>(p + (size_t)(cb + i) * 65536, o);
            }
        }
    }
}
__device__ __forceinline__ void gla_p3(CArgs& a, const Ctx& cx, LAS unsigned char* lds, int l, bool dry) {
    unsigned char* ws = a.ws;
    const float* AL = (const float*)(ws + WS_AL); const bf16_t* QKb = (const bf16_t*)(ws + WS_QK); const bf16_t* Vb = (const bf16_t*)(ws + WS_V);
    const unsigned char* US = ws + WS_US; bf16_t* GA = (bf16_t*)(ws + WS_GA);
    const float* Wup = a.in[2] + (size_t)l * 16 * 512; const float* balpha = a.in[3] + (size_t)l * 512; const float* gnorm = a.in[4] + (size_t)l * 1024;
    const int tid = cx.tid, lane = cx.lane, wv = cx.wave, fr = lane & 15, fq = lane >> 4;
    const int d = tid & 127, tg = tid >> 7;
    const int tp = wv & 1, nq = wv >> 1;
    f32x4 alr = (f32x4){0.f, 0.f, 0.f, 0.f}; u32x4 vr[2][2];
    const int it0 = cx.grp * cx.bpg * 512 + cx.gj, itend = (cx.grp + 1) * cx.bpg * 512;
    if (it0 < itend) gla_load_stage(cx, AL, Vb, it0, alr, vr);
    for (int it = it0; it < itend; it += cx.gs) {
        const int b = it >> 9, c = (it >> 2) & 127, h = it & 3; const int row0 = b * SEQ + c * 64; const int slot = (b * 4 + h) * NCH + c;
        __syncthreads();
        gla_write_stage(cx, lds, L_VT3, alr, vr);
        __syncthreads();
        const bf16_t* qb = QKb + (size_t)row0 * 1024 + h * 128; const unsigned qoff = (unsigned)(tg * 16 * 1024 + d) * 2u;
        bf16_t qraw[16], kraw[16];
#pragma unroll
        for (int tt = 0; tt < 16; ++tt) { qraw[tt] = gldo<bf16_t>(qb + (size_t)tt * 1024, qoff); kraw[tt] = gldo<bf16_t>(qb + 512 + (size_t)tt * 1024, qoff); }
        const unsigned char* sp = US + us_off(b, h, c > 0 ? c - 1 : c) + nq * 64 * 256; const unsigned soff = (unsigned)(fr * 256 + fq * 16);
        bf16x8 sf[4][4];
        if (c > 0) {
#pragma unroll
            for (int nt = 0; nt < 4; ++nt)
#pragma unroll
                for (int ks = 0; ks < 4; ++ks) sf[nt][ks] = gldo<bf16x8>(sp + nt * 4096 + ks * 64, soff);
        }
        float g[16], total;
        {   float w[16]; const float bias = gldo<float>(balpha + h * 128, (unsigned)d * 4u);
#pragma unroll
            for (int r = 0; r < 16; ++r) w[r] = gldo<float>(Wup + r * 512 + h * 128, (unsigned)d * 4u);
            if (it + cx.gs < itend) gla_load_stage(cx, AL, Vb, it + cx.gs, alr, vr);
            gla_G(lds, w, bias, d, tg, g, total); }
        {
            LAS bf16_t* QA = (LAS bf16_t*)(lds + L_QA); LAS bf16_t* KA = (LAS bf16_t*)(lds + L_KA); LAS bf16_t* QB = (LAS bf16_t*)(lds + L_QB); LAS bf16_t* KB = (LAS bf16_t*)(lds + L_KB);
#pragma unroll
            for (int tt = 0; tt < 16; ++tt) {
                const float qv = bf2f(qraw[tt]) * QSCALE, kv = bf2f(kraw[tt]); const float eg = __expf(g[tt]), ei = __expf(-g[tt]);
                const int o = (tg * 16 + tt) * 136 + d;
                const unsigned w0 = cvt_pk_bf16(qv * eg, kv * ei), w1 = cvt_pk_bf16(qv * ei, kv * eg);
                QA[o] = (bf16_t)(w0 & 0xffffu); KA[o] = (bf16_t)(w0 >> 16); QB[o] = (bf16_t)(w1 & 0xffffu); KB[o] = (bf16_t)(w1 >> 16);
            }
        }
        __syncthreads();
#pragma unroll
        for (int x = 0; x < 2; ++x) {
            const int tile = 2 * wv + x, tix = tile >> 2, si = tile & 3;
            f32x4 a1 = (f32x4){0.f, 0.f, 0.f, 0.f}, a2 = (f32x4){0.f, 0.f, 0.f, 0.f};
            if (tix >= si) {
#pragma unroll
                for (int ks = 0; ks < 4; ++ks) { const bf16x8 af = *(const LAS bf16x8*)(lds + L_KA + (si * 16 + fr) * 272 + ks * 64 + fq * 16), bfv = *(const LAS bf16x8*)(lds + L_QA + (tix * 16 + fr) * 272 + ks * 64 + fq * 16);
                    a1 = __builtin_amdgcn_mfma_f32_16x16x32_bf16(af, bfv, a1, 0, 0, 0); }
            }
            if (tix <= si) {
#pragma unroll
                for (int ks = 0; ks < 4; ++ks) { const bf16x8 af = *(const LAS bf16x8*)(lds + L_KB + (si * 16 + fr) * 272 + ks * 64 + fq * 16), bfv = *(const LAS bf16x8*)(lds + L_QB + (tix * 16 + fr) * 272 + ks * 64 + fq * 16);
                    a2 = __builtin_amdgcn_mfma_f32_16x16x32_bf16(af, bfv, a2, 0, 0, 0); }
            }
            const int t = tix * 16 + fr, s0 = si * 16 + fq * 4;
            const float p0 = (t >= s0) ? a1[0] : a2[0], p1 = (t >= s0 + 1) ? a1[1] : a2[1], p2 = (t >= s0 + 2) ? a1[2] : a2[2], p3 = (t >= s0 + 3) ? a1[3] : a2[3];
            u32x2 o; o.x = cvt_pk_bf16_n(p0, p1); o.y = cvt_pk_bf16_n(p2, p3);
            *(LAS u32x2*)(lds + L_P + t * 144 + s0 * 2) = o;
        }
        bf16_t* gp = GA + (size_t)row0 * 1024 + h * 256 + nq * 64; const unsigned goff = (unsigned)((2 * tp * 16 + fr) * 1024 + fq * 4) * 2u;
        u32x2 gwv[2][4];
#pragma unroll
        for (int x = 0; x < 2; ++x)
#pragma unroll
            for (int nt = 0; nt < 4; ++nt) gwv[x][nt] = gldo<u32x2>(gp + (size_t)x * 16 * 1024 + nt * 16, goff);
        __syncthreads();
        f32x4 acc[2][4];
#pragma unroll
        for (int x = 0; x < 2; ++x)
#pragma unroll
            for (int i = 0; i < 4; ++i) acc[x][i] = (f32x4){0.f, 0.f, 0.f, 0.f};
        bf16x8 bP[2][2], bQ[2][4];
#pragma unroll
        for (int x = 0; x < 2; ++x) {
#pragma unroll
            for (int ks = 0; ks < 2; ++ks) bP[x][ks] = *(const LAS bf16x8*)(lds + L_P + ((2 * tp + x) * 16 + fr) * 144 + ks * 64 + fq * 16);
#pragma unroll
            for (int ks = 0; ks < 4; ++ks) bQ[x][ks] = *(const LAS bf16x8*)(lds + L_QA + ((2 * tp + x) * 16 + fr) * 272 + ks * 64 + fq * 16);
        }
#pragma unroll
        for (int nt = 0; nt < 4; ++nt) {
            const int n = (nq * 4 + nt) * 16 + fr;
#pragma unroll
            for (int ks = 0; ks < 2; ++ks) { const bf16x8 af = *(const LAS bf16x8*)(lds + L_VT3 + n * 144 + ks * 64 + fq * 16);
#pragma unroll
                for (int x = 0; x < 2; ++x) acc[x][nt] = __builtin_amdgcn_mfma_f32_16x16x32_bf16(af, bP[x][ks], acc[x][nt], 0, 0, 0); }
        }
        if (c > 0) {
#pragma unroll
            for (int nt = 0; nt < 4; ++nt)
#pragma unroll
                for (int ks = 0; ks < 4; ++ks)
#pragma unroll
                    for (int x = 0; x < 2; ++x) acc[x][nt] = __builtin_amdgcn_mfma_f32_16x16x32_bf16(sf[nt][ks], bQ[x][ks], acc[x][nt], 0, 0, 0);
        }
        LAS float* RS = (LAS float*)(lds + L_RS);
#pragma unroll
        for (int x = 0; x < 2; ++x) {
            float ss = 0.f;
#pragma unroll
            for (int nt = 0; nt < 4; ++nt) ss += (acc[x][nt][0] * acc[x][nt][0] + acc[x][nt][1] * acc[x][nt][1]) + (acc[x][nt][2] * acc[x][nt][2] + acc[x][nt][3] * acc[x][nt][3]);
            ss += __shfl_xor(ss, 16); ss += __shfl_xor(ss, 32);
            if (fq == 0) RS[((2 * tp + x) * 16 + fr) * 4 + nq] = ss;
        }
        __syncthreads();
#pragma unroll
        for (int x = 0; x < 2; ++x) {
            const f32x4 r4 = *(const LAS f32x4*)(RS + ((2 * tp + x) * 16 + fr) * 4);
            const float rinv = __builtin_amdgcn_rsqf(((r4[0] + r4[1]) + (r4[2] + r4[3])) * (1.0f / 256.0f) + LN_EPS);
#pragma unroll
            for (int nt = 0; nt < 4; ++nt) {
                const f32x4 gn = gldo<f32x4>(gnorm + h * 256 + nq * 64 + nt * 16, (unsigned)(fq * 4) * 4u);
                const u32x2 gw = gwv[x][nt];
                const float y0 = acc[x][nt][0] * rinv * gn[0] * siluf_(bf_lo(gw.x)), y1 = acc[x][nt][1] * rinv * gn[1] * siluf_(bf_hi(gw.x));
                const float y2 = acc[x][nt][2] * rinv * gn[2] * siluf_(bf_lo(gw.y)), y3 = acc[x][nt][3] * rinv * gn[3] * siluf_(bf_hi(gw.y));
                u32x2 o; o.x = cvt_pk_bf16_n(y0, y1); o.y = cvt_pk_bf16_n(y2, y3);
                if (!dry) gsto<u32x2>(gp + (size_t)x * 16 * 1024 + nt * 16, goff, o);
            }
        }
    }
}

#define XB_TMO      128
#define XB_XCNT(j)  (256  + 64 * (j))
#define XB_XSUB(j)  (1280 + 64 * (j))
#define XB_XGEN(j)  (2304 + 64 * (j))
#define XB_TOP      3328
#define XB_TOPGEN   3392
#define XCD_BAR_WORDS 3456
#define XB_SPIN_CAP (1u << 22)
__device__ __forceinline__ unsigned xb_ld(unsigned* p)              { return __hip_atomic_load(p, __ATOMIC_RELAXED, __HIP_MEMORY_SCOPE_AGENT); }
__device__ __forceinline__ unsigned xb_add(unsigned* p, unsigned v) { return __hip_atomic_fetch_add(p, v, __ATOMIC_RELAXED, __HIP_MEMORY_SCOPE_AGENT); }
__device__ __forceinline__ unsigned xb_xcc_id() { return (unsigned)__builtin_amdgcn_s_getreg((3 << 11) | 20) & 0xFu; }
#define XB_SPIN(cond, bar) do { unsigned _sp = 0; while (cond) { __builtin_amdgcn_s_sleep(1); \
    if ((++_sp & 255u) == 0u) { if (xb_ld(&(bar)[XB_TMO])) break; if (_sp > XB_SPIN_CAP) { atomicAdd(&(bar)[XB_TMO], 1u); break; } } } } while (0)
struct XcdBarrier { unsigned* bar; unsigned x; volatile LAS unsigned* st; unsigned gs; };
__device__ __forceinline__ XcdBarrier xcd_barrier_post(unsigned* bar, volatile LAS unsigned* st, unsigned gs) {
    XcdBarrier b; b.bar = bar; b.x = xb_xcc_id(); b.st = st; b.gs = gs;
    if (threadIdx.x == 0) (void)xb_add(&bar[XB_XCNT(b.x)], 1u);
    return b;
}
__device__ __forceinline__ void xcd_barrier_complete(unsigned* bar, unsigned x, unsigned& nloc, unsigned& nx, const unsigned G) {
    unsigned sum, cnt, mine, sp = 0u;
    for (;;) {
        sum = 0u; cnt = 0u; mine = 0u;
#pragma unroll
        for (unsigned j = 0; j < 16; ++j) { const unsigned c = xb_ld(&bar[XB_XCNT(j)]); sum += c; cnt += (c > 0u) ? 1u : 0u; mine = (j == x) ? c : mine; }
        if (sum == G) break;
        __builtin_amdgcn_s_sleep(1);
        if ((++sp & 255u) == 0u) { if (xb_ld(&bar[XB_TMO])) break; if (sp > XB_SPIN_CAP) { atomicAdd(&bar[XB_TMO], 1u); break; } }
    }
    nloc = mine > 0u ? mine : 1u; nx = cnt > 0u ? cnt : 1u;
}
__device__ __forceinline__ void xcd_barrier(const XcdBarrier& b) {
    asm volatile("s_waitcnt vmcnt(0)" ::: "memory");
    __syncthreads();
    if (threadIdx.x == 0) {
        unsigned* bar; { const unsigned long long v = (unsigned long long)b.bar;
            unsigned lo = (unsigned)__builtin_amdgcn_readfirstlane((unsigned)v), hi = (unsigned)__builtin_amdgcn_readfirstlane((unsigned)(v >> 32));
            asm volatile("" : "+s"(lo), "+s"(hi)); bar = (unsigned*)(((unsigned long long)hi << 32) | lo); }
        __builtin_amdgcn_s_waitcnt(0);
        unsigned nloc = b.st[0], nx = b.st[1];
        if (nloc == 0u) { xcd_barrier_complete(bar, b.x, nloc, nx, b.gs); b.st[0] = nloc; b.st[1] = nx; }
        const unsigned old = xb_add(&bar[XB_XSUB(b.x)], 1u);
        const unsigned gen = old / nloc;
        if (old + 1u == (gen + 1u) * nloc) {
            __builtin_amdgcn_fence(__ATOMIC_RELEASE, "agent");
            asm volatile("s_waitcnt vmcnt(0)" ::: "memory");
            const unsigned og = xb_add(&bar[XB_TOP], 1u);
            const unsigned tg = og / nx;
            if (og + 1u == (tg + 1u) * nx) xb_add(&bar[XB_TOPGEN], 1u);
            else XB_SPIN(xb_ld(&bar[XB_TOPGEN]) == tg, bar);
            __builtin_amdgcn_fence(__ATOMIC_ACQUIRE, "agent");
            xb_add(&bar[XB_XGEN(b.x)], 1u);
            asm volatile("s_waitcnt vmcnt(0)" ::: "memory");
        } else {
            XB_SPIN(xb_ld(&bar[XB_XGEN(b.x)]) == gen, bar);
            __builtin_amdgcn_fence(__ATOMIC_ACQUIRE, "agent");
            asm volatile("s_waitcnt vmcnt(0)" ::: "memory");
        }
    }
    __syncthreads();
}

constexpr int PH_PER_LAYER = 9, N_PHASES = 1 + DEPTH * PH_PER_LAYER;

__device__ __forceinline__ void run_phase(CArgs& a, const Ctx& cx, LAS unsigned char* lds, int ph, bool dry) {
    unsigned char* ws = a.ws;
    if (ph == 0) {
        row_phase(cx, lds, a.in[0], nullptr, (bf16_t*)(ws + WS_X), (float*)(ws + WS_AL), a.in[1] + 3072, nullptr, nullptr, false);
        __syncthreads();
        convert_weights(a, cx, lds, 0);
        return;
    }
    const int l = (ph - 1) / PH_PER_LAYER; int sp = (ph - 1) % PH_PER_LAYER;
#ifdef ONLY_SP
    sp = ONLY_SP;
#endif
    const unsigned char* wsw = ws + (size_t)(l & 1) * WSET_BYTES;
    pg8::Sched S; S.G = cx.G; S.c = cx.bid; S.chain = 1; S.A1 = nullptr; S.B1 = nullptr; S.a_pn = 0; S.nM = MTOK / 256;
    switch (sp) {
    case 0: {
        S.A0 = (const char*)(ws + WS_X); S.B0 = (const char*)(wsw + WS_W1A); S.a_pm = (size_t)256 * 1024 * 2; S.b_pn = (size_t)256 * 1024 * 2; S.nN = 20; S.nwg = S.nM * S.nN;
        pg8::EpiSplit E{(bf16_t*)(ws + WS_QK)};
        pg8::gemm_phase<pg8::EpiSplit>(lds, cx.tid, pg8::Gemm{1024, 1024, 1024}, S, E);
    } break;
    case 1: pool_phase(cx, (const bf16_t*)(ws + WS_PIN), (bf16_t*)(ws + WS_GB), a.in[6] + (size_t)l * 1024); break;
    case 2: gla_p1(a, cx, lds, l); break;
    case 3: gla_p2(a, cx, dry); break;
    case 4: gla_p3(a, cx, lds, l, dry); break;
    case 5: {
        S.A0 = (const char*)(ws + WS_X); S.B0 = (const char*)(wsw + WS_WM); S.a_pm = (size_t)256 * 1024 * 2; S.b_pn = (size_t)256 * 1024 * 2; S.nN = 8; S.nwg = S.nM * S.nN;
        pg8::EpiSig E{(bf16_t*)(ws + WS_MG), a.in[7] + (size_t)l * 2048};
        pg8::gemm_phase<pg8::EpiSig>(lds, cx.tid, pg8::Gemm{1024, 1024, 1024}, S, E);
    } break;
    case 6: {
        S.chain = 2; S.A0 = (const char*)(ws + WS_GA); S.A1 = (const char*)(ws + WS_GB); S.B0 = (const char*)(wsw + WS_WA); S.B1 = (const char*)(wsw + WS_WB);
        S.a_pm = (size_t)256 * 1024 * 2; S.b_pn = (size_t)256 * 1024 * 2; S.nN = 4; S.nwg = S.nM * S.nN;
        pg8::EpiProj E{(const bf16_t*)(ws + WS_MG), (bf16_t*)(ws + WS_PIN)};
        pg8::gemm_phase<pg8::EpiProj>(lds, cx.tid, pg8::Gemm{1024, 1024, 1024}, S, E);
    } break;
    case 7: {
        S.A0 = (const char*)(ws + WS_PIN); S.B0 = (const char*)(wsw + WS_WO); S.a_pm = (size_t)256 * 1024 * 2; S.b_pn = (size_t)256 * 1024 * 2; S.nN = 4; S.nwg = S.nM * S.nN;
        pg8::EpiOut E{l == 0 ? a.in[0] : a.out, a.out};
        pg8::gemm_phase<pg8::EpiOut>(lds, cx.tid, pg8::Gemm{1024, 1024, 1024}, S, E);
    } break;
    default: {
        const bool more = (l + 1 < DEPTH);
        row_phase(cx, lds, a.out, a.out, more ? (bf16_t*)(ws + WS_X) : nullptr, more ? (float*)(ws + WS_AL) : nullptr,
                  a.in[1] + (size_t)(more ? l + 1 : l) * 1024 * INC + 3072, a.in[11] + (size_t)l * 1024, a.in[12] + (size_t)l * 1024, true, dry);
        if (more) { __syncthreads(); convert_weights(a, cx, lds, l + 1); }
    } break;
    }
}

__global__ void __launch_bounds__(512, 2) mega_fwd(Args a) {
    extern __shared__ __attribute__((aligned(16))) unsigned char lds_raw[];
    LAS unsigned char* lds = (LAS unsigned char*)lds_raw;
    cg::grid_group grid = cg::this_grid();
    if (threadIdx.x < 16) ((LAS unsigned*)(lds + LDS_PHASE))[threadIdx.x] = 0u;
    __syncthreads();
    const int ngrp = ((gridDim.x & 7) == 0) ? 4 : 1;
    const int my_grp = (ngrp == 4) ? (int)((blockIdx.x & 7) >> 1) : 0, my_gs = (int)gridDim.x / ngrp, my_gj = (ngrp == 4) ? (int)((blockIdx.x >> 3) * 2 + (blockIdx.x & 1)) : (int)blockIdx.x;
    const XcdBarrier bar = xcd_barrier_post((unsigned*)(a.ws + WS_BAR), (volatile LAS unsigned*)(lds + LDS_PHASE), gridDim.x);
    const XcdBarrier gbar = xcd_barrier_post((unsigned*)(a.ws + WS_BAR) + 4096 * (1 + my_grp), (volatile LAS unsigned*)(lds + LDS_PHASE + 32), (unsigned)my_gs);
    const int my_team = (ngrp == 4 && (my_gs & 3) == 0) ? 1 : 0;
    const XcdBarrier tbar = xcd_barrier_post((unsigned*)(a.ws + WS_BAR) + 4096 * (5 + my_grp * 4 + (my_gj & 3)), (volatile LAS unsigned*)(lds + LDS_PHASE + 48), (unsigned)(my_team ? my_gs / 4 : 1));
    constexpr int PPL = PH_PER_LAYER + (DUP_SP >= 0 ? 1 : 0);
    unsigned long long pr_acc = 0, pr_t0 = 0;
    for (int idx = a.ph_lo; idx < a.ph_hi; ++idx) {
        if (idx > a.ph_lo) { if (a.ph_lo < 0) grid.sync();
            if (PROBE_SP == 11) pr_t0 = __builtin_amdgcn_s_memrealtime();
            const int pph = (idx - 1 == 0) ? 0 : 1 + ((idx - 2) / PPL) * PH_PER_LAYER + ((idx - 2) % PPL);
            const bool wide = (pph == 0) || ((pph - 1) % PH_PER_LAYER == PH_PER_LAYER - 1);
            const int psp = (pph - 1) % PH_PER_LAYER; const bool tseam = my_team && pph > 0 && (psp == 2 || psp == 3);
            for (int r = 0; r < SYNC_REPS; ++r) { if (wide) xcd_barrier(bar); else if (tseam) xcd_barrier(tbar); else xcd_barrier(gbar); }
            if (PROBE_SP == 11) pr_acc += __builtin_amdgcn_s_memrealtime() - pr_t0; }
        int ph = 0; bool dry = false;
        if (idx > 0) { const int l = (idx - 1) / PPL, e = (idx - 1) % PPL; const int sp = (DUP_SP >= 0 && e > DUP_SP) ? e - 1 : e; ph = 1 + l * PH_PER_LAYER + sp; dry = (DUP_SP >= 0 && e == DUP_SP); }
        int tid = threadIdx.x; asm volatile("" : "+v"(tid));
        Ctx cx; cx.tid = tid; cx.lane = tid & 63; cx.wave = __builtin_amdgcn_readfirstlane(tid >> 6); { int bid_ = blockIdx.x, g_ = gridDim.x; asm volatile("" : "+s"(bid_), "+s"(g_)); cx.G = g_; cx.bid = bid_; }
        { int a_ = __builtin_amdgcn_readfirstlane(my_grp), b_ = __builtin_amdgcn_readfirstlane(my_gj), c_ = __builtin_amdgcn_readfirstlane(my_gs); asm volatile("" : "+s"(a_), "+s"(b_), "+s"(c_)); cx.grp = a_; cx.gj = b_; cx.gs = c_; cx.bpg = 4 / ngrp; cx.team = my_team; }
        CArgs* kp = (CArgs*)__builtin_amdgcn_kernarg_segment_ptr(); asm volatile("" : "+s"(kp));
        const bool pr_on = (PROBE_SP >= 0 && PROBE_SP <= 10) && ((ph == 0) ? (PROBE_SP == 10) : ((ph - 1) % PH_PER_LAYER == PROBE_SP));
        if (pr_on) pr_t0 = __builtin_amdgcn_s_memrealtime();
        run_phase(*kp, cx, lds, ph, dry);
        if (pr_on) { __syncthreads(); pr_acc += __builtin_amdgcn_s_memrealtime() - pr_t0; }
    }
    if (PROBE_SP >= 0 && blockIdx.x == 0) { const unsigned long long t1 = __builtin_amdgcn_s_memrealtime(); while (__builtin_amdgcn_s_memrealtime() - t1 < 9ull * pr_acc) __builtin_amdgcn_s_sleep(8); }
}

extern "C" void kernel_launch(void* const* d_in, const int* in_sizes, int n_in, void* d_out, int out_size, void* d_ws, size_t ws_size, hipStream_t stream) {
    static int grid = 0;
    if (grid == 0) {
        if (n_in != 13 || in_sizes[0] != MTOK * DM || out_size != MTOK * DM || ws_size < WS_END) {
            fprintf(stderr, "kernel_launch: unexpected shapes (n_in %d, in0 %d, out %d, ws %zu, need %zu); nothing launched\n", n_in, n_in > 0 ? in_sizes[0] : -1, out_size, ws_size, (size_t)WS_END); grid = -1; return; }
        int dev = 0, cus = 0, per_cu = 0;
        if (hipGetDevice(&dev) != hipSuccess || hipDeviceGetAttribute(&cus, hipDeviceAttributeMultiprocessorCount, dev) != hipSuccess) { grid = -1; return; }
        if (hipFuncSetAttribute((const void*)mega_fwd, hipFuncAttributeMaxDynamicSharedMemorySize, LDS_BYTES) != hipSuccess) { fprintf(stderr, "kernel_launch: hipFuncSetAttribute failed\n"); grid = -1; return; }
        if (hipOccupancyMaxActiveBlocksPerMultiprocessor(&per_cu, (const void*)mega_fwd, 512, LDS_BYTES) != hipSuccess || per_cu < 1) { fprintf(stderr, "kernel_launch: occupancy query says %d\n", per_cu); per_cu = 1; }
        (void)hipGetLastError();
        grid = cus;
    }
    if (grid < 0) return;
    Args a{};
    for (int i = 0; i < 13; ++i) a.in[i] = (const float*)d_in[i];
    a.out = (float*)d_out; a.ws = (unsigned char*)d_ws;
#if N_LAUNCH_MODE == 1
    for (int ph = 0; ph < N_PHASES; ++ph) {
        a.ph_lo = ph; a.ph_hi = ph + 1;
        hipLaunchKernelGGL(mega_fwd, dim3(grid), dim3(512), LDS_BYTES, stream, a);
    }
#else
    if (hipMemsetAsync((unsigned char*)d_ws + WS_BAR, 0, BAR_BYTES, stream) != hipSuccess) { fprintf(stderr, "kernel_launch: memset of barrier words failed\n"); return; }
    a.ph_lo = 0; a.ph_hi = 1 + DEPTH * (PH_PER_LAYER + (DUP_SP >= 0 ? 1 : 0));
    void* args[] = {&a};
    hipError_t e = hipLaunchCooperativeKernel((const void*)mega_fwd, dim3(grid), dim3(512), args, LDS_BYTES, stream);
    if (e != hipSuccess) fprintf(stderr, "cooperative launch failed: %s (grid %d)\n", hipGetErrorString(e), grid);
#endif
}
```

```cpp
#include <hip/hip_runtime.h>
#include <hip/hip_cooperative_groups.h>
#include <cstdio>
#include <cstdint>
namespace cg = cooperative_groups;

#ifndef N_LAUNCH_MODE
#define N_LAUNCH_MODE 0
#endif

#ifndef DUP_SP
#define DUP_SP -1
#endif
#ifndef PROBE_SP
#define PROBE_SP -1
#endif
#ifndef SYNC_REPS
#define SYNC_REPS 1
#endif
#define LAS __attribute__((address_space(3)))
typedef unsigned short bf16_t;
typedef short bf16x8 __attribute__((ext_vector_type(8)));
typedef float f32x4 __attribute__((ext_vector_type(4)));
typedef float f32x2 __attribute__((ext_vector_type(2)));
typedef unsigned u32x4 __attribute__((ext_vector_type(4)));
typedef unsigned u32x2 __attribute__((ext_vector_type(2)));

constexpr int MTOK = 32768, DM = 1024, SEQ = 8192, DEPTH = 4, INC = 7184;
constexpr int NCH = 128;
constexpr float LN_EPS = 1e-5f;
constexpr float DN_ALPHA = 1.6817928305074290f;
constexpr float QSCALE = 0.08838834764831845f;
constexpr size_t UNITB = (size_t)MTOK * 1024 * 2;
constexpr size_t WS_X = 0, WS_QK = 1 * UNITB, WS_V = 2 * UNITB, WS_GA = 3 * UNITB, WS_GB = 4 * UNITB, WS_PIN = 5 * UNITB, WS_F1 = 6 * UNITB, WS_F2 = 7 * UNITB;
constexpr size_t WS_MG = WS_QK;
constexpr size_t WS_US = WS_PIN;
constexpr size_t WS_W1A = WS_F2;
constexpr size_t WS_WM = WS_W1A + (size_t)5120 * 1024 * 2;
constexpr size_t WS_WA = WS_WM + (size_t)2048 * 1024 * 2;
constexpr size_t WS_WB = WS_WA + (size_t)1024 * 1024 * 2;
constexpr size_t WS_WO = WS_WB + (size_t)1024 * 1024 * 2;
constexpr size_t WS_WG = WS_WO + (size_t)1024 * 1024 * 2;
constexpr size_t WSET_BYTES = WS_WG + (size_t)4 * 256 * 256 * 2 - WS_W1A;
constexpr size_t WS_AL = WS_W1A + 2 * WSET_BYTES;
constexpr size_t WS_DF = WS_AL + (size_t)MTOK * 16 * 4;
constexpr size_t WS_BAR = WS_DF + (size_t)2048 * 128 * 4;
constexpr size_t BAR_BYTES = 21 * 16384;
constexpr size_t WS_CTR = WS_BAR + BAR_BYTES;
constexpr size_t CTR_BYTES = 1024;
constexpr size_t WS_END = WS_CTR + CTR_BYTES;
constexpr int LDS_PHASE = 135168, LDS_BYTES = LDS_PHASE + 64;

#define GAS __attribute__((address_space(1)))
template <class T> __device__ __forceinline__ T gld(const void* p) { return *(const GAS T*)p; }
template <class T> __device__ __forceinline__ void gst(void* p, const T v) { *(GAS T*)p = v; }
template <class T> __device__ __forceinline__ T gldo(const void* ubase, unsigned off) { return *(const GAS T*)((const GAS char*)ubase + off); }
template <class T> __device__ __forceinline__ void gsto(void* ubase, unsigned off, const T v) { *(GAS T*)((GAS char*)ubase + off) = v; }
typedef __bf16 bf16x2_t __attribute__((ext_vector_type(2)));
__device__ __forceinline__ size_t us_off(int b, int h, int c) { return (size_t)(h >> 1) * UNITB + (size_t)b * ((size_t)16 << 20) + (size_t)((h & 1) * NCH + c) * 65536; }
__device__ __forceinline__ unsigned cvt_pk_bf16_n(float lo, float hi) { const f32x2 v = {lo, hi}; const bf16x2_t b = __builtin_convertvector(v, bf16x2_t); return __builtin_bit_cast(unsigned, b); }
__device__ __forceinline__ unsigned cvt_pk_bf16(float lo, float hi) { unsigned r; asm volatile("s_nop 0\n\tv_cvt_pk_bf16_f32 %0, %1, %2" : "=v"(r) : "v"(lo), "v"(hi)); return r; }
__device__ __forceinline__ float bf_lo(unsigned w) { return __uint_as_float(w << 16); }
__device__ __forceinline__ float bf_hi(unsigned w) { return __uint_as_float(w & 0xffff0000u); }
__device__ __forceinline__ float bf2f(bf16_t b) { return __uint_as_float((unsigned)b << 16); }
__device__ __forceinline__ float sigmoidf_(float z) { return __builtin_amdgcn_rcpf(1.0f + __expf(-z)); }
__device__ __forceinline__ float siluf_(float z) { return z * __builtin_amdgcn_rcpf(1.0f + __expf(-z)); }

namespace pg8 {
constexpr int BM = 256, BK = 64, HALF = 128, HTB = HALF * BK * 2, STAGE_BYTES = 8 * HTB, NXCD = 8, WGM = 8;
__host__ __device__ __forceinline__ int lds_byte(int r, int c) { const int st = (r >> 4) * 2 + (c >> 5), rr = r & 15, cc = c & 31, ob = rr * 64 + cc * 2; return st * 1024 + (ob ^ (((ob >> 9) & 1) << 5)); }
__host__ __device__ __forceinline__ void stage_rc(int b, int& R, int& C) { const int st = b / 1024, sb = b % 1024, swz = sb ^ (((sb >> 9) & 1) << 5); R = (st >> 1) * 16 + swz / 64; C = (st & 1) * 32 + (swz % 64) / 2; }
__host__ __device__ __forceinline__ int perm32(int rho) { const int n = rho >> 4, i = rho & 15; return 8 * (i >> 2) + 4 * n + (i & 3); }

struct Unit { const char* A; const char* B; int pm, pn, kind, keep; };
struct Gemm { int lda, ldb, K; };

struct Sched {
    const char *A0, *A1, *B0, *B1; size_t a_pm, a_pn, b_pn; int nM, nN, nwg, G, c, chain;
    __device__ __forceinline__ bool next(int i, Unit& u) const {
        const int ti = (chain == 2) ? (i >> 1) : i, which = (chain == 2) ? (i & 1) : 0;
        const long L = (long)ti * G + c; if (L >= nwg) return false;
        int wgid = (int)L; { const int q = nwg / NXCD, r = nwg % NXCD, xcd = wgid % NXCD, off = wgid / NXCD; wgid = (xcd < r ? xcd * (q + 1) : r * (q + 1) + (xcd - r) * q) + off; }
        const int nig = WGM * nN, gid = wgid / nig, fm = gid * WGM, gsz = (nM - fm) < WGM ? (nM - fm) : WGM;
        u.pm = fm + ((wgid % nig) % gsz); u.pn = (wgid % nig) / gsz;
        u.A = (which ? A1 : A0) + (size_t)u.pm * a_pm + (size_t)u.pn * a_pn; u.B = (which ? B1 : B0) + (size_t)u.pn * b_pn;
        u.kind = which; u.keep = (chain == 2 && which == 0) ? 1 : 0; return true;
    }
};

template <class Epi>
__device__ __forceinline__ void gemm_phase(LAS unsigned char* lds, const int tid, const Gemm g, const Sched& S, const Epi& E) {
    const int wid = __builtin_amdgcn_readfirstlane(tid >> 6), lane = tid & 63, wr = wid >> 2, wc = wid & 3, fr = lane & 15, fq = lane >> 4;
    const int K = g.K, nt = K / BK;
    unsigned voffA[2], voffB[2];
#pragma unroll
    for (int i = 0; i < 2; ++i) { int R, C; stage_rc(tid * 16 + i * 8192, R, C); const int Rb = Epi::PERM ? ((R & ~31) + perm32(R & 31)) : R;
        voffA[i] = (unsigned)(R * g.lda + C) * 2u; voffB[i] = (unsigned)(Rb * g.ldb + C) * 2u; }
    const size_t kstep = (size_t)(BK * 2);
    const size_t hstepA = (size_t)HALF * g.lda * 2, hstepB = (size_t)HALF * g.ldb * 2;
    const unsigned ldsw = (unsigned)wid * 1024u;
    const int aoff = lds_byte(wr * 64 + fr, fq * 8), boff = lds_byte(wc * 32 + fr, fq * 8);
#define PG8_SA(b, h) (((b) * 2 + (h)) * HTB)
#define PG8_SB(b, h) ((4 + (b) * 2 + (h)) * HTB)
#define PG8_STAGE(bufoff, gbase, voff) do { _Pragma("unroll") for (int _i = 0; _i < 2; ++_i) \
        __builtin_amdgcn_global_load_lds((const unsigned*)((const char*)(gbase) + (voff)[_i]), (LAS unsigned*)(lds + (bufoff) + ldsw + _i * 8192), 16, 0, 0); } while (0)
#define PG8_LDA(dst, b, h) do { _Pragma("unroll") for (int m = 0; m < 4; ++m) _Pragma("unroll") for (int k = 0; k < 2; ++k) dst[m][k] = *(const LAS bf16x8*)(lds + PG8_SA(b, h) + aoff + m * 2048 + k * 1024); } while (0)
#define PG8_LDB(dst, b, h) do { _Pragma("unroll") for (int n = 0; n < 2; ++n) _Pragma("unroll") for (int k = 0; k < 2; ++k) dst[n][k] = *(const LAS bf16x8*)(lds + PG8_SB(b, h) + boff + n * 2048 + k * 1024); } while (0)
#define PG8_MMA(ai, bj, At, Bt) do { __builtin_amdgcn_s_setprio(1); _Pragma("unroll") for (int m = 0; m < 4; ++m) _Pragma("unroll") for (int n = 0; n < 2; ++n) _Pragma("unroll") for (int k = 0; k < 2; ++k) \
        acc[ai][bj][m][n] = __builtin_amdgcn_mfma_f32_16x16x32_bf16(Bt[n][k], At[m][k], acc[ai][bj][m][n], 0, 0, 0); __builtin_amdgcn_s_setprio(0); } while (0)
#define PG8_WAIT_V(n) asm volatile("s_waitcnt vmcnt(" #n ")" ::: "memory")
#define PG8_WAIT_L(n) asm volatile("s_waitcnt lgkmcnt(" #n ")" ::: "memory")
#define PG8_BAR __builtin_amdgcn_s_barrier()
#define PG8_SCHED __builtin_amdgcn_sched_barrier(0)
    Unit cur, nxt; int ui = 0;
    if (!S.next(0, cur)) return;
    f32x4 acc[2][2][4][2];
#pragma unroll
    for (int a = 0; a < 2; ++a)
#pragma unroll
        for (int b = 0; b < 2; ++b)
#pragma unroll
            for (int m = 0; m < 4; ++m)
#pragma unroll
                for (int n = 0; n < 2; ++n) acc[a][b][m][n] = (f32x4){0.f, 0.f, 0.f, 0.f};
    bf16x8 At[4][2], B0[2][2], B1[2][2];
    const char* cA = cur.A; const char* cB = cur.B;
    PG8_STAGE(PG8_SB(0, 0), cB, voffB); PG8_STAGE(PG8_SB(0, 1), cB + hstepB, voffB); PG8_STAGE(PG8_SA(0, 0), cA, voffA); PG8_STAGE(PG8_SA(0, 1), cA + hstepA, voffA);
    if (wr == 1) PG8_BAR;
    PG8_WAIT_V(2); PG8_BAR;
    PG8_STAGE(PG8_SB(1, 0), cB + kstep, voffB); PG8_STAGE(PG8_SA(1, 0), cA + kstep, voffA); PG8_STAGE(PG8_SB(1, 1), cB + hstepB + kstep, voffB);
    PG8_WAIT_V(6); PG8_BAR;
    for (;;) {
        const bool has_next = S.next(ui + 1, nxt);
        const char* nA = has_next ? nxt.A : cA; const char* nB = has_next ? nxt.B : cB;
        for (int t = 0; t < nt; t += 2) {
            const bool last = (t == nt - 2);
            const char* a1 = cA + (size_t)(t + 1) * kstep;
            const char* a2 = last ? nA : cA + (size_t)(t + 2) * kstep; const char* b2 = last ? nB : cB + (size_t)(t + 2) * kstep;
            const char* a3 = a2 + kstep; const char* b3 = b2 + kstep;
            PG8_LDB(B0, 0, 0); PG8_LDB(B1, 0, 1); PG8_SCHED; PG8_LDA(At, 0, 0); PG8_STAGE(PG8_SA(1, 1), a1 + hstepA, voffA);
            PG8_WAIT_V(8); PG8_WAIT_L(0); PG8_BAR; PG8_MMA(0, 0, At, B0); PG8_MMA(0, 1, At, B1); PG8_BAR; PG8_SCHED;
            PG8_LDA(At, 0, 1); PG8_STAGE(PG8_SB(0, 0), b2, voffB); PG8_STAGE(PG8_SB(0, 1), b2 + hstepB, voffB); PG8_STAGE(PG8_SA(0, 0), a2, voffA);
            PG8_WAIT_V(8); PG8_WAIT_L(0); PG8_BAR; PG8_MMA(1, 0, At, B0); PG8_MMA(1, 1, At, B1); PG8_BAR; PG8_SCHED;
            PG8_LDB(B0, 1, 0); PG8_LDB(B1, 1, 1); PG8_SCHED; PG8_LDA(At, 1, 0); PG8_STAGE(PG8_SA(0, 1), a2 + hstepA, voffA);
            PG8_WAIT_V(8); PG8_WAIT_L(0); PG8_BAR; PG8_MMA(0, 0, At, B0); PG8_MMA(0, 1, At, B1); PG8_BAR; PG8_SCHED;
            PG8_LDA(At, 1, 1); PG8_STAGE(PG8_SB(1, 0), b3, voffB); PG8_STAGE(PG8_SB(1, 1), b3 + hstepB, voffB); PG8_STAGE(PG8_SA(1, 0), a3, voffA);
            PG8_WAIT_V(8); PG8_WAIT_L(0); PG8_BAR; PG8_MMA(1, 0, At, B0); PG8_MMA(1, 1, At, B1); PG8_BAR; PG8_SCHED;
        }
        if (wr == 0) PG8_BAR;
        asm volatile("s_nop 7\n\ts_nop 7" ::: "memory");
        { int t2 = tid; asm volatile("" : "+v"(t2));
          const int l2 = t2 & 63; E(acc, cur, wr, wc, l2 & 15, l2 >> 4); }
        if (!has_next) break;
        if (!cur.keep) {
#pragma unroll
            for (int a = 0; a < 2; ++a)
#pragma unroll
                for (int b = 0; b < 2; ++b)
#pragma unroll
                    for (int m = 0; m < 4; ++m)
#pragma unroll
                        for (int n = 0; n < 2; ++n) acc[a][b][m][n] = (f32x4){0.f, 0.f, 0.f, 0.f};
        }
        cur = nxt; cA = nA; cB = nB; ++ui;
        if (wr == 1) PG8_BAR;
    }
    PG8_WAIT_V(0);
    PG8_BAR;
#undef PG8_SA
#undef PG8_SB
#undef PG8_STAGE
#undef PG8_LDA
#undef PG8_LDB
#undef PG8_MMA
#undef PG8_WAIT_V
#undef PG8_WAIT_L
#undef PG8_BAR
#undef PG8_SCHED
}

struct EpiSplit {
    static constexpr bool PERM = true;
    bf16_t* base;
    __device__ __forceinline__ void operator()(const f32x4 (&acc)[2][2][4][2], const Unit& u, int wr, int wc, int fr, int fq) const {
        const int row0 = u.pm * BM + wr * 64 + fr; const int colt = u.pn * BM; const int t = colt >> 10;
        bf16_t* b = base + (size_t)t * ((size_t)MTOK * 1024); const int col0 = (colt & 1023) + wc * 32 + 8 * fq;
#pragma unroll
        for (int ai = 0; ai < 2; ++ai)
#pragma unroll
            for (int m = 0; m < 4; ++m) { bf16_t* rowp = b + (size_t)(row0 + ai * HALF + m * 16) * 1024 + col0;
#pragma unroll
                for (int bj = 0; bj < 2; ++bj) { const f32x4 v0 = acc[ai][bj][m][0], v1 = acc[ai][bj][m][1];
                    u32x4 w; w.x = cvt_pk_bf16(v0[0], v0[1]); w.y = cvt_pk_bf16(v0[2], v0[3]); w.z = cvt_pk_bf16(v1[0], v1[1]); w.w = cvt_pk_bf16(v1[2], v1[3]);
                    gst<u32x4>(rowp + bj * HALF, w); } }
    }
};
struct EpiSig {
    static constexpr bool PERM = true;
    bf16_t* O; const float* bias;
    __device__ __forceinline__ void operator()(const f32x4 (&acc)[2][2][4][2], const Unit& u, int wr, int wc, int fr, int fq) const {
        const int row0 = u.pm * BM + wr * 64 + fr; const int col0 = u.pn * BM + wc * 32 + 8 * fq;
        f32x4 bv[2][2];
#pragma unroll
        for (int bj = 0; bj < 2; ++bj)
#pragma unroll
            for (int n = 0; n < 2; ++n) bv[bj][n] = gld<f32x4>(bias + col0 + bj * HALF + 4 * n);
        bf16_t* Oh = O + (size_t)(col0 >> 10) * ((size_t)MTOK * 1024) + (col0 & 1023);
#pragma unroll
        for (int ai = 0; ai < 2; ++ai)
#pragma unroll
            for (int m = 0; m < 4; ++m) { bf16_t* rowp = Oh + (size_t)(row0 + ai * HALF + m * 16) * 1024;
#pragma unroll
                for (int bj = 0; bj < 2; ++bj) { f32x4 v0 = acc[ai][bj][m][0] + bv[bj][0], v1 = acc[ai][bj][m][1] + bv[bj][1];
#pragma unroll
                    for (int j = 0; j < 4; ++j) { v0[j] = sigmoidf_(v0[j]); v1[j] = sigmoidf_(v1[j]); }
                    u32x4 w; w.x = cvt_pk_bf16(v0[0], v0[1]); w.y = cvt_pk_bf16(v0[2], v0[3]); w.z = cvt_pk_bf16(v1[0], v1[1]); w.w = cvt_pk_bf16(v1[2], v1[3]);
                    gst<u32x4>(rowp + bj * HALF, w); } }
    }
};
struct EpiPool {
    static constexpr bool PERM = true;
    bf16_t* GB; const float* scale;
    __device__ __forceinline__ void operator()(const f32x4 (&acc)[2][2][4][2], const Unit& u, int wr, int wc, int fr, int fq) const {
        const int row0 = u.pm * BM + wr * 64 + fr; const int col0 = u.pn * BM + wc * 32 + 8 * fq;
        f32x4 sv[2][2];
#pragma unroll
        for (int bj = 0; bj < 2; ++bj)
#pragma unroll
            for (int n = 0; n < 2; ++n) sv[bj][n] = gld<f32x4>(scale + col0 + bj * HALF + 4 * n);
#pragma unroll
        for (int ai = 0; ai < 2; ++ai)
#pragma unroll
            for (int m = 0; m < 4; ++m) { bf16_t* rowp = GB + (size_t)(row0 + ai * HALF + m * 16) * 1024 + col0;
#pragma unroll
                for (int bj = 0; bj < 2; ++bj) { const u32x4 gw = gld<u32x4>(rowp + bj * HALF);
                    f32x4 v0 = acc[ai][bj][m][0] * sv[bj][0], v1 = acc[ai][bj][m][1] * sv[bj][1];
                    v0[0] *= siluf_(bf_lo(gw.x)); v0[1] *= siluf_(bf_hi(gw.x)); v0[2] *= siluf_(bf_lo(gw.y)); v0[3] *= siluf_(bf_hi(gw.y));
                    v1[0] *= siluf_(bf_lo(gw.z)); v1[1] *= siluf_(bf_hi(gw.z)); v1[2] *= siluf_(bf_lo(gw.w)); v1[3] *= siluf_(bf_hi(gw.w));
                    u32x4 w; w.x = cvt_pk_bf16(v0[0], v0[1]); w.y = cvt_pk_bf16(v0[2], v0[3]); w.z = cvt_pk_bf16(v1[0], v1[1]); w.w = cvt_pk_bf16(v1[2], v1[3]);
                    gst<u32x4>(rowp + bj * HALF, w); } }
    }
};
struct EpiProj {
    static constexpr bool PERM = true;
    const bf16_t* MG; bf16_t* O;
    __device__ __forceinline__ void operator()(f32x4 (&acc)[2][2][4][2], const Unit& u, int wr, int wc, int fr, int fq) const {
        const int row0 = u.pm * BM + wr * 64 + fr; const int col0 = u.pn * BM + wc * 32 + 8 * fq;
        if (u.kind == 0) {
#pragma unroll
            for (int ai = 0; ai < 2; ++ai)
#pragma unroll
                for (int m = 0; m < 4; ++m) { const bf16_t* gp = MG + (size_t)(row0 + ai * HALF + m * 16) * 1024 + col0;
#pragma unroll
                    for (int bj = 0; bj < 2; ++bj) { const u32x4 ga = gld<u32x4>(gp + bj * HALF), gb = gld<u32x4>(gp + (size_t)MTOK * 1024 + bj * HALF);
                        f32x4& v0 = acc[ai][bj][m][0]; f32x4& v1 = acc[ai][bj][m][1];
                        v0[0] *= bf_lo(ga.x) * __builtin_amdgcn_rcpf(bf_lo(gb.x)); v0[1] *= bf_hi(ga.x) * __builtin_amdgcn_rcpf(bf_hi(gb.x));
                        v0[2] *= bf_lo(ga.y) * __builtin_amdgcn_rcpf(bf_lo(gb.y)); v0[3] *= bf_hi(ga.y) * __builtin_amdgcn_rcpf(bf_hi(gb.y));
                        v1[0] *= bf_lo(ga.z) * __builtin_amdgcn_rcpf(bf_lo(gb.z)); v1[1] *= bf_hi(ga.z) * __builtin_amdgcn_rcpf(bf_hi(gb.z));
                        v1[2] *= bf_lo(ga.w) * __builtin_amdgcn_rcpf(bf_lo(gb.w)); v1[3] *= bf_hi(ga.w) * __builtin_amdgcn_rcpf(bf_hi(gb.w)); } }
        } else {
#pragma unroll
            for (int ai = 0; ai < 2; ++ai)
#pragma unroll
                for (int m = 0; m < 4; ++m) { const size_t r = (size_t)(row0 + ai * HALF + m * 16); const bf16_t* gp = MG + (size_t)MTOK * 1024 + r * 1024 + col0; bf16_t* rowp = O + r * 1024 + col0;
#pragma unroll
                    for (int bj = 0; bj < 2; ++bj) { const u32x4 gb = gld<u32x4>(gp + bj * HALF);
                        const f32x4 v0 = acc[ai][bj][m][0], v1 = acc[ai][bj][m][1];
                        u32x4 w; w.x = cvt_pk_bf16(v0[0] * bf_lo(gb.x), v0[1] * bf_hi(gb.x)); w.y = cvt_pk_bf16(v0[2] * bf_lo(gb.y), v0[3] * bf_hi(gb.y));
                        w.z = cvt_pk_bf16(v1[0] * bf_lo(gb.z), v1[1] * bf_hi(gb.z)); w.w = cvt_pk_bf16(v1[2] * bf_lo(gb.w), v1[3] * bf_hi(gb.w));
                        gst<u32x4>(rowp + bj * HALF, w); } }
        }
    }
};
struct EpiOut {
    static constexpr bool PERM = false;
    const float* xres; float* out;
    __device__ __forceinline__ void operator()(const f32x4 (&acc)[2][2][4][2], const Unit& u, int wr, int wc, int fr, int fq) const {
        const int row0 = u.pm * BM + wr * 64 + fr, col0 = u.pn * BM + wc * 32 + 4 * fq;
#pragma unroll
        for (int ai = 0; ai < 2; ++ai)
#pragma unroll
            for (int m = 0; m < 4; ++m) { const size_t off = (size_t)(row0 + ai * HALF + m * 16) * 1024 + col0;
#pragma unroll
                for (int bj = 0; bj < 2; ++bj)
#pragma unroll
                    for (int n = 0; n < 2; ++n) { const f32x4 xs = gld<f32x4>(xres + off + bj * HALF + n * 16);
                        gst<f32x4>(out + off + bj * HALF + n * 16, xs * DN_ALPHA + acc[ai][bj][m][n]); } }
    }
};
}

struct Args { const float* in[13]; float* out; unsigned char* ws; int ph_lo, ph_hi; };
typedef const __attribute__((address_space(4))) Args CArgs;
struct Ctx { int tid, lane, wave, G, bid; int grp, gj, gs, bpg; int team; };

__device__ __forceinline__ float wave_sum(float v) {
#pragma unroll
    for (int o = 1; o < 64; o <<= 1) v += __shfl_xor(v, o);
    return v;
}

__device__ __forceinline__ void transpose_item(const float* W, int ld_src, int col0, int nblk, int K, bf16_t* WT, int row_off, LAS float* scr, int item, int lane) {
    const int kb = item / nblk, nb = item % nblk, k0 = 64 * kb, n0 = 32 * nb;
    {   float tv[32];
        const float* wp = W + (size_t)(k0 + (lane >> 5)) * ld_src + col0 + n0 + (lane & 31);
#pragma unroll
        for (int i = 0; i < 32; ++i) tv[i] = gld<float>(wp + (size_t)(2 * i) * ld_src);
#pragma unroll
        for (int i = 0; i < 32; ++i) scr[(2 * i + (lane >> 5)) * 33 + (lane & 31)] = tv[i]; }
    asm volatile("s_waitcnt lgkmcnt(0)" ::: "memory");
    const int c = lane & 7;
#pragma unroll
    for (int j = 0; j < 4; ++j) { const int n = (lane >> 3) + 8 * j; const LAS float* s = scr + (8 * c) * 33 + n;
        u32x4 o; o.x = cvt_pk_bf16(s[0 * 33], s[1 * 33]); o.y = cvt_pk_bf16(s[2 * 33], s[3 * 33]); o.z = cvt_pk_bf16(s[4 * 33], s[5 * 33]); o.w = cvt_pk_bf16(s[6 * 33], s[7 * 33]);
        gst<u32x4>(WT + (size_t)(row_off + n0 + n) * K + k0 + 8 * c, o); }
    asm volatile("s_waitcnt lgkmcnt(0)" ::: "memory");
}
__device__ __forceinline__ void compose_item(const float* w_in  , const float* w_g  , bf16_t* WT  , LAS float* scr, int item, int lane) {
    const int kb = item >> 5, nb = item & 31, k0 = 16 * kb, ng = nb * 32 + (lane & 31), g = ng >> 8, o = ng & 255, kh = lane >> 5;
    const float* arow = w_in + (size_t)k0 * INC + 3088 + g * 256;
#pragma unroll
    for (int r = 0; r < 16; ++r) *(LAS f32x4*)(scr + r * 256 + 4 * lane) = gld<f32x4>(arow + (size_t)r * INC + 4 * lane);
    asm volatile("s_waitcnt lgkmcnt(0)" ::: "memory");
    const float* bcol = w_g + (size_t)g * 65536 + o;
    float acc[8];
#pragma unroll
    for (int j = 0; j < 8; ++j) acc[j] = 0.f;
    float bv[16], bn[16];
#pragma unroll
    for (int e = 0; e < 16; ++e) bv[e] = gld<float>(bcol + (size_t)e * 256);
#pragma unroll 1
    for (int i0 = 0; i0 < 256; i0 += 16) {
        const int inext = (i0 + 16 < 256) ? i0 + 16 : i0;
#pragma unroll
        for (int e = 0; e < 16; ++e) bn[e] = gld<float>(bcol + (size_t)(inext + e) * 256);
#pragma unroll
        for (int q = 0; q < 4; ++q)
#pragma unroll
            for (int j = 0; j < 8; ++j) { const f32x4 av = *(const LAS f32x4*)(scr + (kh * 8 + j) * 256 + i0 + 4 * q);
                acc[j] += (av[0] * bv[4 * q] + av[1] * bv[4 * q + 1]) + (av[2] * bv[4 * q + 2] + av[3] * bv[4 * q + 3]); }
#pragma unroll
        for (int e = 0; e < 16; ++e) bv[e] = bn[e];
    }
    u32x4 ov; ov.x = cvt_pk_bf16(acc[0], acc[1]); ov.y = cvt_pk_bf16(acc[2], acc[3]); ov.z = cvt_pk_bf16(acc[4], acc[5]); ov.w = cvt_pk_bf16(acc[6], acc[7]);
    gst<u32x4>(WT + (size_t)ng * 1024 + k0 + kh * 8, ov);
    asm volatile("s_waitcnt lgkmcnt(0)" ::: "memory");
}
__device__ __forceinline__ void convert_weights(CArgs& a, const Ctx& cx, LAS unsigned char* lds, int l) {
    LAS float* scr = (LAS float*)(lds + cx.wave * 16384);
    const int gw = cx.bid * 8 + cx.wave, NGW = cx.G * 8;
    unsigned char* ws = a.ws + (size_t)(l & 1) * WSET_BYTES;
    const float* w_in = a.in[1] + (size_t)l * 1024 * INC;
    const float* w_pa = a.in[8] + (size_t)l * 1024 * 1024; const float* w_pb = a.in[9] + (size_t)l * 1024 * 1024; const float* w_o = a.in[10] + (size_t)l * 1024 * 1024;
    const float* w_g = a.in[5] + (size_t)l * 4 * 256 * 256;
    constexpr int I_A = 16 * 96, I_GB = 16 * 32, I_M = 16 * 64, I_P = 16 * 32, I_C = 64 * 32;
    constexpr int NIT = I_A + I_GB + I_M + 3 * I_P + I_C;
    unsigned* ctr = (unsigned*)(a.ws + WS_CTR) + 64 * l;
    volatile LAS unsigned* tw = (volatile LAS unsigned*)(lds + 8 * 16384);
    (void)gw; (void)NGW;
    unsigned tk = 0u;
    if (cx.tid == 0) tk = __hip_atomic_fetch_add(ctr, 8u, __ATOMIC_RELAXED, __HIP_MEMORY_SCOPE_AGENT);
    for (int rnd = 0; ; ++rnd) {
        if (cx.tid == 0) tw[rnd & 1] = tk;
        __syncthreads();
        const int base = (int)tw[rnd & 1];
        if (base >= NIT) break;
        if (cx.tid == 0) tk = __hip_atomic_fetch_add(ctr, 8u, __ATOMIC_RELAXED, __HIP_MEMORY_SCOPE_AGENT);
        int r = base + cx.wave;
        if (r < NIT) {
        if (r < I_C) { compose_item(w_in, w_g, (bf16_t*)(ws + WS_W1A) + (size_t)4096 * 1024, scr, r, cx.lane); }
        else { r -= I_C;
        if (r < I_A) { transpose_item(w_in, INC, 0, 96, 1024, (bf16_t*)(ws + WS_W1A), 0, scr, r, cx.lane); }
        else { r -= I_A;
        if (r < I_GB) { transpose_item(w_in, INC, 4112, 32, 1024, (bf16_t*)(ws + WS_W1A), 3072, scr, r, cx.lane); }
        else { r -= I_GB;
        if (r < I_M) { transpose_item(w_in, INC, 5136, 64, 1024, (bf16_t*)(ws + WS_WM), 0, scr, r, cx.lane); }
        else { r -= I_M;
        if (r < I_P) { transpose_item(w_pa, 1024, 0, 32, 1024, (bf16_t*)(ws + WS_WA), 0, scr, r, cx.lane); }
        else { r -= I_P;
        if (r < I_P) { transpose_item(w_pb, 1024, 0, 32, 1024, (bf16_t*)(ws + WS_WB), 0, scr, r, cx.lane); }
        else { r -= I_P; transpose_item(w_o, 1024, 0, 32, 1024, (bf16_t*)(ws + WS_WO), 0, scr, r, cx.lane); } } } } } }
        }
    }
}

__device__ __forceinline__ void row_phase(const Ctx& cx, LAS unsigned char* lds, const float* src, float* dst, bf16_t* xbf, float* AL, const float* walpha  ,
                                          const float* lng, const float* lnb, bool do_ln, bool dry = false) {
    LAS float* WT = (LAS float*)lds;
    if (AL) {
        for (int idx = cx.tid; idx < 16384; idx += 512) { const int k = idx >> 4, c = idx & 15; WT[c * 1028 + k] = gld<float>(walpha + (size_t)k * INC + c); }
    }
    __syncthreads();
    const int gw = cx.gj * 8 + cx.wave, NGW = cx.gs * 8, lane = cx.lane; const int rg0 = cx.grp * cx.bpg * 2048, nrg = cx.bpg * 2048;
    f32x4 gj[4], bj[4];
#pragma unroll
    for (int j = 0; j < 4; ++j) { gj[j] = (f32x4){1.f, 1.f, 1.f, 1.f}; bj[j] = (f32x4){0.f, 0.f, 0.f, 0.f}; }
    if (do_ln) {
#pragma unroll
        for (int j = 0; j < 4; ++j) { gj[j] = gld<f32x4>(lng + 256 * j + 4 * lane); bj[j] = gld<f32x4>(lnb + 256 * j + 4 * lane); }
    }
    for (int rl = gw; rl < nrg; rl += NGW) {
        const size_t m0 = (size_t)(rg0 + rl) * 4;
        f32x4 v[4][4];
#pragma unroll
        for (int r = 0; r < 4; ++r)
#pragma unroll
            for (int j = 0; j < 4; ++j) v[r][j] = gld<f32x4>(src + (m0 + r) * 1024 + 256 * j + 4 * lane);
        if (do_ln) {
#pragma unroll
            for (int r = 0; r < 4; ++r) {
                float s = 0.f;
#pragma unroll
                for (int j = 0; j < 4; ++j) s += (v[r][j][0] + v[r][j][1]) + (v[r][j][2] + v[r][j][3]);
                const float mean = wave_sum(s) * (1.f / 1024.f); float s2 = 0.f;
#pragma unroll
                for (int j = 0; j < 4; ++j) { v[r][j] = v[r][j] - mean; s2 += (v[r][j][0] * v[r][j][0] + v[r][j][1] * v[r][j][1]) + (v[r][j][2] * v[r][j][2] + v[r][j][3] * v[r][j][3]); }
                const float rstd = __builtin_amdgcn_rsqf(wave_sum(s2) * (1.f / 1024.f) + LN_EPS);
#pragma unroll
                for (int j = 0; j < 4; ++j) { v[r][j] = v[r][j] * rstd * gj[j] + bj[j]; if (!dry) gst<f32x4>(dst + (m0 + r) * 1024 + 256 * j + 4 * lane, v[r][j]); }
            }
        }
        if (xbf) {
#pragma unroll
            for (int r = 0; r < 4; ++r)
#pragma unroll
                for (int j = 0; j < 4; ++j) { u32x2 w; w.x = cvt_pk_bf16(v[r][j][0], v[r][j][1]); w.y = cvt_pk_bf16(v[r][j][2], v[r][j][3]);
                    if (!dry) gst<u32x2>(xbf + (m0 + r) * 1024 + 256 * j + 4 * lane, w); }
        }
        if (AL) {
            float acc[64];
#pragma unroll
            for (int i = 0; i < 64; ++i) acc[i] = 0.f;
#pragma unroll
            for (int c = 0; c < 16; ++c)
#pragma unroll
                for (int j = 0; j < 4; ++j) { const f32x4 w = *(const LAS f32x4*)(WT + c * 1028 + 256 * j + 4 * lane);
#pragma unroll
                    for (int r = 0; r < 4; ++r) acc[r * 16 + c] += (v[r][j][0] * w[0] + v[r][j][1] * w[1]) + (v[r][j][2] * w[2] + v[r][j][3] * w[3]); }
#pragma unroll
            for (int h = 32; h >= 1; h >>= 1) {
                const bool up = (lane & h) != 0;
#pragma unroll
                for (int i = 0; i < h; ++i) { const float keep = up ? acc[i + h] : acc[i]; const float send = up ? acc[i] : acc[i + h]; acc[i] = keep + __shfl_xor(send, h); }
            }
            if (!dry) gst<float>(AL + m0 * 16 + lane, acc[0]);
        }
    }
}

__device__ __forceinline__ void unpack8(const u32x4 w, float (&f)[8]) { f[0] = bf_lo(w.x); f[1] = bf_hi(w.x); f[2] = bf_lo(w.y); f[3] = bf_hi(w.y); f[4] = bf_lo(w.z); f[5] = bf_hi(w.z); f[6] = bf_lo(w.w); f[7] = bf_hi(w.w); }
__device__ __forceinline__ void pool_phase(const Ctx& cx, const bf16_t* pin, bf16_t* gbuf, const float* scale) {
    const int NT = cx.bpg * 32768, q0 = cx.grp * cx.bpg * 32768;
    for (int ql = cx.gj * 512 + cx.tid; ql < NT; ql += cx.gs * 512) { const int q = q0 + ql;
        const int cg8 = q & 127, seg = q >> 7; const int g = cg8 >> 5; const int w = 2 << g;
        const int t0 = seg * 32, pos0 = t0 & (SEQ - 1);
        const bf16_t* base = pin + (size_t)t0 * 1024 + cg8 * 8;
        float sum[8], sc[8];
        { const f32x4 s0 = gld<f32x4>(scale + cg8 * 8), s1 = gld<f32x4>(scale + cg8 * 8 + 4); sc[0] = s0[0]; sc[1] = s0[1]; sc[2] = s0[2]; sc[3] = s0[3]; sc[4] = s1[0]; sc[5] = s1[1]; sc[6] = s1[2]; sc[7] = s1[3]; }
        bf16_t* gb = gbuf + (size_t)t0 * 1024 + cg8 * 8;
#pragma unroll
        for (int e = 0; e < 8; ++e) sum[e] = 0.f;
        if (pos0 > 0) {
#pragma unroll 1
            for (int jb = 0; jb < 16; jb += 8) {
                u32x4 hv[8];
#pragma unroll
                for (int j = 0; j < 8; ++j) hv[j] = gld<u32x4>(base - (size_t)(jb + j + 1) * 1024);
#pragma unroll
                for (int j = 0; j < 8; ++j) { float f[8]; unpack8(hv[j], f); const float m = (jb + j + 1 <= w) ? 1.f : 0.f;
#pragma unroll
                    for (int e = 0; e < 8; ++e) sum[e] += m * f[e]; }
            }
        }
#pragma unroll 1
        for (int ib = 0; ib < 32; ib += 4) {
            u32x4 xv[4], ov[4], gv[4];
#pragma unroll
            for (int i = 0; i < 4; ++i) { xv[i] = gld<u32x4>(base + (size_t)(ib + i) * 1024); gv[i] = gld<u32x4>(gb + (size_t)(ib + i) * 1024);
                const int back = (pos0 + ib + i - w >= 0) ? w : 0;
                ov[i] = gld<u32x4>(base + (size_t)(ib + i - back) * 1024); }
#pragma unroll
            for (int i = 0; i < 4; ++i) {
                const int pos = pos0 + ib + i; float x[8], f[8], gt[8]; unpack8(xv[i], x); unpack8(ov[i], f); unpack8(gv[i], gt);
                const float m = (pos - w >= 0) ? 1.f : 0.f;
#pragma unroll
                for (int e = 0; e < 8; ++e) sum[e] += x[e] - m * f[e];
                const int cnt = (pos + 1 < w) ? (pos + 1) : w; const float inv = __builtin_amdgcn_rcpf((float)cnt);
                float y[8];
#pragma unroll
                for (int e = 0; e < 8; ++e) y[e] = (sum[e] * inv - x[e]) * sc[e] * siluf_(gt[e]);
                u32x4 o; o.x = cvt_pk_bf16(y[0], y[1]); o.y = cvt_pk_bf16(y[2], y[3]); o.z = cvt_pk_bf16(y[4], y[5]); o.w = cvt_pk_bf16(y[6], y[7]);
                gst<u32x4>(gb + (size_t)(ib + i) * 1024, o);
            }
        }
    }
}

constexpr int L_AL = 0, L_GL = 4096, L_RS = 6144, L_KT = 8192  , L_VT1 = 26624  ;
constexpr int L_UST = 63488;
constexpr int L_QA = 8192, L_KA = 25600, L_QB = 43008, L_KB = 60416, L_VT3 = 77824, L_P = 114688;

__device__ __forceinline__ void gla_G(LAS unsigned char* lds, const float (&w)[16], float bias, int d, int tg, float (&g)[16], float& total) {
    const LAS float* AL_s = (const LAS float*)(lds + L_AL); LAS float* GL_s = (LAS float*)(lds + L_GL);
    float run = 0.f;
#pragma unroll
    for (int tt = 0; tt < 16; ++tt) {
        const LAS f32x4* ap = (const LAS f32x4*)(AL_s + (tg * 16 + tt) * 16);
        const f32x4 a0 = ap[0], a1 = ap[1], a2 = ap[2], a3 = ap[3];
        float z0 = bias, z1 = 0.f, z2 = 0.f, z3 = 0.f;
        z0 += a0[0] * w[0]; z1 += a1[0] * w[4]; z2 += a2[0] * w[8];  z3 += a3[0] * w[12];
        z0 += a0[1] * w[1]; z1 += a1[1] * w[5]; z2 += a2[1] * w[9];  z3 += a3[1] * w[13];
        z0 += a0[2] * w[2]; z1 += a1[2] * w[6]; z2 += a2[2] * w[10]; z3 += a3[2] * w[14];
        z0 += a0[3] * w[3]; z1 += a1[3] * w[7]; z2 += a2[3] * w[11]; z3 += a3[3] * w[15];
        const float z = (z0 + z1) + (z2 + z3);
        const float ls = fminf(z, 0.f) - __logf(1.0f + __expf(-fabsf(z)));
        run += ls * (1.0f / 16.0f);
        g[tt] = run;
    }
    GL_s[tg * 128 + d] = run;
    __syncthreads();
    const float p0 = GL_s[d], p1 = GL_s[128 + d], p2 = GL_s[256 + d], p3 = GL_s[384 + d];
    const float prefix = (tg > 0 ? p0 : 0.f) + (tg > 1 ? p1 : 0.f) + (tg > 2 ? p2 : 0.f);
    total = (p0 + p1) + (p2 + p3);
#pragma unroll
    for (int tt = 0; tt < 16; ++tt) g[tt] += prefix;
}
__device__ __forceinline__ void gla_load_stage(const Ctx& cx, const float* AL, const bf16_t* Vb, int it, f32x4& alr, u32x4 (&vr)[2][2]) {
    const int b = it >> 9, c = (it >> 2) & 127, h = it & 3; const int row0 = b * SEQ + c * 64;
    if (cx.tid < 256) alr = gldo<f32x4>(AL + (size_t)row0 * 16, (unsigned)cx.tid * 16u);
    const bf16_t* vb = Vb + (size_t)row0 * 1024 + h * 256;
#pragma unroll
    for (int i = 0; i < 2; ++i) {
        const int q = cx.tid + 512 * i, tp = q & 31, ng = q >> 5;
        const unsigned off = (unsigned)((2 * tp) * 1024 + ng * 8) * 2u;
        vr[i][0] = gldo<u32x4>(vb, off); vr[i][1] = gldo<u32x4>(vb, off + 2048u);
    }
}
__device__ __forceinline__ void gla_write_stage(const Ctx& cx, LAS unsigned char* lds, int vt_off, const f32x4& alr, const u32x4 (&vr)[2][2]) {
    if (cx.tid < 256) ((LAS f32x4*)(lds + L_AL))[cx.tid] = alr;
    LAS unsigned* VT32 = (LAS unsigned*)(lds + vt_off);
#pragma unroll
    for (int i = 0; i < 2; ++i) {
        const int q = cx.tid + 512 * i, tp = q & 31, ng = q >> 5;
        const u32x4 r0 = vr[i][0], r1 = vr[i][1];
#pragma unroll
        for (int j = 0; j < 4; ++j) {
            VT32[(ng * 8 + 2 * j) * 36 + tp] = (r0[j] & 0xffffu) | (r1[j] << 16);
            VT32[(ng * 8 + 2 * j + 1) * 36 + tp] = (r0[j] >> 16) | (r1[j] & 0xffff0000u);
        }
    }
}

__device__ __forceinline__ void gla_p1(CArgs& a, const Ctx& cx, LAS unsigned char* lds, int l) {
    unsigned char* ws = a.ws;
    const float* AL = (const float*)(ws + WS_AL); const bf16_t* QKb = (const bf16_t*)(ws + WS_QK); const bf16_t* Vb = (const bf16_t*)(ws + WS_V);
    unsigned char* US = ws + WS_US; float* DF = (float*)(ws + WS_DF);
    const float* Wup = a.in[2] + (size_t)l * 16 * 512; const float* balpha = a.in[3] + (size_t)l * 512;
    const int tid = cx.tid, lane = cx.lane, wv = cx.wave, fr = lane & 15, fq = lane >> 4;
    const int d = tid & 127, tg = tid >> 7;
    f32x4 alr = (f32x4){0.f, 0.f, 0.f, 0.f}; u32x4 vr[2][2];
    float w[16], bias = 0.f; int prev_h = -1;
    const int it0 = cx.grp * cx.bpg * 512 + cx.gj, itend = (cx.grp + 1) * cx.bpg * 512;
    if (it0 < itend) gla_load_stage(cx, AL, Vb, it0, alr, vr);
    for (int it = it0; it < itend; it += cx.gs) {
        const int b = it >> 9, c = (it >> 2) & 127, h = it & 3; const int row0 = b * SEQ + c * 64; const int slot = (b * 4 + h) * NCH + c;
        __syncthreads();
        gla_write_stage(cx, lds, L_VT1, alr, vr);
        __syncthreads();
        const bf16_t* kb = QKb + (size_t)row0 * 1024 + 512 + h * 128; const unsigned koff = (unsigned)(tg * 16 * 1024 + d) * 2u;
        bf16_t kraw[16];
#pragma unroll
        for (int tt = 0; tt < 16; ++tt) kraw[tt] = gldo<bf16_t>(kb + (size_t)tt * 1024, koff);
        if (h != prev_h) { prev_h = h; bias = gldo<float>(balpha + h * 128, (unsigned)d * 4u);
#pragma unroll
            for (int r = 0; r < 16; ++r) w[r] = gldo<float>(Wup + r * 512 + h * 128, (unsigned)d * 4u); }
        if (it + cx.gs < itend) gla_load_stage(cx, AL, Vb, it + cx.gs, alr, vr);
        float g[16], total;
        gla_G(lds, w, bias, d, tg, g, total);
        unsigned pk[8];
#pragma unroll
        for (int tt = 0; tt < 16; tt += 2) { const float k0 = bf2f(kraw[tt]) * __expf(total - g[tt]), k1 = bf2f(kraw[tt + 1]) * __expf(total - g[tt + 1]); pk[tt >> 1] = cvt_pk_bf16(k0, k1); }
        LAS u32x4* kt = (LAS u32x4*)(lds + L_KT + d * 144 + tg * 32);
        kt[0] = (u32x4){pk[0], pk[1], pk[2], pk[3]}; kt[1] = (u32x4){pk[4], pk[5], pk[6], pk[7]};
        if (tg == 0) gsto<float>(DF + (size_t)slot * 128, (unsigned)d * 4u, __expf(total));
        __syncthreads();
        f32x4 acc[8][2];
#pragma unroll
        for (int dt = 0; dt < 8; ++dt) { acc[dt][0] = (f32x4){0.f, 0.f, 0.f, 0.f}; acc[dt][1] = (f32x4){0.f, 0.f, 0.f, 0.f}; }
#pragma unroll
        for (int ks = 0; ks < 2; ++ks) {
            bf16x8 bfr[2];
#pragma unroll
            for (int nn = 0; nn < 2; ++nn) bfr[nn] = *(const LAS bf16x8*)(lds + L_VT1 + ((2 * wv + nn) * 16 + fr) * 144 + ks * 64 + fq * 16);
#pragma unroll
            for (int dt = 0; dt < 8; ++dt) { const bf16x8 af = *(const LAS bf16x8*)(lds + L_KT + (dt * 16 + fr) * 144 + ks * 64 + fq * 16);
#pragma unroll
                for (int nn = 0; nn < 2; ++nn) acc[dt][nn] = __builtin_amdgcn_mfma_f32_16x16x32_bf16(af, bfr[nn], acc[dt][nn], 0, 0, 0); }
        }
#pragma unroll
        for (int dt = 0; dt < 8; ++dt)
#pragma unroll
            for (int nn = 0; nn < 2; ++nn) { u32x2 o; o.x = cvt_pk_bf16_n(acc[dt][nn][0], acc[dt][nn][1]); o.y = cvt_pk_bf16_n(acc[dt][nn][2], acc[dt][nn][3]);
                *(LAS u32x2*)(lds + L_UST + ((2 * wv + nn) * 16 + fr) * 272 + (dt * 16 + fq * 4) * 2) = o; }
        __syncthreads();
        unsigned char* up = US + us_off(b, h, c);
#pragma unroll
        for (int i = 0; i < 8; ++i) { const int j = tid + 512 * i;
            const u32x4 v = *(const LAS u32x4*)(lds + L_UST + (j >> 4) * 272 + (j & 15) * 16);
            gsto<u32x4>(up + i * 8192, (unsigned)tid * 16u, v); }
    }
}
__device__ __forceinline__ void gla_p2(CArgs& a, const Ctx& cx, bool dry) {
    unsigned char* US = a.ws + WS_US; const float* DF = (const float*)(a.ws + WS_DF);
    const int NT2 = cx.team ? 8192 : cx.bpg * 32768, q20 = cx.team ? (cx.grp * 4 + (cx.gj & 3)) * 8192 : cx.grp * cx.bpg * 32768;
    const int j2 = cx.team ? (cx.gj >> 2) : cx.gj, s2 = cx.team ? (cx.gs >> 2) : cx.gs;
    for (int ql = j2 * 512 + cx.tid; ql < NT2; ql += s2 * 512) { const int q = q20 + ql;
        const int bh = q >> 13, within = q & 8191; const int dq = within & 31;
        unsigned char* p = US + us_off(bh >> 2, bh & 3, 0) + (size_t)within * 8;
        const float* dfp = DF + (size_t)bh * NCH * 128 + dq * 4;
        float s0 = 0.f, s1 = 0.f, s2 = 0.f, s3 = 0.f;
        for (int cb = 0; cb < NCH; cb += 16) {
            u32x2 u[16]; f32x4 df[16];
#pragma unroll
            for (int i = 0; i < 16; ++i) { u[i] = gld<u32x2>(p + (size_t)(cb + i) * 65536); df[i] = gld<f32x4>(dfp + (size_t)(cb + i) * 128); }
#pragma unroll
            for (int i = 0; i < 16; ++i) {
                s0 = df[i][0] * s0 + bf_lo(u[i].x); s1 = df[i][1] * s1 + bf_hi(u[i].x); s2 = df[i][2] * s2 + bf_lo(u[i].y); s3 = df[i][3] * s3 + bf_hi(u[i].y);
                u32x2 o; o.x = cvt_pk_bf16(s0, s1); o.y = cvt_pk_bf16(s2, s3);
                if (!dry) gst<u32x2>(p + (size_t)(cb + i) * 65536, o);
            }
        }
    }
}
__device__ __forceinline__ void gla_p3(CArgs& a, const Ctx& cx, LAS unsigned char* lds, int l, bool dry) {
    unsigned char* ws = a.ws;
    const float* AL = (const float*)(ws + WS_AL); const bf16_t* QKb = (const bf16_t*)(ws + WS_QK); const bf16_t* Vb = (const bf16_t*)(ws + WS_V);
    const unsigned char* US = ws + WS_US; bf16_t* GA = (bf16_t*)(ws + WS_GA);
    const float* Wup = a.in[2] + (size_t)l * 16 * 512; const float* balpha = a.in[3] + (size_t)l * 512; const float* gnorm = a.in[4] + (size_t)l * 1024;
    const int tid = cx.tid, lane = cx.lane, wv = cx.wave, fr = lane & 15, fq = lane >> 4;
    const int d = tid & 127, tg = tid >> 7;
    const int tp = wv & 1, nq = wv >> 1;
    f32x4 alr = (f32x4){0.f, 0.f, 0.f, 0.f}; u32x4 vr[2][2];
    const int it0 = cx.grp * cx.bpg * 512 + cx.gj, itend = (cx.grp + 1) * cx.bpg * 512;
    if (it0 < itend) gla_load_stage(cx, AL, Vb, it0, alr, vr);
    for (int it = it0; it < itend; it += cx.gs) {
        const int b = it >> 9, c = (it >> 2) & 127, h = it & 3; const int row0 = b * SEQ + c * 64; const int slot = (b * 4 + h) * NCH + c;
        __syncthreads();
        gla_write_stage(cx, lds, L_VT3, alr, vr);
        __syncthreads();
        const bf16_t* qb = QKb + (size_t)row0 * 1024 + h * 128; const unsigned qoff = (unsigned)(tg * 16 * 1024 + d) * 2u;
        bf16_t qraw[16], kraw[16];
#pragma unroll
        for (int tt = 0; tt < 16; ++tt) { qraw[tt] = gldo<bf16_t>(qb + (size_t)tt * 1024, qoff); kraw[tt] = gldo<bf16_t>(qb + 512 + (size_t)tt * 1024, qoff); }
        const unsigned char* sp = US + us_off(b, h, c > 0 ? c - 1 : c) + nq * 64 * 256; const unsigned soff = (unsigned)(fr * 256 + fq * 16);
        bf16x8 sf[4][4];
        if (c > 0) {
#pragma unroll
            for (int nt = 0; nt < 4; ++nt)
#pragma unroll
                for (int ks = 0; ks < 4; ++ks) sf[nt][ks] = gldo<bf16x8>(sp + nt * 4096 + ks * 64, soff);
        }
        float g[16], total;
        {   float w[16]; const float bias = gldo<float>(balpha + h * 128, (unsigned)d * 4u);
#pragma unroll
            for (int r = 0; r < 16; ++r) w[r] = gldo<float>(Wup + r * 512 + h * 128, (unsigned)d * 4u);
            if (it + cx.gs < itend) gla_load_stage(cx, AL, Vb, it + cx.gs, alr, vr);
            gla_G(lds, w, bias, d, tg, g, total); }
        {
            LAS bf16_t* QA = (LAS bf16_t*)(lds + L_QA); LAS bf16_t* KA = (LAS bf16_t*)(lds + L_KA); LAS bf16_t* QB = (LAS bf16_t*)(lds + L_QB); LAS bf16_t* KB = (LAS bf16_t*)(lds + L_KB);
#pragma unroll
            for (int tt = 0; tt < 16; ++tt) {
                const float qv = bf2f(qraw[tt]) * QSCALE, kv = bf2f(kraw[tt]); const float eg = __expf(g[tt]), ei = __expf(-g[tt]);
                const int o = (tg * 16 + tt) * 136 + d;
                const unsigned w0 = cvt_pk_bf16(qv * eg, kv * ei), w1 = cvt_pk_bf16(qv * ei, kv * eg);
                QA[o] = (bf16_t)(w0 & 0xffffu); KA[o] = (bf16_t)(w0 >> 16); QB[o] = (bf16_t)(w1 & 0xffffu); KB[o] = (bf16_t)(w1 >> 16);
            }
        }
        __syncthreads();
#pragma unroll
        for (int x = 0; x < 2; ++x) {
            const int tile = 2 * wv + x, tix = tile >> 2, si = tile & 3;
            f32x4 a1 = (f32x4){0.f, 0.f, 0.f, 0.f}, a2 = (f32x4){0.f, 0.f, 0.f, 0.f};
            if (tix >= si) {
#pragma unroll
                for (int ks = 0; ks < 4; ++ks) { const bf16x8 af = *(const LAS bf16x8*)(lds + L_KA + (si * 16 + fr) * 272 + ks * 64 + fq * 16), bfv = *(const LAS bf16x8*)(lds + L_QA + (tix * 16 + fr) * 272 + ks * 64 + fq * 16);
                    a1 = __builtin_amdgcn_mfma_f32_16x16x32_bf16(af, bfv, a1, 0, 0, 0); }
            }
            if (tix <= si) {
#pragma unroll
                for (int ks = 0; ks < 4; ++ks) { const bf16x8 af = *(const LAS bf16x8*)(lds + L_KB + (si * 16 + fr) * 272 + ks * 64 + fq * 16), bfv = *(const LAS bf16x8*)(lds + L_QB + (tix * 16 + fr) * 272 + ks * 64 + fq * 16);
                    a2 = __builtin_amdgcn_mfma_f32_16x16x32_bf16(af, bfv, a2, 0, 0, 0); }
            }
            const int t = tix * 16 + fr, s0 = si * 16 + fq * 4;
            const float p0 = (t >= s0) ? a1[0] : a2[0], p1 = (t >= s0 + 1) ? a1[1] : a2[1], p2 = (t >= s0 + 2) ? a1[2] : a2[2], p3 = (t >= s0 + 3) ? a1[3] : a2[3];
            u32x2 o; o.x = cvt_pk_bf16_n(p0, p1); o.y = cvt_pk_bf16_n(p2, p3);
            *(LAS u32x2*)(lds + L_P + t * 144 + s0 * 2) = o;
        }
        bf16_t* gp = GA + (size_t)row0 * 1024 + h * 256 + nq * 64; const unsigned goff = (unsigned)((2 * tp * 16 + fr) * 1024 + fq * 4) * 2u;
        u32x2 gwv[2][4];
#pragma unroll
        for (int x = 0; x < 2; ++x)
#pragma unroll
            for (int nt = 0; nt < 4; ++nt) gwv[x][nt] = gldo<u32x2>(gp + (size_t)x * 16 * 1024 + nt * 16, goff);
        __syncthreads();
        f32x4 acc[2][4];
#pragma unroll
        for (int x = 0; x < 2; ++x)
#pragma unroll
            for (int i = 0; i < 4; ++i) acc[x][i] = (f32x4){0.f, 0.f, 0.f, 0.f};
        bf16x8 bP[2][2], bQ[2][4];
#pragma unroll
        for (int x = 0; x < 2; ++x) {
#pragma unroll
            for (int ks = 0; ks < 2; ++ks) bP[x][ks] = *(const LAS bf16x8*)(lds + L_P + ((2 * tp + x) * 16 + fr) * 144 + ks * 64 + fq * 16);
#pragma unroll
            for (int ks = 0; ks < 4; ++ks) bQ[x][ks] = *(const LAS bf16x8*)(lds + L_QA + ((2 * tp + x) * 16 + fr) * 272 + ks * 64 + fq * 16);
        }
#pragma unroll
        for (int nt = 0; nt < 4; ++nt) {
            const int n = (nq * 4 + nt) * 16 + fr;
#pragma unroll
            for (int ks = 0; ks < 2; ++ks) { const bf16x8 af = *(const LAS bf16x8*)(lds + L_VT3 + n * 144 + ks * 64 + fq * 16);
#pragma unroll
                for (int x = 0; x < 2; ++x) acc[x][nt] = __builtin_amdgcn_mfma_f32_16x16x32_bf16(af, bP[x][ks], acc[x][nt], 0, 0, 0); }
        }
        if (c > 0) {
#pragma unroll
            for (int nt = 0; nt < 4; ++nt)
#pragma unroll
                for (int ks = 0; ks < 4; ++ks)
#pragma unroll
                    for (int x = 0; x < 2; ++x) acc[x][nt] = __builtin_amdgcn_mfma_f32_16x16x32_bf16(sf[nt][ks], bQ[x][ks], acc[x][nt], 0, 0, 0);
        }
        LAS float* RS = (LAS float*)(lds + L_RS);
#pragma unroll
        for (int x = 0; x < 2; ++x) {
            float ss = 0.f;
#pragma unroll
            for (int nt = 0; nt < 4; ++nt) ss += (acc[x][nt][0] * acc[x][nt][0] + acc[x][nt][1] * acc[x][nt][1]) + (acc[x][nt][2] * acc[x][nt][2] + acc[x][nt][3] * acc[x][nt][3]);
            ss += __shfl_xor(ss, 16); ss += __shfl_xor(ss, 32);
            if (fq == 0) RS[((2 * tp + x) * 16 + fr) * 4 + nq] = ss;
        }
        __syncthreads();
#pragma unroll
        for (int x = 0; x < 2; ++x) {
            const f32x4 r4 = *(const LAS f32x4*)(RS + ((2 * tp + x) * 16 + fr) * 4);
            const float rinv = __builtin_amdgcn_rsqf(((r4[0] + r4[1]) + (r4[2] + r4[3])) * (1.0f / 256.0f) + LN_EPS);
#pragma unroll
            for (int nt = 0; nt < 4; ++nt) {
                const f32x4 gn = gldo<f32x4>(gnorm + h * 256 + nq * 64 + nt * 16, (unsigned)(fq * 4) * 4u);
                const u32x2 gw = gwv[x][nt];
                const float y0 = acc[x][nt][0] * rinv * gn[0] * siluf_(bf_lo(gw.x)), y1 = acc[x][nt][1] * rinv * gn[1] * siluf_(bf_hi(gw.x));
                const float y2 = acc[x][nt][2] * rinv * gn[2] * siluf_(bf_lo(gw.y)), y3 = acc[x][nt][3] * rinv * gn[3] * siluf_(bf_hi(gw.y));
                u32x2 o; o.x = cvt_pk_bf16_n(y0, y1); o.y = cvt_pk_bf16_n(y2, y3);
                if (!dry) gsto<u32x2>(gp + (size_t)x * 16 * 1024 + nt * 16, goff, o);
            }
        }
    }
}

#define XB_TMO      128
#define XB_XCNT(j)  (256  + 64 * (j))
#define XB_XSUB(j)  (1280 + 64 * (j))
#define XB_XGEN(j)  (2304 + 64 * (j))
#define XB_TOP      3328
#define XB_TOPGEN   3392
#define XCD_BAR_WORDS 3456
#define XB_SPIN_CAP (1u << 22)
__device__ __forceinline__ unsigned xb_ld(unsigned* p)              { return __hip_atomic_load(p, __ATOMIC_RELAXED, __HIP_MEMORY_SCOPE_AGENT); }
__device__ __forceinline__ unsigned xb_add(unsigned* p, unsigned v) { return __hip_atomic_fetch_add(p, v, __ATOMIC_RELAXED, __HIP_MEMORY_SCOPE_AGENT); }
__device__ __forceinline__ unsigned xb_xcc_id() { return (unsigned)__builtin_amdgcn_s_getreg((3 << 11) | 20) & 0xFu; }
#define XB_SPIN(cond, bar) do { unsigned _sp = 0; while (cond) { __builtin_amdgcn_s_sleep(1); \
    if ((++_sp & 255u) == 0u) { if (xb_ld(&(bar)[XB_TMO])) break; if (_sp > XB_SPIN_CAP) { atomicAdd(&(bar)[XB_TMO], 1u); break; } } } } while (0)
struct XcdBarrier { unsigned* bar; unsigned x; volatile LAS unsigned* st; unsigned gs; };
__device__ __forceinline__ XcdBarrier xcd_barrier_post(unsigned* bar, volatile LAS unsigned* st, unsigned gs) {
    XcdBarrier b; b.bar = bar; b.x = xb_xcc_id(); b.st = st; b.gs = gs;
    if (threadIdx.x == 0) (void)xb_add(&bar[XB_XCNT(b.x)], 1u);
    return b;
}
__device__ __forceinline__ void xcd_barrier_complete(unsigned* bar, unsigned x, unsigned& nloc, unsigned& nx, const unsigned G) {
    unsigned sum, cnt, mine, sp = 0u;
    for (;;) {
        sum = 0u; cnt = 0u; mine = 0u;
#pragma unroll
        for (unsigned j = 0; j < 16; ++j) { const unsigned c = xb_ld(&bar[XB_XCNT(j)]); sum += c; cnt += (c > 0u) ? 1u : 0u; mine = (j == x) ? c : mine; }
        if (sum == G) break;
        __builtin_amdgcn_s_sleep(1);
        if ((++sp & 255u) == 0u) { if (xb_ld(&bar[XB_TMO])) break; if (sp > XB_SPIN_CAP) { atomicAdd(&bar[XB_TMO], 1u); break; } }
    }
    nloc = mine > 0u ? mine : 1u; nx = cnt > 0u ? cnt : 1u;
}
__device__ __forceinline__ void xcd_barrier(const XcdBarrier& b) {
    asm volatile("s_waitcnt vmcnt(0)" ::: "memory");
    __syncthreads();
    if (threadIdx.x == 0) {
        unsigned* bar; { const unsigned long long v = (unsigned long long)b.bar;
            unsigned lo = (unsigned)__builtin_amdgcn_readfirstlane((unsigned)v), hi = (unsigned)__builtin_amdgcn_readfirstlane((unsigned)(v >> 32));
            asm volatile("" : "+s"(lo), "+s"(hi)); bar = (unsigned*)(((unsigned long long)hi << 32) | lo); }
        __builtin_amdgcn_s_waitcnt(0);
        unsigned nloc = b.st[0], nx = b.st[1];
        if (nloc == 0u) { xcd_barrier_complete(bar, b.x, nloc, nx, b.gs); b.st[0] = nloc; b.st[1] = nx; }
        const unsigned old = xb_add(&bar[XB_XSUB(b.x)], 1u);
        const unsigned gen = old / nloc;
        if (old + 1u == (gen + 1u) * nloc) {
            __builtin_amdgcn_fence(__ATOMIC_RELEASE, "agent");
            asm volatile("s_waitcnt vmcnt(0)" ::: "memory");
            const unsigned og = xb_add(&bar[XB_TOP], 1u);
            const unsigned tg = og / nx;
            if (og + 1u == (tg + 1u) * nx) xb_add(&bar[XB_TOPGEN], 1u);
            else XB_SPIN(xb_ld(&bar[XB_TOPGEN]) == tg, bar);
            __builtin_amdgcn_fence(__ATOMIC_ACQUIRE, "agent");
            xb_add(&bar[XB_XGEN(b.x)], 1u);
            asm volatile("s_waitcnt vmcnt(0)" ::: "memory");
        } else {
            XB_SPIN(xb_ld(&bar[XB_XGEN(b.x)]) == gen, bar);
            __builtin_amdgcn_fence(__ATOMIC_ACQUIRE, "agent");
            asm volatile("s_waitcnt vmcnt(0)" ::: "memory");
        }
    }
    __syncthreads();
}

constexpr int PH_PER_LAYER = 9, N_PHASES = 1 + DEPTH * PH_PER_LAYER;

__device__ __forceinline__ void run_phase(CArgs& a, const Ctx& cx, LAS unsigned char* lds, int ph, bool dry) {
    unsigned char* ws = a.ws;
    if (ph == 0) {
        row_phase(cx, lds, a.in[0], nullptr, (bf16_t*)(ws + WS_X), (float*)(ws + WS_AL), a.in[1] + 3072, nullptr, nullptr, false);
        __syncthreads();
        convert_weights(a, cx, lds, 0);
        return;
    }
    const int l = (ph - 1) / PH_PER_LAYER; int sp = (ph - 1) % PH_PER_LAYER;
#ifdef ONLY_SP
    sp = ONLY_SP;
#endif
    const unsigned char* wsw = ws + (size_t)(l & 1) * WSET_BYTES;
    pg8::Sched S; S.G = cx.G; S.c = cx.bid; S.chain = 1; S.A1 = nullptr; S.B1 = nullptr; S.a_pn = 0; S.nM = MTOK / 256;
    switch (sp) {
    case 0: {
        S.A0 = (const char*)(ws + WS_X); S.B0 = (const char*)(wsw + WS_W1A); S.a_pm = (size_t)256 * 1024 * 2; S.b_pn = (size_t)256 * 1024 * 2; S.nN = 20; S.nwg = S.nM * S.nN;
        pg8::EpiSplit E{(bf16_t*)(ws + WS_QK)};
        pg8::gemm_phase<pg8::EpiSplit>(lds, cx.tid, pg8::Gemm{1024, 1024, 1024}, S, E);
    } break;
    case 1: pool_phase(cx, (const bf16_t*)(ws + WS_PIN), (bf16_t*)(ws + WS_GB), a.in[6] + (size_t)l * 1024); break;
    case 2: gla_p1(a, cx, lds, l); break;
    case 3: gla_p2(a, cx, dry); break;
    case 4: gla_p3(a, cx, lds, l, dry); break;
    case 5: {
        S.A0 = (const char*)(ws + WS_X); S.B0 = (const char*)(wsw + WS_WM); S.a_pm = (size_t)256 * 1024 * 2; S.b_pn = (size_t)256 * 1024 * 2; S.nN = 8; S.nwg = S.nM * S.nN;
        pg8::EpiSig E{(bf16_t*)(ws + WS_MG), a.in[7] + (size_t)l * 2048};
        pg8::gemm_phase<pg8::EpiSig>(lds, cx.tid, pg8::Gemm{1024, 1024, 1024}, S, E);
    } break;
    case 6: {
        S.chain = 2; S.A0 = (const char*)(ws + WS_GA); S.A1 = (const char*)(ws + WS_GB); S.B0 = (const char*)(wsw + WS_WA); S.B1 = (const char*)(wsw + WS_WB);
        S.a_pm = (size_t)256 * 1024 * 2; S.b_pn = (size_t)256 * 1024 * 2; S.nN = 4; S.nwg = S.nM * S.nN;
        pg8::EpiProj E{(const bf16_t*)(ws + WS_MG), (bf16_t*)(ws + WS_PIN)};
        pg8::gemm_phase<pg8::EpiProj>(lds, cx.tid, pg8::Gemm{1024, 1024, 1024}, S, E);
    } break;
    case 7: {
        S.A0 = (const char*)(ws + WS_PIN); S.B0 = (const char*)(wsw + WS_WO); S.a_pm = (size_t)256 * 1024 * 2; S.b_pn = (size_t)256 * 1024 * 2; S.nN = 4; S.nwg = S.nM * S.nN;
        pg8::EpiOut E{l == 0 ? a.in[0] : a.out, a.out};
        pg8::gemm_phase<pg8::EpiOut>(lds, cx.tid, pg8::Gemm{1024, 1024, 1024}, S, E);
    } break;
    default: {
        const bool more = (l + 1 < DEPTH);
        row_phase(cx, lds, a.out, a.out, more ? (bf16_t*)(ws + WS_X) : nullptr, more ? (float*)(ws + WS_AL) : nullptr,
                  a.in[1] + (size_t)(more ? l + 1 : l) * 1024 * INC + 3072, a.in[11] + (size_t)l * 1024, a.in[12] + (size_t)l * 1024, true, dry);
        if (more) { __syncthreads(); convert_weights(a, cx, lds, l + 1); }
    } break;
    }
}

__global__ void __launch_bounds__(512, 2) mega_fwd(Args a) {
    extern __shared__ __attribute__((aligned(16))) unsigned char lds_raw[];
    LAS unsigned char* lds = (LAS unsigned char*)lds_raw;
    cg::grid_group grid = cg::this_grid();
    if (threadIdx.x < 16) ((LAS unsigned*)(lds + LDS_PHASE))[threadIdx.x] = 0u;
    __syncthreads();
    const int ngrp = ((gridDim.x & 7) == 0) ? 4 : 1;
    const int my_grp = (ngrp == 4) ? (int)((blockIdx.x & 7) >> 1) : 0, my_gs = (int)gridDim.x / ngrp, my_gj = (ngrp == 4) ? (int)((blockIdx.x >> 3) * 2 + (blockIdx.x & 1)) : (int)blockIdx.x;
    const XcdBarrier bar = xcd_barrier_post((unsigned*)(a.ws + WS_BAR), (volatile LAS unsigned*)(lds + LDS_PHASE), gridDim.x);
    const XcdBarrier gbar = xcd_barrier_post((unsigned*)(a.ws + WS_BAR) + 4096 * (1 + my_grp), (volatile LAS unsigned*)(lds + LDS_PHASE + 32), (unsigned)my_gs);
    const int my_team = (ngrp == 4 && (my_gs & 3) == 0) ? 1 : 0;
    const XcdBarrier tbar = xcd_barrier_post((unsigned*)(a.ws + WS_BAR) + 4096 * (5 + my_grp * 4 + (my_gj & 3)), (volatile LAS unsigned*)(lds + LDS_PHASE + 48), (unsigned)(my_team ? my_gs / 4 : 1));
    constexpr int PPL = PH_PER_LAYER + (DUP_SP >= 0 ? 1 : 0);
    unsigned long long pr_acc = 0, pr_t0 = 0;
    for (int idx = a.ph_lo; idx < a.ph_hi; ++idx) {
        if (idx > a.ph_lo) { if (a.ph_lo < 0) grid.sync();
            if (PROBE_SP == 11) pr_t0 = __builtin_amdgcn_s_memrealtime();
            const int pph = (idx - 1 == 0) ? 0 : 1 + ((idx - 2) / PPL) * PH_PER_LAYER + ((idx - 2) % PPL);
            const bool wide = (pph == 0) || ((pph - 1) % PH_PER_LAYER == PH_PER_LAYER - 1);
            const int psp = (pph - 1) % PH_PER_LAYER; const bool tseam = my_team && pph > 0 && (psp == 2 || psp == 3);
            for (int r = 0; r < SYNC_REPS; ++r) { if (wide) xcd_barrier(bar); else if (tseam) xcd_barrier(tbar); else xcd_barrier(gbar); }
            if (PROBE_SP == 11) pr_acc += __builtin_amdgcn_s_memrealtime() - pr_t0; }
        int ph = 0; bool dry = false;
        if (idx > 0) { const int l = (idx - 1) / PPL, e = (idx - 1) % PPL; const int sp = (DUP_SP >= 0 && e > DUP_SP) ? e - 1 : e; ph = 1 + l * PH_PER_LAYER + sp; dry = (DUP_SP >= 0 && e == DUP_SP); }
        int tid = threadIdx.x; asm volatile("" : "+v"(tid));
        Ctx cx; cx.tid = tid; cx.lane = tid & 63; cx.wave = __builtin_amdgcn_readfirstlane(tid >> 6); { int bid_ = blockIdx.x, g_ = gridDim.x; asm volatile("" : "+s"(bid_), "+s"(g_)); cx.G = g_; cx.bid = bid_; }
        { int a_ = __builtin_amdgcn_readfirstlane(my_grp), b_ = __builtin_amdgcn_readfirstlane(my_gj), c_ = __builtin_amdgcn_readfirstlane(my_gs); asm volatile("" : "+s"(a_), "+s"(b_), "+s"(c_)); cx.grp = a_; cx.gj = b_; cx.gs = c_; cx.bpg = 4 / ngrp; cx.team = my_team; }
        CArgs* kp = (CArgs*)__builtin_amdgcn_kernarg_segment_ptr(); asm volatile("" : "+s"(kp));
        const bool pr_on = (PROBE_SP >= 0 && PROBE_SP <= 10) && ((ph == 0) ? (PROBE_SP == 10) : ((ph - 1) % PH_PER_LAYER == PROBE_SP));
        if (pr_on) pr_t0 = __builtin_amdgcn_s_memrealtime();
        run_phase(*kp, cx, lds, ph, dry);
        if (pr_on) { __syncthreads(); pr_acc += __builtin_amdgcn_s_memrealtime() - pr_t0; }
    }
    if (PROBE_SP >= 0 && blockIdx.x == 0) { const unsigned long long t1 = __builtin_amdgcn_s_memrealtime(); while (__builtin_amdgcn_s_memrealtime() - t1 < 9ull * pr_acc) __builtin_amdgcn_s_sleep(8); }
}

extern "C" void kernel_launch(void* const* d_in, const int* in_sizes, int n_in, void* d_out, int out_size, void* d_ws, size_t ws_size, hipStream_t stream) {
    static int grid = 0;
    if (grid == 0) {
        if (n_in != 13 || in_sizes[0] != MTOK * DM || out_size != MTOK * DM || ws_size < WS_END) {
            fprintf(stderr, "kernel_launch: unexpected shapes (n_in %d, in0 %d, out %d, ws %zu, need %zu); nothing launched\n", n_in, n_in > 0 ? in_sizes[0] : -1, out_size, ws_size, (size_t)WS_END); grid = -1; return; }
        int dev = 0, cus = 0, per_cu = 0;
        if (hipGetDevice(&dev) != hipSuccess || hipDeviceGetAttribute(&cus, hipDeviceAttributeMultiprocessorCount, dev) != hipSuccess) { grid = -1; return; }
        if (hipFuncSetAttribute((const void*)mega_fwd, hipFuncAttributeMaxDynamicSharedMemorySize, LDS_BYTES) != hipSuccess) { fprintf(stderr, "kernel_launch: hipFuncSetAttribute failed\n"); grid = -1; return; }
        if (hipOccupancyMaxActiveBlocksPerMultiprocessor(&per_cu, (const void*)mega_fwd, 512, LDS_BYTES) != hipSuccess || per_cu < 1) { fprintf(stderr, "kernel_launch: occupancy query says %d\n", per_cu); per_cu = 1; }
        (void)hipGetLastError();
        grid = cus;
    }
    if (grid < 0) return;
    Args a{};
    for (int i = 0; i < 13; ++i) a.in[i] = (const float*)d_in[i];
    a.out = (float*)d_out; a.ws = (unsigned char*)d_ws;
#if N_LAUNCH_MODE == 1
    for (int ph = 0; ph < N_PHASES; ++ph) {
        a.ph_lo = ph; a.ph_hi = ph + 1;
        hipLaunchKernelGGL(mega_fwd, dim3(grid), dim3(512), LDS_BYTES, stream, a);
    }
#else
    if (hipMemsetAsync((unsigned char*)d_ws + WS_BAR, 0, BAR_BYTES + CTR_BYTES, stream) != hipSuccess) { fprintf(stderr, "kernel_launch: memset of barrier words failed\n"); return; }
    a.ph_lo = 0; a.ph_hi = 1 + DEPTH * (PH_PER_LAYER + (DUP_SP >= 0 ? 1 : 0));
    void* args[] = {&a};
    hipError_t e = hipLaunchCooperativeKernel((const void*)mega_fwd, dim3(grid), dim3(512), args, LDS_BYTES, stream);
    if (e != hipSuccess) fprintf(stderr, "cooperative launch failed: %s (grid %d)\n", hipGetErrorString(e), grid);
#endif
}
```

```cpp
#include <hip/hip_runtime.h>
#include <hip/hip_cooperative_groups.h>
#include <cstdio>
#include <cstdint>
namespace cg = cooperative_groups;

#ifndef N_LAUNCH_MODE
#define N_LAUNCH_MODE 0
#endif

#ifndef DUP_SP
#define DUP_SP -1
#endif
#ifndef PROBE_SP
#define PROBE_SP -1
#endif
#ifndef SYNC_REPS
#define SYNC_REPS 1
#endif
#define LAS __attribute__((address_space(3)))
typedef unsigned short bf16_t;
typedef short bf16x8 __attribute__((ext_vector_type(8)));
typedef float f32x4 __attribute__((ext_vector_type(4)));
typedef float f32x2 __attribute__((ext_vector_type(2)));
typedef unsigned u32x4 __attribute__((ext_vector_type(4)));
typedef unsigned u32x2 __attribute__((ext_vector_type(2)));

constexpr int MTOK = 32768, DM = 1024, SEQ = 8192, DEPTH = 4, INC = 7184;
constexpr int NCH = 128;
constexpr float LN_EPS = 1e-5f;
constexpr float DN_ALPHA = 1.6817928305074290f;
constexpr float QSCALE = 0.08838834764831845f;
constexpr size_t UNITB = (size_t)MTOK * 1024 * 2;
constexpr size_t WS_X = 0, WS_QK = 1 * UNITB, WS_V = 2 * UNITB, WS_GA = 3 * UNITB, WS_GB = 4 * UNITB, WS_PIN = 5 * UNITB, WS_F1 = 6 * UNITB, WS_F2 = 7 * UNITB;
constexpr size_t WS_MG = WS_QK;
constexpr size_t WS_US = WS_PIN;
constexpr size_t WS_W1A = WS_F2;
constexpr size_t WS_WM = WS_W1A + (size_t)5120 * 1024 * 2;
constexpr size_t WS_WA = WS_WM + (size_t)2048 * 1024 * 2;
constexpr size_t WS_WB = WS_WA + (size_t)1024 * 1024 * 2;
constexpr size_t WS_WO = WS_WB + (size_t)1024 * 1024 * 2;
constexpr size_t WS_WG = WS_WO + (size_t)1024 * 1024 * 2;
constexpr size_t WSET_BYTES = WS_WG + (size_t)4 * 256 * 256 * 2 - WS_W1A;
constexpr size_t WS_AL = WS_W1A + 2 * WSET_BYTES;
constexpr size_t WS_DF = WS_AL + (size_t)MTOK * 16 * 4;
constexpr size_t WS_BAR = WS_DF + (size_t)2048 * 128 * 4;
constexpr size_t BAR_BYTES = 21 * 16384;
constexpr size_t WS_CTR = WS_BAR + BAR_BYTES;
constexpr size_t CTR_BYTES = 1024;
constexpr size_t WS_END = WS_CTR + CTR_BYTES;
constexpr int LDS_PHASE = 135168, LDS_BYTES = LDS_PHASE + 64;

#define GAS __attribute__((address_space(1)))
template <class T> __device__ __forceinline__ T gld(const void* p) { return *(const GAS T*)p; }
template <class T> __device__ __forceinline__ void gst(void* p, const T v) { *(GAS T*)p = v; }
template <class T> __device__ __forceinline__ T gld_nt(const void* p) { return __builtin_nontemporal_load((const GAS T*)p); }
template <class T> __device__ __forceinline__ void gst_nt(void* p, const T v) { __builtin_nontemporal_store(v, (GAS T*)p); }
template <class T> __device__ __forceinline__ T gldo(const void* ubase, unsigned off) { return *(const GAS T*)((const GAS char*)ubase + off); }
template <class T> __device__ __forceinline__ void gsto(void* ubase, unsigned off, const T v) { *(GAS T*)((GAS char*)ubase + off) = v; }
typedef __bf16 bf16x2_t __attribute__((ext_vector_type(2)));
__device__ __forceinline__ size_t us_off(int b, int h, int c) { return (size_t)(h >> 1) * UNITB + (size_t)b * ((size_t)16 << 20) + (size_t)((h & 1) * NCH + c) * 65536; }
__device__ __forceinline__ unsigned cvt_pk_bf16_n(float lo, float hi) { const f32x2 v = {lo, hi}; const bf16x2_t b = __builtin_convertvector(v, bf16x2_t); return __builtin_bit_cast(unsigned, b); }
__device__ __forceinline__ unsigned cvt_pk_bf16(float lo, float hi) { unsigned r; asm volatile("s_nop 0\n\tv_cvt_pk_bf16_f32 %0, %1, %2" : "=v"(r) : "v"(lo), "v"(hi)); return r; }
__device__ __forceinline__ float bf_lo(unsigned w) { return __uint_as_float(w << 16); }
__device__ __forceinline__ float bf_hi(unsigned w) { return __uint_as_float(w & 0xffff0000u); }
__device__ __forceinline__ float bf2f(bf16_t b) { return __uint_as_float((unsigned)b << 16); }
__device__ __forceinline__ float sigmoidf_(float z) { return __builtin_amdgcn_rcpf(1.0f + __expf(-z)); }
__device__ __forceinline__ float siluf_(float z) { return z * __builtin_amdgcn_rcpf(1.0f + __expf(-z)); }

namespace pg8 {
constexpr int BM = 256, BK = 64, HALF = 128, HTB = HALF * BK * 2, STAGE_BYTES = 8 * HTB, NXCD = 8, WGM = 8;
__host__ __device__ __forceinline__ int lds_byte(int r, int c) { const int st = (r >> 4) * 2 + (c >> 5), rr = r & 15, cc = c & 31, ob = rr * 64 + cc * 2; return st * 1024 + (ob ^ (((ob >> 9) & 1) << 5)); }
__host__ __device__ __forceinline__ void stage_rc(int b, int& R, int& C) { const int st = b / 1024, sb = b % 1024, swz = sb ^ (((sb >> 9) & 1) << 5); R = (st >> 1) * 16 + swz / 64; C = (st & 1) * 32 + (swz % 64) / 2; }
__host__ __device__ __forceinline__ int perm32(int rho) { const int n = rho >> 4, i = rho & 15; return 8 * (i >> 2) + 4 * n + (i & 3); }

struct Unit { const char* A; const char* B; int pm, pn, kind, keep; };
struct Gemm { int lda, ldb, K; };

struct Sched {
    const char *A0, *A1, *B0, *B1; size_t a_pm, a_pn, b_pn; int nM, nN, nwg, G, c, chain;
    __device__ __forceinline__ bool next(int i, Unit& u) const {
        const int ti = (chain == 2) ? (i >> 1) : i, which = (chain == 2) ? (i & 1) : 0;
        const long L = (long)ti * G + c; if (L >= nwg) return false;
        int wgid = (int)L; { const int q = nwg / NXCD, r = nwg % NXCD, xcd = wgid % NXCD, off = wgid / NXCD; wgid = (xcd < r ? xcd * (q + 1) : r * (q + 1) + (xcd - r) * q) + off; }
        const int nig = WGM * nN, gid = wgid / nig, fm = gid * WGM, gsz = (nM - fm) < WGM ? (nM - fm) : WGM;
        u.pm = fm + ((wgid % nig) % gsz); u.pn = (wgid % nig) / gsz;
        u.A = (which ? A1 : A0) + (size_t)u.pm * a_pm + (size_t)u.pn * a_pn; u.B = (which ? B1 : B0) + (size_t)u.pn * b_pn;
        u.kind = which; u.keep = (chain == 2 && which == 0) ? 1 : 0; return true;
    }
};

template <class Epi>
__device__ __forceinline__ void gemm_phase(LAS unsigned char* lds, const int tid, const Gemm g, const Sched& S, const Epi& E) {
    const int wid = __builtin_amdgcn_readfirstlane(tid >> 6), lane = tid & 63, wr = wid >> 2, wc = wid & 3, fr = lane & 15, fq = lane >> 4;
    const int K = g.K, nt = K / BK;
    unsigned voffA[2], voffB[2];
#pragma unroll
    for (int i = 0; i < 2; ++i) { int R, C; stage_rc(tid * 16 + i * 8192, R, C); const int Rb = Epi::PERM ? ((R & ~31) + perm32(R & 31)) : R;
        voffA[i] = (unsigned)(R * g.lda + C) * 2u; voffB[i] = (unsigned)(Rb * g.ldb + C) * 2u; }
    const size_t kstep = (size_t)(BK * 2);
    const size_t hstepA = (size_t)HALF * g.lda * 2, hstepB = (size_t)HALF * g.ldb * 2;
    const unsigned ldsw = (unsigned)wid * 1024u;
    const int aoff = lds_byte(wr * 64 + fr, fq * 8), boff = lds_byte(wc * 32 + fr, fq * 8);
#define PG8_SA(b, h) (((b) * 2 + (h)) * HTB)
#define PG8_SB(b, h) ((4 + (b) * 2 + (h)) * HTB)
#define PG8_STAGE(bufoff, gbase, voff) do { _Pragma("unroll") for (int _i = 0; _i < 2; ++_i) \
        __builtin_amdgcn_global_load_lds((const unsigned*)((const char*)(gbase) + (voff)[_i]), (LAS unsigned*)(lds + (bufoff) + ldsw + _i * 8192), 16, 0, 0); } while (0)
#define PG8_LDA(dst, b, h) do { _Pragma("unroll") for (int m = 0; m < 4; ++m) _Pragma("unroll") for (int k = 0; k < 2; ++k) dst[m][k] = *(const LAS bf16x8*)(lds + PG8_SA(b, h) + aoff + m * 2048 + k * 1024); } while (0)
#define PG8_LDB(dst, b, h) do { _Pragma("unroll") for (int n = 0; n < 2; ++n) _Pragma("unroll") for (int k = 0; k < 2; ++k) dst[n][k] = *(const LAS bf16x8*)(lds + PG8_SB(b, h) + boff + n * 2048 + k * 1024); } while (0)
#define PG8_MMA(ai, bj, At, Bt) do { __builtin_amdgcn_s_setprio(1); _Pragma("unroll") for (int m = 0; m < 4; ++m) _Pragma("unroll") for (int n = 0; n < 2; ++n) _Pragma("unroll") for (int k = 0; k < 2; ++k) \
        acc[ai][bj][m][n] = __builtin_amdgcn_mfma_f32_16x16x32_bf16(Bt[n][k], At[m][k], acc[ai][bj][m][n], 0, 0, 0); __builtin_amdgcn_s_setprio(0); } while (0)
#define PG8_WAIT_V(n) asm volatile("s_waitcnt vmcnt(" #n ")" ::: "memory")
#define PG8_WAIT_L(n) asm volatile("s_waitcnt lgkmcnt(" #n ")" ::: "memory")
#define PG8_BAR __builtin_amdgcn_s_barrier()
#define PG8_SCHED __builtin_amdgcn_sched_barrier(0)
    Unit cur, nxt; int ui = 0;
    if (!S.next(0, cur)) return;
    f32x4 acc[2][2][4][2];
#pragma unroll
    for (int a = 0; a < 2; ++a)
#pragma unroll
        for (int b = 0; b < 2; ++b)
#pragma unroll
            for (int m = 0; m < 4; ++m)
#pragma unroll
                for (int n = 0; n < 2; ++n) acc[a][b][m][n] = (f32x4){0.f, 0.f, 0.f, 0.f};
    bf16x8 At[4][2], B0[2][2], B1[2][2];
    const char* cA = cur.A; const char* cB = cur.B;
    PG8_STAGE(PG8_SB(0, 0), cB, voffB); PG8_STAGE(PG8_SB(0, 1), cB + hstepB, voffB); PG8_STAGE(PG8_SA(0, 0), cA, voffA); PG8_STAGE(PG8_SA(0, 1), cA + hstepA, voffA);
    if (wr == 1) PG8_BAR;
    PG8_WAIT_V(2); PG8_BAR;
    PG8_STAGE(PG8_SB(1, 0), cB + kstep, voffB); PG8_STAGE(PG8_SA(1, 0), cA + kstep, voffA); PG8_STAGE(PG8_SB(1, 1), cB + hstepB + kstep, voffB);
    PG8_WAIT_V(6); PG8_BAR;
    for (;;) {
        const bool has_next = S.next(ui + 1, nxt);
        const char* nA = has_next ? nxt.A : cA; const char* nB = has_next ? nxt.B : cB;
        for (int t = 0; t < nt; t += 2) {
            const bool last = (t == nt - 2);
            const char* a1 = cA + (size_t)(t + 1) * kstep;
            const char* a2 = last ? nA : cA + (size_t)(t + 2) * kstep; const char* b2 = last ? nB : cB + (size_t)(t + 2) * kstep;
            const char* a3 = a2 + kstep; const char* b3 = b2 + kstep;
            PG8_LDB(B0, 0, 0); PG8_LDB(B1, 0, 1); PG8_SCHED; PG8_LDA(At, 0, 0); PG8_STAGE(PG8_SA(1, 1), a1 + hstepA, voffA);
            PG8_WAIT_V(8); PG8_WAIT_L(0); PG8_BAR; PG8_MMA(0, 0, At, B0); PG8_MMA(0, 1, At, B1); PG8_BAR; PG8_SCHED;
            PG8_LDA(At, 0, 1); PG8_STAGE(PG8_SB(0, 0), b2, voffB); PG8_STAGE(PG8_SB(0, 1), b2 + hstepB, voffB); PG8_STAGE(PG8_SA(0, 0), a2, voffA);
            PG8_WAIT_V(8); PG8_WAIT_L(0); PG8_BAR; PG8_MMA(1, 0, At, B0); PG8_MMA(1, 1, At, B1); PG8_BAR; PG8_SCHED;
            PG8_LDB(B0, 1, 0); PG8_LDB(B1, 1, 1); PG8_SCHED; PG8_LDA(At, 1, 0); PG8_STAGE(PG8_SA(0, 1), a2 + hstepA, voffA);
            PG8_WAIT_V(8); PG8_WAIT_L(0); PG8_BAR; PG8_MMA(0, 0, At, B0); PG8_MMA(0, 1, At, B1); PG8_BAR; PG8_SCHED;
            PG8_LDA(At, 1, 1); PG8_STAGE(PG8_SB(1, 0), b3, voffB); PG8_STAGE(PG8_SB(1, 1), b3 + hstepB, voffB); PG8_STAGE(PG8_SA(1, 0), a3, voffA);
            PG8_WAIT_V(8); PG8_WAIT_L(0); PG8_BAR; PG8_MMA(1, 0, At, B0); PG8_MMA(1, 1, At, B1); PG8_BAR; PG8_SCHED;
        }
        if (wr == 0) PG8_BAR;
        asm volatile("s_nop 7\n\ts_nop 7" ::: "memory");
        { int t2 = tid; asm volatile("" : "+v"(t2));
          const int l2 = t2 & 63; E(acc, cur, wr, wc, l2 & 15, l2 >> 4); }
        if (!has_next) break;
        if (!cur.keep) {
#pragma unroll
            for (int a = 0; a < 2; ++a)
#pragma unroll
                for (int b = 0; b < 2; ++b)
#pragma unroll
                    for (int m = 0; m < 4; ++m)
#pragma unroll
                        for (int n = 0; n < 2; ++n) acc[a][b][m][n] = (f32x4){0.f, 0.f, 0.f, 0.f};
        }
        cur = nxt; cA = nA; cB = nB; ++ui;
        if (wr == 1) PG8_BAR;
    }
    PG8_WAIT_V(0);
    PG8_BAR;
#undef PG8_SA
#undef PG8_SB
#undef PG8_STAGE
#undef PG8_LDA
#undef PG8_LDB
#undef PG8_MMA
#undef PG8_WAIT_V
#undef PG8_WAIT_L
#undef PG8_BAR
#undef PG8_SCHED
}

struct EpiSplit {
    static constexpr bool PERM = true;
    bf16_t* base;
    __device__ __forceinline__ void operator()(const f32x4 (&acc)[2][2][4][2], const Unit& u, int wr, int wc, int fr, int fq) const {
        const int row0 = u.pm * BM + wr * 64 + fr; const int colt = u.pn * BM; const int t = colt >> 10;
        bf16_t* b = base + (size_t)t * ((size_t)MTOK * 1024); const int col0 = (colt & 1023) + wc * 32 + 8 * fq;
#pragma unroll
        for (int ai = 0; ai < 2; ++ai)
#pragma unroll
            for (int m = 0; m < 4; ++m) { bf16_t* rowp = b + (size_t)(row0 + ai * HALF + m * 16) * 1024 + col0;
#pragma unroll
                for (int bj = 0; bj < 2; ++bj) { const f32x4 v0 = acc[ai][bj][m][0], v1 = acc[ai][bj][m][1];
                    u32x4 w; w.x = cvt_pk_bf16(v0[0], v0[1]); w.y = cvt_pk_bf16(v0[2], v0[3]); w.z = cvt_pk_bf16(v1[0], v1[1]); w.w = cvt_pk_bf16(v1[2], v1[3]);
                    gst<u32x4>(rowp + bj * HALF, w); } }
    }
};
struct EpiSig {
    static constexpr bool PERM = true;
    bf16_t* O; const float* bias;
    __device__ __forceinline__ void operator()(const f32x4 (&acc)[2][2][4][2], const Unit& u, int wr, int wc, int fr, int fq) const {
        const int row0 = u.pm * BM + wr * 64 + fr; const int col0 = u.pn * BM + wc * 32 + 8 * fq;
        f32x4 bv[2][2];
#pragma unroll
        for (int bj = 0; bj < 2; ++bj)
#pragma unroll
            for (int n = 0; n < 2; ++n) bv[bj][n] = gld<f32x4>(bias + col0 + bj * HALF + 4 * n);
        bf16_t* Oh = O + (size_t)(col0 >> 10) * ((size_t)MTOK * 1024) + (col0 & 1023);
#pragma unroll
        for (int ai = 0; ai < 2; ++ai)
#pragma unroll
            for (int m = 0; m < 4; ++m) { bf16_t* rowp = Oh + (size_t)(row0 + ai * HALF + m * 16) * 1024;
#pragma unroll
                for (int bj = 0; bj < 2; ++bj) { f32x4 v0 = acc[ai][bj][m][0] + bv[bj][0], v1 = acc[ai][bj][m][1] + bv[bj][1];
#pragma unroll
                    for (int j = 0; j < 4; ++j) { v0[j] = sigmoidf_(v0[j]); v1[j] = sigmoidf_(v1[j]); }
                    u32x4 w; w.x = cvt_pk_bf16(v0[0], v0[1]); w.y = cvt_pk_bf16(v0[2], v0[3]); w.z = cvt_pk_bf16(v1[0], v1[1]); w.w = cvt_pk_bf16(v1[2], v1[3]);
                    gst<u32x4>(rowp + bj * HALF, w); } }
    }
};
struct EpiPool {
    static constexpr bool PERM = true;
    bf16_t* GB; const float* scale;
    __device__ __forceinline__ void operator()(const f32x4 (&acc)[2][2][4][2], const Unit& u, int wr, int wc, int fr, int fq) const {
        const int row0 = u.pm * BM + wr * 64 + fr; const int col0 = u.pn * BM + wc * 32 + 8 * fq;
        f32x4 sv[2][2];
#pragma unroll
        for (int bj = 0; bj < 2; ++bj)
#pragma unroll
            for (int n = 0; n < 2; ++n) sv[bj][n] = gld<f32x4>(scale + col0 + bj * HALF + 4 * n);
#pragma unroll
        for (int ai = 0; ai < 2; ++ai)
#pragma unroll
            for (int m = 0; m < 4; ++m) { bf16_t* rowp = GB + (size_t)(row0 + ai * HALF + m * 16) * 1024 + col0;
#pragma unroll
                for (int bj = 0; bj < 2; ++bj) { const u32x4 gw = gld<u32x4>(rowp + bj * HALF);
                    f32x4 v0 = acc[ai][bj][m][0] * sv[bj][0], v1 = acc[ai][bj][m][1] * sv[bj][1];
                    v0[0] *= siluf_(bf_lo(gw.x)); v0[1] *= siluf_(bf_hi(gw.x)); v0[2] *= siluf_(bf_lo(gw.y)); v0[3] *= siluf_(bf_hi(gw.y));
                    v1[0] *= siluf_(bf_lo(gw.z)); v1[1] *= siluf_(bf_hi(gw.z)); v1[2] *= siluf_(bf_lo(gw.w)); v1[3] *= siluf_(bf_hi(gw.w));
                    u32x4 w; w.x = cvt_pk_bf16(v0[0], v0[1]); w.y = cvt_pk_bf16(v0[2], v0[3]); w.z = cvt_pk_bf16(v1[0], v1[1]); w.w = cvt_pk_bf16(v1[2], v1[3]);
                    gst<u32x4>(rowp + bj * HALF, w); } }
    }
};
struct EpiProj {
    static constexpr bool PERM = true;
    const bf16_t* MG; bf16_t* O;
    __device__ __forceinline__ void operator()(f32x4 (&acc)[2][2][4][2], const Unit& u, int wr, int wc, int fr, int fq) const {
        const int row0 = u.pm * BM + wr * 64 + fr; const int col0 = u.pn * BM + wc * 32 + 8 * fq;
        if (u.kind == 0) {
#pragma unroll
            for (int ai = 0; ai < 2; ++ai)
#pragma unroll
                for (int m = 0; m < 4; ++m) { const bf16_t* gp = MG + (size_t)(row0 + ai * HALF + m * 16) * 1024 + col0;
#pragma unroll
                    for (int bj = 0; bj < 2; ++bj) { const u32x4 ga = gld<u32x4>(gp + bj * HALF), gb = gld<u32x4>(gp + (size_t)MTOK * 1024 + bj * HALF);
                        f32x4& v0 = acc[ai][bj][m][0]; f32x4& v1 = acc[ai][bj][m][1];
                        v0[0] *= bf_lo(ga.x) * __builtin_amdgcn_rcpf(bf_lo(gb.x)); v0[1] *= bf_hi(ga.x) * __builtin_amdgcn_rcpf(bf_hi(gb.x));
                        v0[2] *= bf_lo(ga.y) * __builtin_amdgcn_rcpf(bf_lo(gb.y)); v0[3] *= bf_hi(ga.y) * __builtin_amdgcn_rcpf(bf_hi(gb.y));
                        v1[0] *= bf_lo(ga.z) * __builtin_amdgcn_rcpf(bf_lo(gb.z)); v1[1] *= bf_hi(ga.z) * __builtin_amdgcn_rcpf(bf_hi(gb.z));
                        v1[2] *= bf_lo(ga.w) * __builtin_amdgcn_rcpf(bf_lo(gb.w)); v1[3] *= bf_hi(ga.w) * __builtin_amdgcn_rcpf(bf_hi(gb.w)); } }
        } else {
#pragma unroll
            for (int ai = 0; ai < 2; ++ai)
#pragma unroll
                for (int m = 0; m < 4; ++m) { const size_t r = (size_t)(row0 + ai * HALF + m * 16); const bf16_t* gp = MG + (size_t)MTOK * 1024 + r * 1024 + col0; bf16_t* rowp = O + r * 1024 + col0;
#pragma unroll
                    for (int bj = 0; bj < 2; ++bj) { const u32x4 gb = gld<u32x4>(gp + bj * HALF);
                        const f32x4 v0 = acc[ai][bj][m][0], v1 = acc[ai][bj][m][1];
                        u32x4 w; w.x = cvt_pk_bf16(v0[0] * bf_lo(gb.x), v0[1] * bf_hi(gb.x)); w.y = cvt_pk_bf16(v0[2] * bf_lo(gb.y), v0[3] * bf_hi(gb.y));
                        w.z = cvt_pk_bf16(v1[0] * bf_lo(gb.z), v1[1] * bf_hi(gb.z)); w.w = cvt_pk_bf16(v1[2] * bf_lo(gb.w), v1[3] * bf_hi(gb.w));
                        gst<u32x4>(rowp + bj * HALF, w); } }
        }
    }
};
struct EpiOut {
    static constexpr bool PERM = false;
    const float* xres; float* out;
    __device__ __forceinline__ void operator()(const f32x4 (&acc)[2][2][4][2], const Unit& u, int wr, int wc, int fr, int fq) const {
        const int row0 = u.pm * BM + wr * 64 + fr, col0 = u.pn * BM + wc * 32 + 4 * fq;
#pragma unroll
        for (int ai = 0; ai < 2; ++ai)
#pragma unroll
            for (int m = 0; m < 4; ++m) { const size_t off = (size_t)(row0 + ai * HALF + m * 16) * 1024 + col0;
#pragma unroll
                for (int bj = 0; bj < 2; ++bj)
#pragma unroll
                    for (int n = 0; n < 2; ++n) { const f32x4 xs = gld<f32x4>(xres + off + bj * HALF + n * 16);
                        gst<f32x4>(out + off + bj * HALF + n * 16, xs * DN_ALPHA + acc[ai][bj][m][n]); } }
    }
};
}

struct Args { const float* in[13]; float* out; unsigned char* ws; int ph_lo, ph_hi; };
typedef const __attribute__((address_space(4))) Args CArgs;
struct Ctx { int tid, lane, wave, G, bid; int grp, gj, gs, bpg; int team; };

__device__ __forceinline__ float wave_sum(float v) {
#pragma unroll
    for (int o = 1; o < 64; o <<= 1) v += __shfl_xor(v, o);
    return v;
}

__device__ __forceinline__ void transpose_item(const float* W, int ld_src, int col0, int nblk, int K, bf16_t* WT, int row_off, LAS float* scr, int item, int lane) {
    const int kb = item / nblk, nb = item % nblk, k0 = 64 * kb, n0 = 32 * nb;
    {   float tv[32];
        const float* wp = W + (size_t)(k0 + (lane >> 5)) * ld_src + col0 + n0 + (lane & 31);
#pragma unroll
        for (int i = 0; i < 32; ++i) tv[i] = gld<float>(wp + (size_t)(2 * i) * ld_src);
#pragma unroll
        for (int i = 0; i < 32; ++i) scr[(2 * i + (lane >> 5)) * 33 + (lane & 31)] = tv[i]; }
    asm volatile("s_waitcnt lgkmcnt(0)" ::: "memory");
    const int c = lane & 7;
#pragma unroll
    for (int j = 0; j < 4; ++j) { const int n = (lane >> 3) + 8 * j; const LAS float* s = scr + (8 * c) * 33 + n;
        u32x4 o; o.x = cvt_pk_bf16(s[0 * 33], s[1 * 33]); o.y = cvt_pk_bf16(s[2 * 33], s[3 * 33]); o.z = cvt_pk_bf16(s[4 * 33], s[5 * 33]); o.w = cvt_pk_bf16(s[6 * 33], s[7 * 33]);
        gst<u32x4>(WT + (size_t)(row_off + n0 + n) * K + k0 + 8 * c, o); }
    asm volatile("s_waitcnt lgkmcnt(0)" ::: "memory");
}
__device__ __forceinline__ void compose_item(const float* w_in  , const float* w_g  , bf16_t* WT  , LAS float* scr, int item, int lane) {
    const int kb = item >> 5, nb = item & 31, k0 = 16 * kb, ng = nb * 32 + (lane & 31), g = ng >> 8, o = ng & 255, kh = lane >> 5;
    const float* arow = w_in + (size_t)k0 * INC + 3088 + g * 256;
#pragma unroll
    for (int r = 0; r < 16; ++r) *(LAS f32x4*)(scr + r * 256 + 4 * lane) = gld<f32x4>(arow + (size_t)r * INC + 4 * lane);
    asm volatile("s_waitcnt lgkmcnt(0)" ::: "memory");
    const float* bcol = w_g + (size_t)g * 65536 + o;
    float acc[8];
#pragma unroll
    for (int j = 0; j < 8; ++j) acc[j] = 0.f;
    float bv[16], bn[16];
#pragma unroll
    for (int e = 0; e < 16; ++e) bv[e] = gld<float>(bcol + (size_t)e * 256);
#pragma unroll 1
    for (int i0 = 0; i0 < 256; i0 += 16) {
        const int inext = (i0 + 16 < 256) ? i0 + 16 : i0;
#pragma unroll
        for (int e = 0; e < 16; ++e) bn[e] = gld<float>(bcol + (size_t)(inext + e) * 256);
#pragma unroll
        for (int q = 0; q < 4; ++q)
#pragma unroll
            for (int j = 0; j < 8; ++j) { const f32x4 av = *(const LAS f32x4*)(scr + (kh * 8 + j) * 256 + i0 + 4 * q);
                acc[j] += (av[0] * bv[4 * q] + av[1] * bv[4 * q + 1]) + (av[2] * bv[4 * q + 2] + av[3] * bv[4 * q + 3]); }
#pragma unroll
        for (int e = 0; e < 16; ++e) bv[e] = bn[e];
    }
    u32x4 ov; ov.x = cvt_pk_bf16(acc[0], acc[1]); ov.y = cvt_pk_bf16(acc[2], acc[3]); ov.z = cvt_pk_bf16(acc[4], acc[5]); ov.w = cvt_pk_bf16(acc[6], acc[7]);
    gst<u32x4>(WT + (size_t)ng * 1024 + k0 + kh * 8, ov);
    asm volatile("s_waitcnt lgkmcnt(0)" ::: "memory");
}
__device__ __forceinline__ void convert_weights(CArgs& a, const Ctx& cx, LAS unsigned char* lds, int l) {
    LAS float* scr = (LAS float*)(lds + cx.wave * 16384);
    const int gw = cx.bid * 8 + cx.wave, NGW = cx.G * 8;
    unsigned char* ws = a.ws + (size_t)(l & 1) * WSET_BYTES;
    const float* w_in = a.in[1] + (size_t)l * 1024 * INC;
    const float* w_pa = a.in[8] + (size_t)l * 1024 * 1024; const float* w_pb = a.in[9] + (size_t)l * 1024 * 1024; const float* w_o = a.in[10] + (size_t)l * 1024 * 1024;
    const float* w_g = a.in[5] + (size_t)l * 4 * 256 * 256;
    constexpr int I_A = 16 * 96, I_GB = 16 * 32, I_M = 16 * 64, I_P = 16 * 32, I_C = 64 * 32;
    constexpr int NIT = I_A + I_GB + I_M + 3 * I_P + I_C;
    unsigned* ctr = (unsigned*)(a.ws + WS_CTR) + 64 * l;
    volatile LAS unsigned* tw = (volatile LAS unsigned*)(lds + 8 * 16384);
    (void)gw; (void)NGW;
    unsigned tk = 0u;
    if (cx.tid == 0) tk = __hip_atomic_fetch_add(ctr, 8u, __ATOMIC_RELAXED, __HIP_MEMORY_SCOPE_AGENT);
    for (int rnd = 0; ; ++rnd) {
        if (cx.tid == 0) tw[rnd & 1] = tk;
        __syncthreads();
        const int base = (int)tw[rnd & 1];
        if (base >= NIT) break;
        if (cx.tid == 0) tk = __hip_atomic_fetch_add(ctr, 8u, __ATOMIC_RELAXED, __HIP_MEMORY_SCOPE_AGENT);
        int r = base + cx.wave;
        if (r < NIT) {
        if (r < I_C) { compose_item(w_in, w_g, (bf16_t*)(ws + WS_W1A) + (size_t)4096 * 1024, scr, r, cx.lane); }
        else { r -= I_C;
        if (r < I_A) { transpose_item(w_in, INC, 0, 96, 1024, (bf16_t*)(ws + WS_W1A), 0, scr, r, cx.lane); }
        else { r -= I_A;
        if (r < I_GB) { transpose_item(w_in, INC, 4112, 32, 1024, (bf16_t*)(ws + WS_W1A), 3072, scr, r, cx.lane); }
        else { r -= I_GB;
        if (r < I_M) { transpose_item(w_in, INC, 5136, 64, 1024, (bf16_t*)(ws + WS_WM), 0, scr, r, cx.lane); }
        else { r -= I_M;
        if (r < I_P) { transpose_item(w_pa, 1024, 0, 32, 1024, (bf16_t*)(ws + WS_WA), 0, scr, r, cx.lane); }
        else { r -= I_P;
        if (r < I_P) { transpose_item(w_pb, 1024, 0, 32, 1024, (bf16_t*)(ws + WS_WB), 0, scr, r, cx.lane); }
        else { r -= I_P; transpose_item(w_o, 1024, 0, 32, 1024, (bf16_t*)(ws + WS_WO), 0, scr, r, cx.lane); } } } } } }
        }
    }
}

__device__ __forceinline__ void row_phase(const Ctx& cx, LAS unsigned char* lds, const float* src, float* dst, bf16_t* xbf, float* AL, const float* walpha  ,
                                          const float* lng, const float* lnb, bool do_ln, bool dry = false) {
    LAS float* WT = (LAS float*)lds;
    if (AL) {
        for (int idx = cx.tid; idx < 16384; idx += 512) { const int k = idx >> 4, c = idx & 15; WT[c * 1028 + k] = gld<float>(walpha + (size_t)k * INC + c); }
    }
    __syncthreads();
    const int gw = cx.gj * 8 + cx.wave, NGW = cx.gs * 8, lane = cx.lane; const int rg0 = cx.grp * cx.bpg * 2048, nrg = cx.bpg * 2048;
    f32x4 gj[4], bj[4];
#pragma unroll
    for (int j = 0; j < 4; ++j) { gj[j] = (f32x4){1.f, 1.f, 1.f, 1.f}; bj[j] = (f32x4){0.f, 0.f, 0.f, 0.f}; }
    if (do_ln) {
#pragma unroll
        for (int j = 0; j < 4; ++j) { gj[j] = gld<f32x4>(lng + 256 * j + 4 * lane); bj[j] = gld<f32x4>(lnb + 256 * j + 4 * lane); }
    }
    for (int rl = gw; rl < nrg; rl += NGW) {
        const size_t m0 = (size_t)(rg0 + rl) * 4;
        f32x4 v[4][4];
#pragma unroll
        for (int r = 0; r < 4; ++r)
#pragma unroll
            for (int j = 0; j < 4; ++j) v[r][j] = gld_nt<f32x4>(src + (m0 + r) * 1024 + 256 * j + 4 * lane);
        if (do_ln) {
#pragma unroll
            for (int r = 0; r < 4; ++r) {
                float s = 0.f;
#pragma unroll
                for (int j = 0; j < 4; ++j) s += (v[r][j][0] + v[r][j][1]) + (v[r][j][2] + v[r][j][3]);
                const float mean = wave_sum(s) * (1.f / 1024.f); float s2 = 0.f;
#pragma unroll
                for (int j = 0; j < 4; ++j) { v[r][j] = v[r][j] - mean; s2 += (v[r][j][0] * v[r][j][0] + v[r][j][1] * v[r][j][1]) + (v[r][j][2] * v[r][j][2] + v[r][j][3] * v[r][j][3]); }
                const float rstd = __builtin_amdgcn_rsqf(wave_sum(s2) * (1.f / 1024.f) + LN_EPS);
#pragma unroll
                for (int j = 0; j < 4; ++j) { v[r][j] = v[r][j] * rstd * gj[j] + bj[j]; if (!dry) gst_nt<f32x4>(dst + (m0 + r) * 1024 + 256 * j + 4 * lane, v[r][j]); }
            }
        }
        if (xbf) {
#pragma unroll
            for (int r = 0; r < 4; ++r)
#pragma unroll
                for (int j = 0; j < 4; ++j) { u32x2 w; w.x = cvt_pk_bf16(v[r][j][0], v[r][j][1]); w.y = cvt_pk_bf16(v[r][j][2], v[r][j][3]);
                    if (!dry) gst<u32x2>(xbf + (m0 + r) * 1024 + 256 * j + 4 * lane, w); }
        }
        if (AL) {
            float acc[64];
#pragma unroll
            for (int i = 0; i < 64; ++i) acc[i] = 0.f;
#pragma unroll
            for (int c = 0; c < 16; ++c)
#pragma unroll
                for (int j = 0; j < 4; ++j) { const f32x4 w = *(const LAS f32x4*)(WT + c * 1028 + 256 * j + 4 * lane);
#pragma unroll
                    for (int r = 0; r < 4; ++r) acc[r * 16 + c] += (v[r][j][0] * w[0] + v[r][j][1] * w[1]) + (v[r][j][2] * w[2] + v[r][j][3] * w[3]); }
#pragma unroll
            for (int h = 32; h >= 1; h >>= 1) {
                const bool up = (lane & h) != 0;
#pragma unroll
                for (int i = 0; i < h; ++i) { const float keep = up ? acc[i + h] : acc[i]; const float send = up ? acc[i] : acc[i + h]; acc[i] = keep + __shfl_xor(send, h); }
            }
            if (!dry) gst<float>(AL + m0 * 16 + lane, acc[0]);
        }
    }
}

__device__ __forceinline__ void unpack8(const u32x4 w, float (&f)[8]) { f[0] = bf_lo(w.x); f[1] = bf_hi(w.x); f[2] = bf_lo(w.y); f[3] = bf_hi(w.y); f[4] = bf_lo(w.z); f[5] = bf_hi(w.z); f[6] = bf_lo(w.w); f[7] = bf_hi(w.w); }
__device__ __forceinline__ void pool_phase(const Ctx& cx, const bf16_t* pin, bf16_t* gbuf, const float* scale) {
    const int NT = cx.bpg * 32768, q0 = cx.grp * cx.bpg * 32768;
    for (int ql = cx.gj * 512 + cx.tid; ql < NT; ql += cx.gs * 512) { const int q = q0 + ql;
        const int cg8 = q & 127, seg = q >> 7; const int g = cg8 >> 5; const int w = 2 << g;
        const int t0 = seg * 32, pos0 = t0 & (SEQ - 1);
        const bf16_t* base = pin + (size_t)t0 * 1024 + cg8 * 8;
        float sum[8], sc[8];
        { const f32x4 s0 = gld<f32x4>(scale + cg8 * 8), s1 = gld<f32x4>(scale + cg8 * 8 + 4); sc[0] = s0[0]; sc[1] = s0[1]; sc[2] = s0[2]; sc[3] = s0[3]; sc[4] = s1[0]; sc[5] = s1[1]; sc[6] = s1[2]; sc[7] = s1[3]; }
        bf16_t* gb = gbuf + (size_t)t0 * 1024 + cg8 * 8;
#pragma unroll
        for (int e = 0; e < 8; ++e) sum[e] = 0.f;
        if (pos0 > 0) {
#pragma unroll 1
            for (int jb = 0; jb < 16; jb += 8) {
                u32x4 hv[8];
#pragma unroll
                for (int j = 0; j < 8; ++j) hv[j] = gld<u32x4>(base - (size_t)(jb + j + 1) * 1024);
#pragma unroll
                for (int j = 0; j < 8; ++j) { float f[8]; unpack8(hv[j], f); const float m = (jb + j + 1 <= w) ? 1.f : 0.f;
#pragma unroll
                    for (int e = 0; e < 8; ++e) sum[e] += m * f[e]; }
            }
        }
#pragma unroll 1
        for (int ib = 0; ib < 32; ib += 4) {
            u32x4 xv[4], ov[4], gv[4];
#pragma unroll
            for (int i = 0; i < 4; ++i) { xv[i] = gld<u32x4>(base + (size_t)(ib + i) * 1024); gv[i] = gld_nt<u32x4>(gb + (size_t)(ib + i) * 1024);
                const int back = (pos0 + ib + i - w >= 0) ? w : 0;
                ov[i] = gld<u32x4>(base + (size_t)(ib + i - back) * 1024); }
#pragma unroll
            for (int i = 0; i < 4; ++i) {
                const int pos = pos0 + ib + i; float x[8], f[8], gt[8]; unpack8(xv[i], x); unpack8(ov[i], f); unpack8(gv[i], gt);
                const float m = (pos - w >= 0) ? 1.f : 0.f;
#pragma unroll
                for (int e = 0; e < 8; ++e) sum[e] += x[e] - m * f[e];
                const int cnt = (pos + 1 < w) ? (pos + 1) : w; const float inv = __builtin_amdgcn_rcpf((float)cnt);
                float y[8];
#pragma unroll
                for (int e = 0; e < 8; ++e) y[e] = (sum[e] * inv - x[e]) * sc[e] * siluf_(gt[e]);
                u32x4 o; o.x = cvt_pk_bf16(y[0], y[1]); o.y = cvt_pk_bf16(y[2], y[3]); o.z = cvt_pk_bf16(y[4], y[5]); o.w = cvt_pk_bf16(y[6], y[7]);
                gst_nt<u32x4>(gb + (size_t)(ib + i) * 1024, o);
            }
        }
    }
}

constexpr int L_AL = 0, L_GL = 4096, L_RS = 6144, L_KT = 8192  , L_VT1 = 26624  ;
constexpr int L_UST = 63488;
constexpr int L_QA = 8192, L_KA = 25600, L_QB = 43008, L_KB = 60416, L_VT3 = 77824, L_P = 114688;

__device__ __forceinline__ void gla_G(LAS unsigned char* lds, const float (&w)[16], float bias, int d, int tg, float (&g)[16], float& total) {
    const LAS float* AL_s = (const LAS float*)(lds + L_AL); LAS float* GL_s = (LAS float*)(lds + L_GL);
    float run = 0.f;
#pragma unroll
    for (int tt = 0; tt < 16; ++tt) {
        const LAS f32x4* ap = (const LAS f32x4*)(AL_s + (tg * 16 + tt) * 16);
        const f32x4 a0 = ap[0], a1 = ap[1], a2 = ap[2], a3 = ap[3];
        float z0 = bias, z1 = 0.f, z2 = 0.f, z3 = 0.f;
        z0 += a0[0] * w[0]; z1 += a1[0] * w[4]; z2 += a2[0] * w[8];  z3 += a3[0] * w[12];
        z0 += a0[1] * w[1]; z1 += a1[1] * w[5]; z2 += a2[1] * w[9];  z3 += a3[1] * w[13];
        z0 += a0[2] * w[2]; z1 += a1[2] * w[6]; z2 += a2[2] * w[10]; z3 += a3[2] * w[14];
        z0 += a0[3] * w[3]; z1 += a1[3] * w[7]; z2 += a2[3] * w[11]; z3 += a3[3] * w[15];
        const float z = (z0 + z1) + (z2 + z3);
        const float ls = fminf(z, 0.f) - __logf(1.0f + __expf(-fabsf(z)));
        run += ls * (1.0f / 16.0f);
        g[tt] = run;
    }
    GL_s[tg * 128 + d] = run;
    __syncthreads();
    const float p0 = GL_s[d], p1 = GL_s[128 + d], p2 = GL_s[256 + d], p3 = GL_s[384 + d];
    const float prefix = (tg > 0 ? p0 : 0.f) + (tg > 1 ? p1 : 0.f) + (tg > 2 ? p2 : 0.f);
    total = (p0 + p1) + (p2 + p3);
#pragma unroll
    for (int tt = 0; tt < 16; ++tt) g[tt] += prefix;
}
__device__ __forceinline__ void gla_load_stage(const Ctx& cx, const float* AL, const bf16_t* Vb, int it, f32x4& alr, u32x4 (&vr)[2][2]) {
    const int b = it >> 9, c = (it >> 2) & 127, h = it & 3; const int row0 = b * SEQ + c * 64;
    if (cx.tid < 256) alr = gldo<f32x4>(AL + (size_t)row0 * 16, (unsigned)cx.tid * 16u);
    const bf16_t* vb = Vb + (size_t)row0 * 1024 + h * 256;
#pragma unroll
    for (int i = 0; i < 2; ++i) {
        const int q = cx.tid + 512 * i, tp = q & 31, ng = q >> 5;
        const unsigned off = (unsigned)((2 * tp) * 1024 + ng * 8) * 2u;
        vr[i][0] = gldo<u32x4>(vb, off); vr[i][1] = gldo<u32x4>(vb, off + 2048u);
    }
}
__device__ __forceinline__ void gla_write_stage(const Ctx& cx, LAS unsigned char* lds, int vt_off, const f32x4& alr, const u32x4 (&vr)[2][2]) {
    if (cx.tid < 256) ((LAS f32x4*)(lds + L_AL))[cx.tid] = alr;
    LAS unsigned* VT32 = (LAS unsigned*)(lds + vt_off);
#pragma unroll
    for (int i = 0; i < 2; ++i) {
        const int q = cx.tid + 512 * i, tp = q & 31, ng = q >> 5;
        const u32x4 r0 = vr[i][0], r1 = vr[i][1];
#pragma unroll
        for (int j = 0; j < 4; ++j) {
            VT32[(ng * 8 + 2 * j) * 36 + tp] = (r0[j] & 0xffffu) | (r1[j] << 16);
            VT32[(ng * 8 + 2 * j + 1) * 36 + tp] = (r0[j] >> 16) | (r1[j] & 0xffff0000u);
        }
    }
}

__device__ __forceinline__ void gla_p1(CArgs& a, const Ctx& cx, LAS unsigned char* lds, int l) {
    unsigned char* ws = a.ws;
    const float* AL = (const float*)(ws + WS_AL); const bf16_t* QKb = (const bf16_t*)(ws + WS_QK); const bf16_t* Vb = (const bf16_t*)(ws + WS_V);
    unsigned char* US = ws + WS_US; float* DF = (float*)(ws + WS_DF);
    const float* Wup = a.in[2] + (size_t)l * 16 * 512; const float* balpha = a.in[3] + (size_t)l * 512;
    const int tid = cx.tid, lane = cx.lane, wv = cx.wave, fr = lane & 15, fq = lane >> 4;
    const int d = tid & 127, tg = tid >> 7;
    f32x4 alr = (f32x4){0.f, 0.f, 0.f, 0.f}; u32x4 vr[2][2];
    float w[16], bias = 0.f; int prev_h = -1;
    const int it0 = cx.grp * cx.bpg * 512 + cx.gj, itend = (cx.grp + 1) * cx.bpg * 512;
    if (it0 < itend) gla_load_stage(cx, AL, Vb, it0, alr, vr);
    for (int it = it0; it < itend; it += cx.gs) {
        const int b = it >> 9, c = (it >> 2) & 127, h = it & 3; const int row0 = b * SEQ + c * 64; const int slot = (b * 4 + h) * NCH + c;
        __syncthreads();
        gla_write_stage(cx, lds, L_VT1, alr, vr);
        __syncthreads();
        const bf16_t* kb = QKb + (size_t)row0 * 1024 + 512 + h * 128; const unsigned koff = (unsigned)(tg * 16 * 1024 + d) * 2u;
        bf16_t kraw[16];
#pragma unroll
        for (int tt = 0; tt < 16; ++tt) kraw[tt] = gldo<bf16_t>(kb + (size_t)tt * 1024, koff);
        if (h != prev_h) { prev_h = h; bias = gldo<float>(balpha + h * 128, (unsigned)d * 4u);
#pragma unroll
            for (int r = 0; r < 16; ++r) w[r] = gldo<float>(Wup + r * 512 + h * 128, (unsigned)d * 4u); }
        if (it + cx.gs < itend) gla_load_stage(cx, AL, Vb, it + cx.gs, alr, vr);
        float g[16], total;
        gla_G(lds, w, bias, d, tg, g, total);
        unsigned pk[8];
#pragma unroll
        for (int tt = 0; tt < 16; tt += 2) { const float k0 = bf2f(kraw[tt]) * __expf(total - g[tt]), k1 = bf2f(kraw[tt + 1]) * __expf(total - g[tt + 1]); pk[tt >> 1] = cvt_pk_bf16(k0, k1); }
        LAS u32x4* kt = (LAS u32x4*)(lds + L_KT + d * 144 + tg * 32);
        kt[0] = (u32x4){pk[0], pk[1], pk[2], pk[3]}; kt[1] = (u32x4){pk[4], pk[5], pk[6], pk[7]};
        if (tg == 0) gsto<float>(DF + (size_t)slot * 128, (unsigned)d * 4u, __expf(total));
        __syncthreads();
        f32x4 acc[8][2];
#pragma unroll
        for (int dt = 0; dt < 8; ++dt) { acc[dt][0] = (f32x4){0.f, 0.f, 0.f, 0.f}; acc[dt][1] = (f32x4){0.f, 0.f, 0.f, 0.f}; }
#pragma unroll
        for (int ks = 0; ks < 2; ++ks) {
            bf16x8 bfr[2];
#pragma unroll
            for (int nn = 0; nn < 2; ++nn) bfr[nn] = *(const LAS bf16x8*)(lds + L_VT1 + ((2 * wv + nn) * 16 + fr) * 144 + ks * 64 + fq * 16);
#pragma unroll
            for (int dt = 0; dt < 8; ++dt) { const bf16x8 af = *(const LAS bf16x8*)(lds + L_KT + (dt * 16 + fr) * 144 + ks * 64 + fq * 16);
#pragma unroll
                for (int nn = 0; nn < 2; ++nn) acc[dt][nn] = __builtin_amdgcn_mfma_f32_16x16x32_bf16(af, bfr[nn], acc[dt][nn], 0, 0, 0); }
        }
#pragma unroll
        for (int dt = 0; dt < 8; ++dt)
#pragma unroll
            for (int nn = 0; nn < 2; ++nn) { u32x2 o; o.x = cvt_pk_bf16_n(acc[dt][nn][0], acc[dt][nn][1]); o.y = cvt_pk_bf16_n(acc[dt][nn][2], acc[dt][nn][3]);
                *(LAS u32x2*)(lds + L_UST + ((2 * wv + nn) * 16 + fr) * 272 + (dt * 16 + fq * 4) * 2) = o; }
        __syncthreads();
        unsigned char* up = US + us_off(b, h, c);
#pragma unroll
        for (int i = 0; i < 8; ++i) { const int j = tid + 512 * i;
            const u32x4 v = *(const LAS u32x4*)(lds + L_UST + (j >> 4) * 272 + (j & 15) * 16);
            gsto<u32x4>(up + i * 8192, (unsigned)tid * 16u, v); }
    }
}
__device__ __forceinline__ void gla_p2(CArgs& a, const Ctx& cx, bool dry) {
    unsigned char* US = a.ws + WS_US; const float* DF = (const float*)(a.ws + WS_DF);
    const int NT2 = cx.team ? 8192 : cx.bpg * 32768, q20 = cx.team ? (cx.grp * 4 + (cx.gj & 3)) * 8192 : cx.grp * cx.bpg * 32768;
    const int j2 = cx.team ? (cx.gj >> 2) : cx.gj, s2 = cx.team ? (cx.gs >> 2) : cx.gs;
    for (int ql = j2 * 512 + cx.tid; ql < NT2; ql += s2 * 512) { const int q = q20 + ql;
        const int bh = q >> 13, within = q & 8191; const int dq = within & 31;
        unsigned char* p = US + us_off(bh >> 2, bh & 3, 0) + (size_t)within * 8;
        const float* dfp = DF + (size_t)bh * NCH * 128 + dq * 4;
        float s0 = 0.f, s1 = 0.f, s2 = 0.f, s3 = 0.f;
        for (int cb = 0; cb < NCH; cb += 16) {
            u32x2 u[16]; f32x4 df[16];
#pragma unroll
            for (int i = 0; i < 16; ++i) { u[i] = gld<u32x2>(p + (size_t)(cb + i) * 65536); df[i] = gld<f32x4>(dfp + (size_t)(cb + i) * 128); }
#pragma unroll
            for (int i = 0; i < 16; ++i) {
                s0 = df[i][0] * s0 + bf_lo(u[i].x); s1 = df[i][1] * s1 + bf_hi(u[i].x); s2 = df[i][2] * s2 + bf_lo(u[i].y); s3 = df[i][3] * s3 + bf_hi(u[i].y);
                u32x2 o; o.x = cvt_pk_bf16(s0, s1); o.y = cvt_pk_bf16(s2, s3);
                if (!dry) gst<u32x2>(p + (size_t)(cb + i) * 65536, o);
            }
        }
    }
}
__device__ __forceinline__ void gla_p3(CArgs& a, const Ctx& cx, LAS unsigned char* lds, int l, bool dry) {
    unsigned char* ws = a.ws;
    const float* AL = (const float*)(ws + WS_AL); const bf16_t* QKb = (const bf16_t*)(ws + WS_QK); const bf16_t* Vb = (const bf16_t*)(ws + WS_V);
    const unsigned char* US = ws + WS_US; bf16_t* GA = (bf16_t*)(ws + WS_GA);
    const float* Wup = a.in[2] + (size_t)l * 16 * 512; const float* balpha = a.in[3] + (size_t)l * 512; const float* gnorm = a.in[4] + (size_t)l * 1024;
    const int tid = cx.tid, lane = cx.lane, wv = cx.wave, fr = lane & 15, fq = lane >> 4;
    const int d = tid & 127, tg = tid >> 7;
    const int tp = wv & 1, nq = wv >> 1;
    f32x4 alr = (f32x4){0.f, 0.f, 0.f, 0.f}; u32x4 vr[2][2];
    const int it0 = cx.grp * cx.bpg * 512 + cx.gj, itend = (cx.grp + 1) * cx.bpg * 512;
    if (it0 < itend) gla_load_stage(cx, AL, Vb, it0, alr, vr);
    for (int it = it0; it < itend; it += cx.gs) {
        const int b = it >> 9, c = (it >> 2) & 127, h = it & 3; const int row0 = b * SEQ + c * 64; const int slot = (b * 4 + h) * NCH + c;
        __syncthreads();
        gla_write_stage(cx, lds, L_VT3, alr, vr);
        __syncthreads();
        const bf16_t* qb = QKb + (size_t)row0 * 1024 + h * 128; const unsigned qoff = (unsigned)(tg * 16 * 1024 + d) * 2u;
        bf16_t qraw[16], kraw[16];
#pragma unroll
        for (int tt = 0; tt < 16; ++tt) { qraw[tt] = gldo<bf16_t>(qb + (size_t)tt * 1024, qoff); kraw[tt] = gldo<bf16_t>(qb + 512 + (size_t)tt * 1024, qoff); }
        const unsigned char* sp = US + us_off(b, h, c > 0 ? c - 1 : c) + nq * 64 * 256; const unsigned soff = (unsigned)(fr * 256 + fq * 16);
        bf16x8 sf[4][4];
        if (c > 0) {
#pragma unroll
            for (int nt = 0; nt < 4; ++nt)
#pragma unroll
                for (int ks = 0; ks < 4; ++ks) sf[nt][ks] = gldo<bf16x8>(sp + nt * 4096 + ks * 64, soff);
        }
        float g[16], total;
        {   float w[16]; const float bias = gldo<float>(balpha + h * 128, (unsigned)d * 4u);
#pragma unroll
            for (int r = 0; r < 16; ++r) w[r] = gldo<float>(Wup + r * 512 + h * 128, (unsigned)d * 4u);
            if (it + cx.gs < itend) gla_load_stage(cx, AL, Vb, it + cx.gs, alr, vr);
            gla_G(lds, w, bias, d, tg, g, total); }
        {
            LAS bf16_t* QA = (LAS bf16_t*)(lds + L_QA); LAS bf16_t* KA = (LAS bf16_t*)(lds + L_KA); LAS bf16_t* QB = (LAS bf16_t*)(lds + L_QB); LAS bf16_t* KB = (LAS bf16_t*)(lds + L_KB);
#pragma unroll
            for (int tt = 0; tt < 16; ++tt) {
                const float qv = bf2f(qraw[tt]) * QSCALE, kv = bf2f(kraw[tt]); const float eg = __expf(g[tt]), ei = __expf(-g[tt]);
                const int o = (tg * 16 + tt) * 136 + d;
                const unsigned w0 = cvt_pk_bf16(qv * eg, kv * ei), w1 = cvt_pk_bf16(qv * ei, kv * eg);
                QA[o] = (bf16_t)(w0 & 0xffffu); KA[o] = (bf16_t)(w0 >> 16); QB[o] = (bf16_t)(w1 & 0xffffu); KB[o] = (bf16_t)(w1 >> 16);
            }
        }
        __syncthreads();
#pragma unroll
        for (int x = 0; x < 2; ++x) {
            const int tile = 2 * wv + x, tix = tile >> 2, si = tile & 3;
            f32x4 a1 = (f32x4){0.f, 0.f, 0.f, 0.f}, a2 = (f32x4){0.f, 0.f, 0.f, 0.f};
            if (tix >= si) {
#pragma unroll
                for (int ks = 0; ks < 4; ++ks) { const bf16x8 af = *(const LAS bf16x8*)(lds + L_KA + (si * 16 + fr) * 272 + ks * 64 + fq * 16), bfv = *(const LAS bf16x8*)(lds + L_QA + (tix * 16 + fr) * 272 + ks * 64 + fq * 16);
                    a1 = __builtin_amdgcn_mfma_f32_16x16x32_bf16(af, bfv, a1, 0, 0, 0); }
            }
            if (tix <= si) {
#pragma unroll
                for (int ks = 0; ks < 4; ++ks) { const bf16x8 af = *(const LAS bf16x8*)(lds + L_KB + (si * 16 + fr) * 272 + ks * 64 + fq * 16), bfv = *(const LAS bf16x8*)(lds + L_QB + (tix * 16 + fr) * 272 + ks * 64 + fq * 16);
                    a2 = __builtin_amdgcn_mfma_f32_16x16x32_bf16(af, bfv, a2, 0, 0, 0); }
            }
            const int t = tix * 16 + fr, s0 = si * 16 + fq * 4;
            const float p0 = (t >= s0) ? a1[0] : a2[0], p1 = (t >= s0 + 1) ? a1[1] : a2[1], p2 = (t >= s0 + 2) ? a1[2] : a2[2], p3 = (t >= s0 + 3) ? a1[3] : a2[3];
            u32x2 o; o.x = cvt_pk_bf16_n(p0, p1); o.y = cvt_pk_bf16_n(p2, p3);
            *(LAS u32x2*)(lds + L_P + t * 144 + s0 * 2) = o;
        }
        bf16_t* gp = GA + (size_t)row0 * 1024 + h * 256 + nq * 64; const unsigned goff = (unsigned)((2 * tp * 16 + fr) * 1024 + fq * 4) * 2u;
        u32x2 gwv[2][4];
#pragma unroll
        for (int x = 0; x < 2; ++x)
#pragma unroll
            for (int nt = 0; nt < 4; ++nt) gwv[x][nt] = gldo<u32x2>(gp + (size_t)x * 16 * 1024 + nt * 16, goff);
        __syncthreads();
        f32x4 acc[2][4];
#pragma unroll
        for (int x = 0; x < 2; ++x)
#pragma unroll
            for (int i = 0; i < 4; ++i) acc[x][i] = (f32x4){0.f, 0.f, 0.f, 0.f};
        bf16x8 bP[2][2], bQ[2][4];
#pragma unroll
        for (int x = 0; x < 2; ++x) {
#pragma unroll
            for (int ks = 0; ks < 2; ++ks) bP[x][ks] = *(const LAS bf16x8*)(lds + L_P + ((2 * tp + x) * 16 + fr) * 144 + ks * 64 + fq * 16);
#pragma unroll
            for (int ks = 0; ks < 4; ++ks) bQ[x][ks] = *(const LAS bf16x8*)(lds + L_QA + ((2 * tp + x) * 16 + fr) * 272 + ks * 64 + fq * 16);
        }
#pragma unroll
        for (int nt = 0; nt < 4; ++nt) {
            const int n = (nq * 4 + nt) * 16 + fr;
#pragma unroll
            for (int ks = 0; ks < 2; ++ks) { const bf16x8 af = *(const LAS bf16x8*)(lds + L_VT3 + n * 144 + ks * 64 + fq * 16);
#pragma unroll
                for (int x = 0; x < 2; ++x) acc[x][nt] = __builtin_amdgcn_mfma_f32_16x16x32_bf16(af, bP[x][ks], acc[x][nt], 0, 0, 0); }
        }
        if (c > 0) {
#pragma unroll
            for (int nt = 0; nt < 4; ++nt)
#pragma unroll
                for (int ks = 0; ks < 4; ++ks)
#pragma unroll
                    for (int x = 0; x < 2; ++x) acc[x][nt] = __builtin_amdgcn_mfma_f32_16x16x32_bf16(sf[nt][ks], bQ[x][ks], acc[x][nt], 0, 0, 0);
        }
        LAS float* RS = (LAS float*)(lds + L_RS);
#pragma unroll
        for (int x = 0; x < 2; ++x) {
            float ss = 0.f;
#pragma unroll
            for (int nt = 0; nt < 4; ++nt) ss += (acc[x][nt][0] * acc[x][nt][0] + acc[x][nt][1] * acc[x][nt][1]) + (acc[x][nt][2] * acc[x][nt][2] + acc[x][nt][3] * acc[x][nt][3]);
            ss += __shfl_xor(ss, 16); ss += __shfl_xor(ss, 32);
            if (fq == 0) RS[((2 * tp + x) * 16 + fr) * 4 + nq] = ss;
        }
        __syncthreads();
#pragma unroll
        for (int x = 0; x < 2; ++x) {
            const f32x4 r4 = *(const LAS f32x4*)(RS + ((2 * tp + x) * 16 + fr) * 4);
            const float rinv = __builtin_amdgcn_rsqf(((r4[0] + r4[1]) + (r4[2] + r4[3])) * (1.0f / 256.0f) + LN_EPS);
#pragma unroll
            for (int nt = 0; nt < 4; ++nt) {
                const f32x4 gn = gldo<f32x4>(gnorm + h * 256 + nq * 64 + nt * 16, (unsigned)(fq * 4) * 4u);
                const u32x2 gw = gwv[x][nt];
                const float y0 = acc[x][nt][0] * rinv * gn[0] * siluf_(bf_lo(gw.x)), y1 = acc[x][nt][1] * rinv * gn[1] * siluf_(bf_hi(gw.x));
                const float y2 = acc[x][nt][2] * rinv * gn[2] * siluf_(bf_lo(gw.y)), y3 = acc[x][nt][3] * rinv * gn[3] * siluf_(bf_hi(gw.y));
                u32x2 o; o.x = cvt_pk_bf16_n(y0, y1); o.y = cvt_pk_bf16_n(y2, y3);
                if (!dry) gsto<u32x2>(gp + (size_t)x * 16 * 1024 + nt * 16, goff, o);
            }
        }
    }
}

#define XB_TMO      128
#define XB_XCNT(j)  (256  + 64 * (j))
#define XB_XSUB(j)  (1280 + 64 * (j))
#define XB_XGEN(j)  (2304 + 64 * (j))
#define XB_TOP      3328
#define XB_TOPGEN   3392
#define XCD_BAR_WORDS 3456
#define XB_SPIN_CAP (1u << 22)
__device__ __forceinline__ unsigned xb_ld(unsigned* p)              { return __hip_atomic_load(p, __ATOMIC_RELAXED, __HIP_MEMORY_SCOPE_AGENT); }
__device__ __forceinline__ unsigned xb_add(unsigned* p, unsigned v) { return __hip_atomic_fetch_add(p, v, __ATOMIC_RELAXED, __HIP_MEMORY_SCOPE_AGENT); }
__device__ __forceinline__ unsigned xb_xcc_id() { return (unsigned)__builtin_amdgcn_s_getreg((3 << 11) | 20) & 0xFu; }
#define XB_SPIN(cond, bar) do { unsigned _sp = 0; while (cond) { __builtin_amdgcn_s_sleep(1); \
    if ((++_sp & 255u) == 0u) { if (xb_ld(&(bar)[XB_TMO])) break; if (_sp > XB_SPIN_CAP) { atomicAdd(&(bar)[XB_TMO], 1u); break; } } } } while (0)
struct XcdBarrier { unsigned* bar; unsigned x; volatile LAS unsigned* st; unsigned gs; };
__device__ __forceinline__ XcdBarrier xcd_barrier_post(unsigned* bar, volatile LAS unsigned* st, unsigned gs) {
    XcdBarrier b; b.bar = bar; b.x = xb_xcc_id(); b.st = st; b.gs = gs;
    if (threadIdx.x == 0) (void)xb_add(&bar[XB_XCNT(b.x)], 1u);
    return b;
}
__device__ __forceinline__ void xcd_barrier_complete(unsigned* bar, unsigned x, unsigned& nloc, unsigned& nx, const unsigned G) {
    unsigned sum, cnt, mine, sp = 0u;
    for (;;) {
        sum = 0u; cnt = 0u; mine = 0u;
#pragma unroll
        for (unsigned j = 0; j < 16; ++j) { const unsigned c = xb_ld(&bar[XB_XCNT(j)]); sum += c; cnt += (c > 0u) ? 1u : 0u; mine = (j == x) ? c : mine; }
        if (sum == G) break;
        __builtin_amdgcn_s_sleep(1);
        if ((++sp & 255u) == 0u) { if (xb_ld(&bar[XB_TMO])) break; if (sp > XB_SPIN_CAP) { atomicAdd(&bar[XB_TMO], 1u); break; } }
    }
    nloc = mine > 0u ? mine : 1u; nx = cnt > 0u ? cnt : 1u;
}
__device__ __forceinline__ void xcd_barrier(const XcdBarrier& b) {
    asm volatile("s_waitcnt vmcnt(0)" ::: "memory");
    __syncthreads();
    if (threadIdx.x == 0) {
        unsigned* bar; { const unsigned long long v = (unsigned long long)b.bar;
            unsigned lo = (unsigned)__builtin_amdgcn_readfirstlane((unsigned)v), hi = (unsigned)__builtin_amdgcn_readfirstlane((unsigned)(v >> 32));
            asm volatile("" : "+s"(lo), "+s"(hi)); bar = (unsigned*)(((unsigned long long)hi << 32) | lo); }
        __builtin_amdgcn_s_waitcnt(0);
        unsigned nloc = b.st[0], nx = b.st[1];
        if (nloc == 0u) { xcd_barrier_complete(bar, b.x, nloc, nx, b.gs); b.st[0] = nloc; b.st[1] = nx; }
        const unsigned old = xb_add(&bar[XB_XSUB(b.x)], 1u);
        const unsigned gen = old / nloc;
        if (old + 1u == (gen + 1u) * nloc) {
            __builtin_amdgcn_fence(__ATOMIC_RELEASE, "agent");
            asm volatile("s_waitcnt vmcnt(0)" ::: "memory");
            const unsigned og = xb_add(&bar[XB_TOP], 1u);
            const unsigned tg = og / nx;
            if (og + 1u == (tg + 1u) * nx) xb_add(&bar[XB_TOPGEN], 1u);
            else XB_SPIN(xb_ld(&bar[XB_TOPGEN]) == tg, bar);
            __builtin_amdgcn_fence(__ATOMIC_ACQUIRE, "agent");
            xb_add(&bar[XB_XGEN(b.x)], 1u);
            asm volatile("s_waitcnt vmcnt(0)" ::: "memory");
        } else {
            XB_SPIN(xb_ld(&bar[XB_XGEN(b.x)]) == gen, bar);
            __builtin_amdgcn_fence(__ATOMIC_ACQUIRE, "agent");
            asm volatile("s_waitcnt vmcnt(0)" ::: "memory");
        }
    }
    __syncthreads();
}

constexpr int PH_PER_LAYER = 9, N_PHASES = 1 + DEPTH * PH_PER_LAYER;

__device__ __forceinline__ void run_phase(CArgs& a, const Ctx& cx, LAS unsigned char* lds, int ph, bool dry) {
    unsigned char* ws = a.ws;
    if (ph == 0) {
        row_phase(cx, lds, a.in[0], nullptr, (bf16_t*)(ws + WS_X), (float*)(ws + WS_AL), a.in[1] + 3072, nullptr, nullptr, false);
        __syncthreads();
        convert_weights(a, cx, lds, 0);
        return;
    }
    const int l = (ph - 1) / PH_PER_LAYER; int sp = (ph - 1) % PH_PER_LAYER;
#ifdef ONLY_SP
    sp = ONLY_SP;
#endif
    const unsigned char* wsw = ws + (size_t)(l & 1) * WSET_BYTES;
    pg8::Sched S; S.G = cx.G; S.c = cx.bid; S.chain = 1; S.A1 = nullptr; S.B1 = nullptr; S.a_pn = 0; S.nM = MTOK / 256;
    switch (sp) {
    case 0: {
        S.A0 = (const char*)(ws + WS_X); S.B0 = (const char*)(wsw + WS_W1A); S.a_pm = (size_t)256 * 1024 * 2; S.b_pn = (size_t)256 * 1024 * 2; S.nN = 20; S.nwg = S.nM * S.nN;
        pg8::EpiSplit E{(bf16_t*)(ws + WS_QK)};
        pg8::gemm_phase<pg8::EpiSplit>(lds, cx.tid, pg8::Gemm{1024, 1024, 1024}, S, E);
    } break;
    case 1: pool_phase(cx, (const bf16_t*)(ws + WS_PIN), (bf16_t*)(ws + WS_GB), a.in[6] + (size_t)l * 1024); break;
    case 2: gla_p1(a, cx, lds, l); break;
    case 3: gla_p2(a, cx, dry); break;
    case 4: gla_p3(a, cx, lds, l, dry); break;
    case 5: {
        S.A0 = (const char*)(ws + WS_X); S.B0 = (const char*)(wsw + WS_WM); S.a_pm = (size_t)256 * 1024 * 2; S.b_pn = (size_t)256 * 1024 * 2; S.nN = 8; S.nwg = S.nM * S.nN;
        pg8::EpiSig E{(bf16_t*)(ws + WS_MG), a.in[7] + (size_t)l * 2048};
        pg8::gemm_phase<pg8::EpiSig>(lds, cx.tid, pg8::Gemm{1024, 1024, 1024}, S, E);
    } break;
    case 6: {
        S.chain = 2; S.A0 = (const char*)(ws + WS_GA); S.A1 = (const char*)(ws + WS_GB); S.B0 = (const char*)(wsw + WS_WA); S.B1 = (const char*)(wsw + WS_WB);
        S.a_pm = (size_t)256 * 1024 * 2; S.b_pn = (size_t)256 * 1024 * 2; S.nN = 4; S.nwg = S.nM * S.nN;
        pg8::EpiProj E{(const bf16_t*)(ws + WS_MG), (bf16_t*)(ws + WS_PIN)};
        pg8::gemm_phase<pg8::EpiProj>(lds, cx.tid, pg8::Gemm{1024, 1024, 1024}, S, E);
    } break;
    case 7: {
        S.A0 = (const char*)(ws + WS_PIN); S.B0 = (const char*)(wsw + WS_WO); S.a_pm = (size_t)256 * 1024 * 2; S.b_pn = (size_t)256 * 1024 * 2; S.nN = 4; S.nwg = S.nM * S.nN;
        pg8::EpiOut E{l == 0 ? a.in[0] : a.out, a.out};
        pg8::gemm_phase<pg8::EpiOut>(lds, cx.tid, pg8::Gemm{1024, 1024, 1024}, S, E);
    } break;
    default: {
        const bool more = (l + 1 < DEPTH);
        row_phase(cx, lds, a.out, a.out, more ? (bf16_t*)(ws + WS_X) : nullptr, more ? (float*)(ws + WS_AL) : nullptr,
                  a.in[1] + (size_t)(more ? l + 1 : l) * 1024 * INC + 3072, a.in[11] + (size_t)l * 1024, a.in[12] + (size_t)l * 1024, true, dry);
        if (more) { __syncthreads(); convert_weights(a, cx, lds, l + 1); }
    } break;
    }
}

__global__ void __launch_bounds__(512, 2) mega_fwd(Args a) {
    extern __shared__ __attribute__((aligned(16))) unsigned char lds_raw[];
    LAS unsigned char* lds = (LAS unsigned char*)lds_raw;
    cg::grid_group grid = cg::this_grid();
    if (threadIdx.x < 16) ((LAS unsigned*)(lds + LDS_PHASE))[threadIdx.x] = 0u;
    __syncthreads();
    const int ngrp = ((gridDim.x & 7) == 0) ? 4 : 1;
    const int my_grp = (ngrp == 4) ? (int)((blockIdx.x & 7) >> 1) : 0, my_gs = (int)gridDim.x / ngrp, my_gj = (ngrp == 4) ? (int)((blockIdx.x >> 3) * 2 + (blockIdx.x & 1)) : (int)blockIdx.x;
    const XcdBarrier bar = xcd_barrier_post((unsigned*)(a.ws + WS_BAR), (volatile LAS unsigned*)(lds + LDS_PHASE), gridDim.x);
    const XcdBarrier gbar = xcd_barrier_post((unsigned*)(a.ws + WS_BAR) + 4096 * (1 + my_grp), (volatile LAS unsigned*)(lds + LDS_PHASE + 32), (unsigned)my_gs);
    const int my_team = (ngrp == 4 && (my_gs & 3) == 0) ? 1 : 0;
    const XcdBarrier tbar = xcd_barrier_post((unsigned*)(a.ws + WS_BAR) + 4096 * (5 + my_grp * 4 + (my_gj & 3)), (volatile LAS unsigned*)(lds + LDS_PHASE + 48), (unsigned)(my_team ? my_gs / 4 : 1));
    constexpr int PPL = PH_PER_LAYER + (DUP_SP >= 0 ? 1 : 0);
    unsigned long long pr_acc = 0, pr_t0 = 0;
    for (int idx = a.ph_lo; idx < a.ph_hi; ++idx) {
        if (idx > a.ph_lo) { if (a.ph_lo < 0) grid.sync();
            if (PROBE_SP == 11) pr_t0 = __builtin_amdgcn_s_memrealtime();
            const int pph = (idx - 1 == 0) ? 0 : 1 + ((idx - 2) / PPL) * PH_PER_LAYER + ((idx - 2) % PPL);
            const bool wide = (pph == 0) || ((pph - 1) % PH_PER_LAYER == PH_PER_LAYER - 1);
            const int psp = (pph - 1) % PH_PER_LAYER; const bool tseam = my_team && pph > 0 && (psp == 2 || psp == 3);
            for (int r = 0; r < SYNC_REPS; ++r) { if (wide) xcd_barrier(bar); else if (tseam) xcd_barrier(tbar); else xcd_barrier(gbar); }
            if (PROBE_SP == 11) pr_acc += __builtin_amdgcn_s_memrealtime() - pr_t0; }
        int ph = 0; bool dry = false;
        if (idx > 0) { const int l = (idx - 1) / PPL, e = (idx - 1) % PPL; const int sp = (DUP_SP >= 0 && e > DUP_SP) ? e - 1 : e; ph = 1 + l * PH_PER_LAYER + sp; dry = (DUP_SP >= 0 && e == DUP_SP); }
        int tid = threadIdx.x; asm volatile("" : "+v"(tid));
        Ctx cx; cx.tid = tid; cx.lane = tid & 63; cx.wave = __builtin_amdgcn_readfirstlane(tid >> 6); { int bid_ = blockIdx.x, g_ = gridDim.x; asm volatile("" : "+s"(bid_), "+s"(g_)); cx.G = g_; cx.bid = bid_; }
        { int a_ = __builtin_amdgcn_readfirstlane(my_grp), b_ = __builtin_amdgcn_readfirstlane(my_gj), c_ = __builtin_amdgcn_readfirstlane(my_gs); asm volatile("" : "+s"(a_), "+s"(b_), "+s"(c_)); cx.grp = a_; cx.gj = b_; cx.gs = c_; cx.bpg = 4 / ngrp; cx.team = my_team; }
        CArgs* kp = (CArgs*)__builtin_amdgcn_kernarg_segment_ptr(); asm volatile("" : "+s"(kp));
        const bool pr_on = (PROBE_SP >= 0 && PROBE_SP <= 10) && ((ph == 0) ? (PROBE_SP == 10) : ((ph - 1) % PH_PER_LAYER == PROBE_SP));
        if (pr_on) pr_t0 = __builtin_amdgcn_s_memrealtime();
        run_phase(*kp, cx, lds, ph, dry);
        if (pr_on) { __syncthreads(); pr_acc += __builtin_amdgcn_s_memrealtime() - pr_t0; }
    }
    if (PROBE_SP >= 0 && blockIdx.x == 0) { const unsigned long long t1 = __builtin_amdgcn_s_memrealtime(); while (__builtin_amdgcn_s_memrealtime() - t1 < 9ull * pr_acc) __builtin_amdgcn_s_sleep(8); }
}

extern "C" void kernel_launch(void* const* d_in, const int* in_sizes, int n_in, void* d_out, int out_size, void* d_ws, size_t ws_size, hipStream_t stream) {
    static int grid = 0;
    if (grid == 0) {
        if (n_in != 13 || in_sizes[0] != MTOK * DM || out_size != MTOK * DM || ws_size < WS_END) {
            fprintf(stderr, "kernel_launch: unexpected shapes (n_in %d, in0 %d, out %d, ws %zu, need %zu); nothing launched\n", n_in, n_in > 0 ? in_sizes[0] : -1, out_size, ws_size, (size_t)WS_END); grid = -1; return; }
        int dev = 0, cus = 0, per_cu = 0;
        if (hipGetDevice(&dev) != hipSuccess || hipDeviceGetAttribute(&cus, hipDeviceAttributeMultiprocessorCount, dev) != hipSuccess) { grid = -1; return; }
        if (hipFuncSetAttribute((const void*)mega_fwd, hipFuncAttributeMaxDynamicSharedMemorySize, LDS_BYTES) != hipSuccess) { fprintf(stderr, "kernel_launch: hipFuncSetAttribute failed\n"); grid = -1; return; }
        if (hipOccupancyMaxActiveBlocksPerMultiprocessor(&per_cu, (const void*)mega_fwd, 512, LDS_BYTES) != hipSuccess || per_cu < 1) { fprintf(stderr, "kernel_launch: occupancy query says %d\n", per_cu); per_cu = 1; }
        (void)hipGetLastError();
        grid = cus;
    }
    if (grid < 0) return;
    Args a{};
    for (int i = 0; i < 13; ++i) a.in[i] = (const float*)d_in[i];
    a.out = (float*)d_out; a.ws = (unsigned char*)d_ws;
#if N_LAUNCH_MODE == 1
    for (int ph = 0; ph < N_PHASES; ++ph) {
        a.ph_lo = ph; a.ph_hi = ph + 1;
        hipLaunchKernelGGL(mega_fwd, dim3(grid), dim3(512), LDS_BYTES, stream, a);
    }
#else
    if (hipMemsetAsync((unsigned char*)d_ws + WS_BAR, 0, BAR_BYTES + CTR_BYTES, stream) != hipSuccess) { fprintf(stderr, "kernel_launch: memset of barrier words failed\n"); return; }
    a.ph_lo = 0; a.ph_hi = 1 + DEPTH * (PH_PER_LAYER + (DUP_SP >= 0 ? 1 : 0));
    void* args[] = {&a};
    hipError_t e = hipLaunchCooperativeKernel((const void*)mega_fwd, dim3(grid), dim3(512), args, LDS_BYTES, stream);
    if (e != hipSuccess) fprintf(stderr, "cooperative launch failed: %s (grid %d)\n", hipGetErrorString(e), grid);
#endif
}
```
